# Optimizing an MI355X kernel written in HIP

```python
import math
import jax
import jax.numpy as jnp
from jax import lax
import numpy as np

D_MODEL = 1024
BATCH = 16
SEQ = 2048
DEPTH = 2

GRID_W = 64
CTX_LEN = 256
Q_BLOCK = 128
ROPE_THETA = 10000.0
EPS = 1e-6
N_MOD = 9

HEAD_DIM = 64
GROUP_WIDTH = D_MODEL // 4
N_HEADS_A = GROUP_WIDTH // HEAD_DIM
N_KV_A = N_HEADS_A // 2
GQA_GROUP = N_HEADS_A // N_KV_A
N_HEADS_C = GROUP_WIDTH // HEAD_DIM
DIFF_DIM = HEAD_DIM // 2
DIFF_VDIM = HEAD_DIM
GMLP_GROUPS = GROUP_WIDTH // HEAD_DIM
GMLP_GROUP_DIM = HEAD_DIM
GMLP_WIDTH = GROUP_WIDTH
CHUNK = 128
CONV_CH = GROUP_WIDTH
CONV_K = 31
D_FF = ((8 * D_MODEL // 3 + 127) // 128) * 128

IN_SPLITS = (
    N_HEADS_A * HEAD_DIM,
    N_HEADS_C * 2 * DIFF_DIM,
    N_KV_A * HEAD_DIM,
    N_KV_A * HEAD_DIM,
    N_HEADS_C * 2 * DIFF_DIM,
    N_HEADS_C * DIFF_VDIM,
    2 * GMLP_WIDTH,
    2 * CONV_CH,
)
IN_COLS = sum(IN_SPLITS)
KV_LO = IN_SPLITS[0] + IN_SPLITS[1]
KV_HI = KV_LO + sum(IN_SPLITS[2:6])

kernel_name = "hybrid_parallel_group_dit_block"


def rms_norm(x, g):
    x32 = x.astype(jnp.float32)
    y = x32 * lax.rsqrt(jnp.mean(x32 * x32, axis=-1, keepdims=True) + EPS)
    return y.astype(x.dtype) * g


def split_cols(x, sizes):
    return jnp.split(x, np.cumsum(sizes)[:-1].tolist(), axis=-1)


def adaln(cvec, w, b):
    m = jax.nn.silu(cvec) @ w + b
    return m.reshape(m.shape[:-1] + (N_MOD, 1, D_MODEL))


def modulate(h, g, mod, i):
    return rms_norm(h, g) * (1 + mod[..., i + 1, :, :]) + mod[..., i, :, :]


def swiglu(x, w_in, w_out):
    a, b = jnp.split(x @ w_in, 2, axis=-1)
    return (jax.nn.silu(a) * b) @ w_out


def axial_rope_tables(row, col, head_dim):
    quarter = head_dim // 4
    inv = ROPE_THETA ** (-jnp.arange(quarter, dtype=jnp.float32) / quarter)
    ang = jnp.concatenate([row.astype(jnp.float32)[:, None] * inv,
                           col.astype(jnp.float32)[:, None] * inv], axis=-1)
    return jnp.cos(ang), jnp.sin(ang)


def apply_rope(x, cos, sin):
    x1, x2 = jnp.split(x, 2, axis=-1)
    cos = cos.astype(x.dtype)
    sin = sin.astype(x.dtype)
    return jnp.concatenate([x1 * cos - x2 * sin, x1 * sin + x2 * cos], axis=-1)


def sweep_query_blocks(fn, q):
    n, d = q.shape[-2], q.shape[-1]
    qb = jnp.moveaxis(q.reshape(q.shape[:-2] + (n // Q_BLOCK, Q_BLOCK, d)), -3, 0)
    out = jnp.moveaxis(lax.map(fn, qb), 0, -3)
    return out.reshape(out.shape[:-3] + (n, out.shape[-1]))


def to_heads(x, n_heads, d):
    b, n, _ = x.shape
    return x.reshape(b, n, n_heads, d).transpose(0, 2, 1, 3)


def gqa_q_heads(q, g):
    b, n, _ = q.shape
    q = rms_norm(q.reshape(b, n, N_KV_A, GQA_GROUP, HEAD_DIM), g)
    return q.transpose(0, 2, 3, 1, 4)


def gqa_attend(q, k, v):
    s = jnp.einsum('bkgqd,bksd->bkgqs', q, k) * HEAD_DIM ** -0.5
    p = jax.nn.softmax(s.astype(jnp.float32), axis=-1).astype(v.dtype)
    return jnp.einsum('bkgqs,bksd->bkgqd', p, v)


def merge_gqa(o):
    b, kv, g, n, d = o.shape
    return o.transpose(0, 3, 1, 2, 4).reshape(b, n, kv * g * d)


def diff_qk_heads(x):
    b, n, _ = x.shape
    return x.reshape(b, n, N_HEADS_C, 2, DIFF_DIM).transpose(0, 2, 3, 1, 4)


def diff_lambda(lp, lam_init):
    lp = lp.astype(jnp.float32)
    return jnp.exp(jnp.sum(lp[0] * lp[1])) - jnp.exp(jnp.sum(lp[2] * lp[3])) + lam_init


def diff_attend(q, k, v, lam):
    s = jnp.einsum('bhcqd,bhcsd->bhcqs', q, k) * DIFF_DIM ** -0.5
    p = jax.nn.softmax(s.astype(jnp.float32), axis=-1)
    a = (p[:, :, 0] - lam * p[:, :, 1]).astype(v.dtype)
    return jnp.einsum('bhqs,bhsd->bhqd', a, v)


def diff_finish(o, g_sub, lam_init):
    o = rms_norm(o, g_sub) * (1.0 - lam_init)
    b, h, n, d = o.shape
    return o.transpose(0, 2, 1, 3).reshape(b, n, h * d)


def chunk_gmlp(uv, g_v, w_s, b_s):
    u, v = jnp.split(jax.nn.gelu(uv), 2, axis=-1)
    v = rms_norm(v, g_v)
    b, n, _ = v.shape
    vb = v.reshape(b, n // CHUNK, CHUNK, GMLP_GROUPS, GMLP_GROUP_DIM)
    mixed = jnp.einsum('gpq,bcqgd->bcpgd', w_s, vb) + jnp.transpose(b_s)[:, :, None]
    return u * mixed.reshape(b, n, GMLP_WIDTH)


def conformer_conv(glu_in, w_dw, b_dw, g_n):
    a, gate = jnp.split(glu_in, 2, axis=-1)
    y = a * jax.nn.sigmoid(gate)
    y = lax.conv_general_dilated(
        y, w_dw[:, None, :], window_strides=(1,), padding=[(CONV_K // 2, CONV_K // 2)],
        dimension_numbers=('NWC', 'WIO', 'NWC'), feature_group_count=CONV_CH) + b_dw
    return jax.nn.silu(rms_norm(y, g_n))


def setup_inputs(seed: int = 0) -> dict:
    key = jax.random.key(seed)
    ks = jax.random.split(key, 24)
    f32 = jnp.float32

    def nrm(k, shape, scale):
        return jax.random.normal(k, shape, f32) * scale

    return {
        "x": nrm(ks[0], (BATCH, SEQ, D_MODEL), 1.0),
        "c": nrm(ks[1], (BATCH, D_MODEL), 1.0),
        "ctx": nrm(ks[2], (BATCH, CTX_LEN, D_MODEL), 1.0),
        "c_ctx": nrm(ks[3], (D_MODEL,), 1.0),
        "w_ada": nrm(ks[4], (DEPTH, D_MODEL, N_MOD * D_MODEL), 0.5 * D_MODEL ** -0.5),
        "b_ada": nrm(ks[5], (DEPTH, N_MOD * D_MODEL), 0.02),
        "g_norm": 1.0 + nrm(ks[6], (DEPTH, 3, D_MODEL), 0.02),
        "w_ff1_in": nrm(ks[7], (DEPTH, D_MODEL, 2 * D_FF), D_MODEL ** -0.5),
        "w_ff1_out": nrm(ks[8], (DEPTH, D_FF, D_MODEL), D_FF ** -0.5),
        "w_ff2_in": nrm(ks[9], (DEPTH, D_MODEL, 2 * D_FF), D_MODEL ** -0.5),
        "w_ff2_out": nrm(ks[10], (DEPTH, D_FF, D_MODEL), D_FF ** -0.5),
        "w_in": nrm(ks[11], (DEPTH, D_MODEL, IN_COLS), D_MODEL ** -0.5),
        "w_out": nrm(ks[12], (DEPTH, D_MODEL, D_MODEL), D_MODEL ** -0.5),
        "g_q_a": 1.0 + nrm(ks[13], (DEPTH, HEAD_DIM), 0.02),
        "g_k_a": 1.0 + nrm(ks[14], (DEPTH, HEAD_DIM), 0.02),
        "lam_c": nrm(ks[15], (DEPTH, 4, DIFF_DIM), 0.1),
        "g_sub_c": 1.0 + nrm(ks[16], (DEPTH, DIFF_VDIM), 0.02),
        "g_v_b": 1.0 + nrm(ks[17], (DEPTH, GMLP_WIDTH), 0.02),
        "w_s_b": nrm(ks[18], (DEPTH, GMLP_GROUPS, CHUNK, CHUNK), CHUNK ** -0.5),
        "b_s_b": 1.0 + nrm(ks[19], (DEPTH, GMLP_GROUPS, CHUNK), 0.02),
        "w_dw_d": nrm(ks[20], (DEPTH, CONV_K, CONV_CH), CONV_K ** -0.5),
        "b_dw_d": nrm(ks[21], (DEPTH, CONV_CH), 0.02),
        "g_conv_d": 1.0 + nrm(ks[22], (DEPTH, CONV_CH), 0.02),
        "g_final": 1.0 + nrm(ks[23], (D_MODEL,), 0.02),
    }


def reference(x, c, ctx, c_ctx, w_ada, b_ada, g_norm, w_ff1_in, w_ff1_out, w_ff2_in,
              w_ff2_out, w_in, w_out, g_q_a, g_k_a, lam_c, g_sub_c, g_v_b, w_s_b, b_s_b,
              w_dw_d, b_dw_d, g_conv_d, g_final):
    n = x.shape[1]
    rows = n // GRID_W
    row = jnp.repeat(jnp.arange(rows, dtype=jnp.int32), GRID_W)
    col = jnp.tile(jnp.arange(GRID_W, dtype=jnp.int32), rows)
    cos_a, sin_a = axial_rope_tables(row, col, HEAD_DIM)
    cos_c, sin_c = axial_rope_tables(row, col, DIFF_DIM)

    h, hc = x, ctx
    for l in range(DEPTH):
        last = l == DEPTH - 1
        m = adaln(c, w_ada[l], b_ada[l])
        mc = adaln(c_ctx, w_ada[l], b_ada[l])

        h = h + 0.5 * m[..., 2, :, :] * swiglu(modulate(h, g_norm[l, 0], m, 0), w_ff1_in[l], w_ff1_out[l])
        hc = hc + 0.5 * mc[..., 2, :, :] * swiglu(modulate(hc, g_norm[l, 0], mc, 0), w_ff1_in[l], w_ff1_out[l])

        hn = modulate(h, g_norm[l, 1], m, 3)
        hcn = modulate(hc, g_norm[l, 1], mc, 3)
        qa, qc, ka, va, kc, vc, uv, glu = split_cols(hn @ w_in[l], IN_SPLITS)
        if last:
            ka_x, va_x, kc_x, vc_x = split_cols(hcn @ w_in[l, :, KV_LO:KV_HI], IN_SPLITS[2:6])
        else:
            qa_x, qc_x, ka_x, va_x, kc_x, vc_x, uv_x, glu_x = split_cols(hcn @ w_in[l], IN_SPLITS)
        ka_x = rms_norm(to_heads(ka_x, N_KV_A, HEAD_DIM), g_k_a[l])
        va_x = to_heads(va_x, N_KV_A, HEAD_DIM)
        kc_x = diff_qk_heads(kc_x)
        vc_x = to_heads(vc_x, N_HEADS_C, DIFF_VDIM)
        lam_init = 0.8 - 0.6 * math.exp(-0.3 * l)
        lam = diff_lambda(lam_c[l], lam_init)

        qa_h = apply_rope(gqa_q_heads(qa, g_q_a[l]), cos_a, sin_a)
        ka_all = jnp.concatenate(
            [apply_rope(rms_norm(to_heads(ka, N_KV_A, HEAD_DIM), g_k_a[l]), cos_a, sin_a), ka_x], axis=2)
        va_all = jnp.concatenate([to_heads(va, N_KV_A, HEAD_DIM), va_x], axis=2)
        oa = merge_gqa(sweep_query_blocks(lambda qb: gqa_attend(qb, ka_all, va_all), qa_h))

        qc_h = apply_rope(diff_qk_heads(qc), cos_c, sin_c)
        kc_all = jnp.concatenate([apply_rope(diff_qk_heads(kc), cos_c, sin_c), kc_x], axis=3)
        vc_all = jnp.concatenate([to_heads(vc, N_HEADS_C, DIFF_VDIM), vc_x], axis=2)
        oc = diff_finish(sweep_query_blocks(lambda qb: diff_attend(qb, kc_all, vc_all, lam), qc_h),
                         g_sub_c[l], lam_init)

        ob = chunk_gmlp(uv, g_v_b[l], w_s_b[l], b_s_b[l])
        od = conformer_conv(glu, w_dw_d[l], b_dw_d[l], g_conv_d[l])

        mix = jnp.concatenate([oa, oc, ob, od], axis=-1) @ w_out[l]
        h = h + m[..., 5, :, :] * mix

        if not last:
            oa_x = merge_gqa(gqa_attend(gqa_q_heads(qa_x, g_q_a[l]), ka_x, va_x))
            oc_x = diff_finish(diff_attend(diff_qk_heads(qc_x), kc_x, vc_x, lam), g_sub_c[l], lam_init)
            ob_x = chunk_gmlp(uv_x, g_v_b[l], w_s_b[l], b_s_b[l])
            od_x = conformer_conv(glu_x, w_dw_d[l], b_dw_d[l], g_conv_d[l])
            mix_x = jnp.concatenate([oa_x, oc_x, ob_x, od_x], axis=-1) @ w_out[l]
            hc = hc + mc[..., 5, :, :] * mix_x

        h = h + 0.5 * m[..., 8, :, :] * swiglu(modulate(h, g_norm[l, 2], m, 6), w_ff2_in[l], w_ff2_out[l])
        if not last:
            hc = hc + 0.5 * mc[..., 8, :, :] * swiglu(modulate(hc, g_norm[l, 2], mc, 6), w_ff2_in[l], w_ff2_out[l])

    return rms_norm(h, g_final)
```

```cpp
#include <hip/hip_runtime.h>
#include <hip/hip_cooperative_groups.h>
#include <cstdint>
#include <cstdio>
#include <cmath>
namespace cg = cooperative_groups;

#ifndef N_LAUNCH_MODE
#define N_LAUNCH_MODE 0
#endif

typedef unsigned short bf16_t;
typedef short bf16x8 __attribute__((ext_vector_type(8)));
typedef short s16x4 __attribute__((ext_vector_type(4)));
typedef float f32x4 __attribute__((ext_vector_type(4)));
typedef float f32x2 __attribute__((ext_vector_type(2)));
typedef float f32x16 __attribute__((ext_vector_type(16)));
typedef unsigned u32x2 __attribute__((ext_vector_type(2)));
typedef unsigned u32x4 __attribute__((ext_vector_type(4)));
typedef __bf16 bf2_t __attribute__((ext_vector_type(2)));
#define DI __device__ __forceinline__

constexpr int D = 1024, NB = 16, SEQ = 2048, CTX = 256, NLAT = NB * SEQ, NCTX = NB * CTX, NTOK = NLAT + NCTX;
constexpr int DFF = 2816, INC = 2304, KEYS = SEQ + CTX, DEPTH = 2, MODW = 9 * D;
constexpr int NTHR = 512;
constexpr int LDS_BYTES = 135168;
constexpr float EPS = 1e-6f;

DI unsigned pk2(float a, float b) { f32x2 v = {a, b}; bf2_t r = __builtin_convertvector(v, bf2_t); return __builtin_bit_cast(unsigned, r); }
DI float bf2f(bf16_t v) { return __uint_as_float(((unsigned)v) << 16); }
DI float bflo(unsigned v) { return __uint_as_float(v << 16); }
DI float bfhi(unsigned v) { return __uint_as_float(v & 0xffff0000u); }
DI bf16_t f2bf(float a) { return (bf16_t)(pk2(a, 0.f) & 0xffffu); }
DI float silu_f(float x) { return x / (1.f + __expf(-x)); }
DI float sigmoid_f(float x) { return 1.f / (1.f + __expf(-x)); }
DI float gelu_f(float x) { float u = 1.5957691216057308f * (x + 0.044715f * x * x * x); return x / (1.f + __expf(-u)); }
DI int TID() { int t = __builtin_amdgcn_workitem_id_x(); asm volatile("" : "+v"(t)); return t; }
DI float wave_sum(float v) {
#pragma unroll
    for (int o = 32; o >= 1; o >>= 1) v += __shfl_xor(v, o);
    return v;
}

struct Params {
    const float *x, *c, *ctx, *c_ctx, *w_ada, *b_ada, *g_norm, *w_ff1_in, *w_ff1_out, *w_ff2_in, *w_ff2_out, *w_in, *w_out, *g_q_a, *g_k_a, *lam_c,
        *g_sub_c, *g_v_b, *w_s_b, *b_s_b, *w_dw_d, *b_dw_d, *g_conv_d, *g_final;
    float* out;
    bf16_t *Wff1in, *Wff1out, *Wff2in, *Wff2out, *Win, *Wout, *Ws;
    float *mods, *ropeA, *ropeC, *hc;
    bf16_t *xn, *hid, *QA, *KA, *VtA, *QC, *KC, *VtC, *U, *VN, *Y, *cat;
};

DI void sincos_d(double x, double& s, double& c) {
    double k = rint(x * 0.15915494309189535);
    double r = fma(-k, 6.283185307179586, x);
    r = fma(-k, 2.4492935982947064e-16, r);
    double r2 = r * r, as = 1.0, ac = 1.0;
#pragma unroll
    for (int n = 14; n >= 1; --n) {
        as = 1.0 - r2 / (double)((2 * n) * (2 * n + 1)) * as;
        ac = 1.0 - r2 / (double)((2 * n - 1) * (2 * n)) * ac;
    }
    s = r * as; c = ac;
}

constexpr int T_FFIN = (D / 64) * (2 * DFF / 64), T_FFOUT = (DFF / 64) * (D / 64), T_WIN = (D / 64) * (INC / 64), T_WOUT = (D / 64) * (D / 64);
constexpr int T_LAYER = 2 * T_FFIN + 2 * T_FFOUT + T_WIN + T_WOUT;
constexpr int U_TR = DEPTH * T_LAYER, U_WS = 32, U_ADA = 288, U_ROPE = 192;
constexpr int U_P0 = U_TR + U_WS + U_ADA + U_ROPE;

DI void transpose_unit(const float* src, bf16_t* dst, int K, int N, int perm, int ti, float* tile) {
    const int tn = N / 64, kt = ti / tn, nt = ti % tn, k0 = kt * 64, n0 = nt * 64;
    int sc0 = n0;
    if (perm == 1) { int t = n0 >> 8, j = n0 & 255; sc0 = j < 128 ? t * 128 + j : DFF + t * 128 + (j - 128); }
    else if (perm == 2 && n0 >= 1792) { int m = n0 - 1792, t = m >> 8, j = m & 255; sc0 = j < 128 ? 1792 + t * 128 + j : 2048 + t * 128 + (j - 128); }
    const int t = TID();
    {
        const int kk = t >> 4, c4 = (t & 15) * 4;
#pragma unroll
        for (int i = 0; i < 2; ++i) {
            const int k = kk + 32 * i;
            f32x4 v = *(const f32x4*)(src + (size_t)(k0 + k) * N + sc0 + c4);
            tile[k * 65 + c4 + 0] = v[0]; tile[k * 65 + c4 + 1] = v[1]; tile[k * 65 + c4 + 2] = v[2]; tile[k * 65 + c4 + 3] = v[3];
        }
    }
    __syncthreads();
    {
        const int n = t >> 3, k8 = (t & 7) * 8;
        u32x4 o;
        o[0] = pk2(tile[(k8 + 0) * 65 + n], tile[(k8 + 1) * 65 + n]);
        o[1] = pk2(tile[(k8 + 2) * 65 + n], tile[(k8 + 3) * 65 + n]);
        o[2] = pk2(tile[(k8 + 4) * 65 + n], tile[(k8 + 5) * 65 + n]);
        o[3] = pk2(tile[(k8 + 6) * 65 + n], tile[(k8 + 7) * 65 + n]);
        *(u32x4*)(dst + (size_t)(n0 + n) * K + k0 + k8) = o;
    }
    __syncthreads();
}

DI void phase_prologue(const Params& p, char* smem) {
    const int t = TID();
    for (int u = blockIdx.x; u < U_P0; u += gridDim.x) {
        if (u < U_TR) {
            const int l = u / T_LAYER; int r = u % T_LAYER;
            const float* src; bf16_t* dst; int K, N, perm;
            if (r < T_FFIN) { src = p.w_ff1_in + (size_t)l * D * 2 * DFF; dst = p.Wff1in + (size_t)l * D * 2 * DFF; K = D; N = 2 * DFF; perm = 1; }
            else if ((r -= T_FFIN) < T_FFOUT) { src = p.w_ff1_out + (size_t)l * D * DFF; dst = p.Wff1out + (size_t)l * D * DFF; K = DFF; N = D; perm = 0; }
            else if ((r -= T_FFOUT) < T_FFIN) { src = p.w_ff2_in + (size_t)l * D * 2 * DFF; dst = p.Wff2in + (size_t)l * D * 2 * DFF; K = D; N = 2 * DFF; perm = 1; }
            else if ((r -= T_FFIN) < T_FFOUT) { src = p.w_ff2_out + (size_t)l * D * DFF; dst = p.Wff2out + (size_t)l * D * DFF; K = DFF; N = D; perm = 0; }
            else if ((r -= T_FFOUT) < T_WIN) { src = p.w_in + (size_t)l * D * INC; dst = p.Win + (size_t)l * D * INC; K = D; N = INC; perm = 2; }
            else { r -= T_WIN; src = p.w_out + (size_t)l * D * D; dst = p.Wout + (size_t)l * D * D; K = D; N = D; perm = 0; }
            transpose_unit(src, dst, K, N, perm, r, (float*)smem);
        } else if (u < U_TR + U_WS) {
            const int e0 = (u - U_TR) * 4096 + t * 8;
            f32x4 a = *(const f32x4*)(p.w_s_b + e0), b = *(const f32x4*)(p.w_s_b + e0 + 4);
            u32x4 o; o[0] = pk2(a[0], a[1]); o[1] = pk2(a[2], a[3]); o[2] = pk2(b[0], b[1]); o[3] = pk2(b[2], b[3]);
            *(u32x4*)(p.Ws + e0) = o;
        } else if (u < U_TR + U_WS + U_ADA) {
            const int uu = u - U_TR - U_WS, l = uu / 144, col0 = (uu % 144) * 64;
            float* s = (float*)smem;
            float* red = s + 17 * 1024;
            for (int i = t; i < 17 * 1024; i += NTHR) { const int r = i >> 10, k = i & 1023; const float v = r < 16 ? p.c[r * D + k] : p.c_ctx[k]; s[i] = silu_f(v); }
            __syncthreads();
            const int col = t & 63, ks = t >> 6;
            float acc[17];
#pragma unroll
            for (int r = 0; r < 17; ++r) acc[r] = 0.f;
            const float* w = p.w_ada + (size_t)l * D * MODW + (size_t)(ks * 128) * MODW + col0 + col;
            for (int k = 0; k < 128; ++k) {
                const float wv = w[(size_t)k * MODW];
#pragma unroll
                for (int r = 0; r < 17; ++r) acc[r] += s[r * 1024 + ks * 128 + k] * wv;
            }
#pragma unroll
            for (int r = 0; r < 17; ++r) red[(ks * 17 + r) * 64 + col] = acc[r];
            __syncthreads();
            for (int i = t; i < 17 * 64; i += NTHR) {
                const int r = i >> 6, cc = i & 63; float sum = 0.f;
#pragma unroll
                for (int q = 0; q < 8; ++q) sum += red[(q * 17 + r) * 64 + cc];
                p.mods[((size_t)l * 17 + r) * MODW + col0 + cc] = sum + p.b_ada[(size_t)l * MODW + col0 + cc];
            }
            __syncthreads();
        } else {
            const int e = (u - U_TR - U_WS - U_ADA) * 512 + t;
            const int pos = e / 48, j = e % 48, row = pos >> 6, col = pos & 63;
            float ang; float* dst;
            if (j < 32) { const float inv = exp2f(-(float)(j & 15) * (13.287712379549449f / 16.f)); ang = (float)(j < 16 ? row : col) * inv; dst = p.ropeA + ((size_t)pos * 32 + j) * 2; }
            else { const int jj = j - 32; const float inv = exp2f(-(float)(jj & 7) * (13.287712379549449f / 8.f)); ang = (float)(jj < 8 ? row : col) * inv; dst = p.ropeC + ((size_t)pos * 16 + jj) * 2; }
            double sn, cs; sincos_d((double)ang, sn, cs);
            dst[0] = (float)cs; dst[1] = (float)sn;
        }
    }
}

template <bool FINAL>
DI void phase_norm(const Params& p, const float* lat, const float* cx, const float* g, const float* mods_l, int mi, int nrows) {
    const int wid = TID() >> 6, lane = TID() & 63;
    for (int u = blockIdx.x; u < nrows / 8; u += gridDim.x) {
        const int row = u * 8 + wid;
        const float* src = row < NLAT ? lat + (size_t)row * D : cx + (size_t)(row - NLAT) * D;
        const int mb = row < NLAT ? row / SEQ : 16;
        f32x4 v[4]; float ss = 0.f;
#pragma unroll
        for (int i = 0; i < 4; ++i) { v[i] = *(const f32x4*)(src + i * 256 + lane * 4); ss += v[i][0] * v[i][0] + v[i][1] * v[i][1] + v[i][2] * v[i][2] + v[i][3] * v[i][3]; }
        ss = wave_sum(ss);
        const float rstd = rsqrtf(ss * (1.f / D) + EPS);
        if (FINAL) {
#pragma unroll
            for (int i = 0; i < 4; ++i) { const int col = i * 256 + lane * 4; const f32x4 gv = *(const f32x4*)(g + col); *(f32x4*)(p.out + (size_t)row * D + col) = v[i] * rstd * gv; }
        } else {
            const float* sh = mods_l + (size_t)mb * MODW + mi * D; const float* scl = sh + D;
#pragma unroll
            for (int i = 0; i < 4; ++i) {
                const int col = i * 256 + lane * 4;
                const f32x4 gv = *(const f32x4*)(g + col), sv = *(const f32x4*)(scl + col), bv = *(const f32x4*)(sh + col);
                const f32x4 o = v[i] * rstd * gv * (1.f + sv) + bv;
                u32x2 w; w[0] = pk2(o[0], o[1]); w[1] = pk2(o[2], o[3]);
                *(u32x2*)(p.xn + (size_t)row * D + col) = w;
            }
        }
    }
}

constexpr int BM = 256, BK = 64, HALF = 128, HT = HALF * BK, NXCD = 8, WGM = 8;
DI int lds_byte(int r, int c) { const int st = (r >> 4) * 2 + (c >> 5), rr = r & 15, cc = c & 31, ob = rr * 64 + cc * 2; return st * 1024 + (ob ^ (((ob >> 9) & 1) << 5)); }
DI void stage_rc(int b, int& R, int& C) { const int st = b / 1024, sb = b % 1024, swz = sb ^ (((sb >> 9) & 1) << 5); R = (st >> 1) * 16 + swz / 64; C = (st & 1) * 32 + (swz % 64) / 2; }

#define LAS __attribute__((address_space(3)))
constexpr int HTB = HALF * BK * 2;
DI void gemm_tile(const bf16_t* A, const bf16_t* Bt, int K, int brow, int bcol, f32x4 (&acc)[2][2][4][2], LAS unsigned char* lds) {
    const int tid = TID(), wid = __builtin_amdgcn_readfirstlane(tid >> 6), lane = tid & 63, wr = wid >> 2, wc = wid & 3, fr = lane & 15, fq = lane >> 4;
    const int nt = K / BK;
    unsigned voff[2];
#pragma unroll
    for (int i = 0; i < 2; ++i) { int R, C; stage_rc(tid * 16 + i * 8192, R, C); voff[i] = (unsigned)(R * K + C) * 2u; }
    const size_t kstep = (size_t)(BK * 2), hstep = (size_t)HALF * K * 2;
    const unsigned ldsw = (unsigned)wid * 1024u;
    const int aoff = lds_byte(wr * 64 + fr, fq * 8), boff = lds_byte(wc * 32 + fr, fq * 8);
#define SA(b, h) (((b) * 2 + (h)) * HTB)
#define SB(b, h) ((4 + (b) * 2 + (h)) * HTB)
#define STAGE(bufoff, gbase) do { _Pragma("unroll") for (int _i = 0; _i < 2; ++_i) \
        __builtin_amdgcn_global_load_lds((const unsigned*)((const char*)(gbase) + voff[_i]), (LAS unsigned*)(lds + (bufoff) + ldsw + _i * 8192), 16, 0, 0); } while (0)
#define LDA(dst, b, h) do { _Pragma("unroll") for (int m = 0; m < 4; ++m) _Pragma("unroll") for (int k = 0; k < 2; ++k) dst[m][k] = *(const LAS bf16x8*)(lds + SA(b, h) + aoff + m * 2048 + k * 1024); } while (0)
#define LDB(dst, b, h) do { _Pragma("unroll") for (int n = 0; n < 2; ++n) _Pragma("unroll") for (int k = 0; k < 2; ++k) dst[n][k] = *(const LAS bf16x8*)(lds + SB(b, h) + boff + n * 2048 + k * 1024); } while (0)
#define MMA(ai, bj, At_, Bt_) do { __builtin_amdgcn_s_setprio(1); _Pragma("unroll") for (int m = 0; m < 4; ++m) _Pragma("unroll") for (int n = 0; n < 2; ++n) _Pragma("unroll") for (int k = 0; k < 2; ++k) \
        acc[ai][bj][m][n] = __builtin_amdgcn_mfma_f32_16x16x32_bf16(Bt_[n][k], At_[m][k], acc[ai][bj][m][n], 0, 0, 0); __builtin_amdgcn_s_setprio(0); } while (0)
#define WAIT_V(n) asm volatile("s_waitcnt vmcnt(" #n ")" ::: "memory")
#define WAIT_L(n) asm volatile("s_waitcnt lgkmcnt(" #n ")" ::: "memory")
#define BAR __builtin_amdgcn_s_barrier()
#define SCHED __builtin_amdgcn_sched_barrier(0)
#pragma unroll
    for (int a = 0; a < 2; ++a)
#pragma unroll
        for (int b = 0; b < 2; ++b)
#pragma unroll
            for (int m = 0; m < 4; ++m)
#pragma unroll
                for (int n = 0; n < 2; ++n) acc[a][b][m][n] = (f32x4){0.f, 0.f, 0.f, 0.f};
    bf16x8 At[4][2], B0[2][2], B1[2][2];
    const char* cA = (const char*)A + (size_t)brow * K * 2; const char* cB = (const char*)Bt + (size_t)bcol * K * 2;
    STAGE(SB(0, 0), cB); STAGE(SA(0, 0), cA); STAGE(SB(0, 1), cB + hstep); STAGE(SA(0, 1), cA + hstep);
    if (wr == 1) BAR;
    WAIT_V(4); BAR;
    STAGE(SB(1, 0), cB + kstep); STAGE(SA(1, 0), cA + kstep); STAGE(SB(1, 1), cB + hstep + kstep);
    WAIT_V(6); BAR;
    for (int t = 0; t < nt - 2; t += 2) {
        const char* a1 = cA + (size_t)(t + 1) * kstep; const char* a2 = cA + (size_t)(t + 2) * kstep; const char* b2 = cB + (size_t)(t + 2) * kstep;
        const char* a3 = a2 + kstep; const char* b3 = b2 + kstep;
        LDB(B0, 0, 0); SCHED; LDA(At, 0, 0); STAGE(SA(1, 1), a1 + hstep);
        WAIT_L(8); BAR; WAIT_L(0); MMA(0, 0, At, B0); BAR; SCHED;
        LDB(B1, 0, 1); STAGE(SB(0, 0), b2);
        BAR; WAIT_L(0); MMA(0, 1, At, B1); BAR;
        LDA(At, 0, 1); STAGE(SA(0, 0), a2);
        BAR; WAIT_L(0); MMA(1, 0, At, B0); BAR; SCHED;
        STAGE(SB(0, 1), b2 + hstep);
        WAIT_V(6); BAR; MMA(1, 1, At, B1); BAR;
        LDB(B0, 1, 0); SCHED; LDA(At, 1, 0); STAGE(SA(0, 1), a2 + hstep);
        WAIT_L(8); BAR; WAIT_L(0); MMA(0, 0, At, B0); BAR; SCHED;
        LDB(B1, 1, 1); STAGE(SB(1, 0), b3);
        BAR; WAIT_L(0); MMA(0, 1, At, B1); BAR;
        LDA(At, 1, 1); STAGE(SA(1, 0), a3);
        BAR; WAIT_L(0); MMA(1, 0, At, B0); BAR; SCHED;
        STAGE(SB(1, 1), b3 + hstep);
        WAIT_V(6); BAR; MMA(1, 1, At, B1); BAR;
    }
    { LDB(B0, 0, 0); LDA(At, 0, 0); STAGE(SA(1, 1), cA + (size_t)(nt - 1) * kstep + hstep);
      BAR; WAIT_L(0); MMA(0, 0, At, B0); BAR;
      LDB(B1, 0, 1); BAR; WAIT_L(0); MMA(0, 1, At, B1); BAR;
      LDA(At, 0, 1); WAIT_V(4); BAR; WAIT_L(0); MMA(1, 0, At, B0); MMA(1, 1, At, B1); BAR; }
    { LDB(B0, 1, 0); LDA(At, 1, 0); WAIT_V(2); BAR; WAIT_L(0); MMA(0, 0, At, B0); BAR;
      LDB(B1, 1, 1); WAIT_V(0); BAR; WAIT_L(0); MMA(0, 1, At, B1); BAR;
      LDA(At, 1, 1); BAR; WAIT_L(0); MMA(1, 0, At, B0); MMA(1, 1, At, B1); BAR; }
    if (wr == 0) BAR;
}

DI void tile_order(int L, int nM, int nN, int& pm, int& pn) {
    const int nwg = nM * nN; int wgid = L;
    { const int q = nwg / NXCD, r = nwg % NXCD, xcd = wgid % NXCD, off = wgid / NXCD; wgid = (xcd < r ? xcd * (q + 1) : r * (q + 1) + (xcd - r) * q) + off; }
    const int nig = WGM * nN, gid = wgid / nig, fm = gid * WGM, gsz = (nM - fm) < WGM ? (nM - fm) : WGM;
    pm = fm + ((wgid % nig) % gsz); pn = (wgid % nig) / gsz;
}

struct EpiSwiglu {
    bf16_t* hid;
    DI void operator()(f32x4 (&acc)[2][2][4][2], int pm, int pn, char* smem) const {
        const int wid = TID() >> 6, lane = TID() & 63, wr = wid >> 2, wc = wid & 3, fr = lane & 15, fq = lane >> 4;
#pragma unroll
        for (int ai = 0; ai < 2; ++ai)
#pragma unroll
            for (int m = 0; m < 4; ++m) {
                const int row = pm * BM + ai * HALF + wr * 64 + m * 16 + fr;
#pragma unroll
                for (int n = 0; n < 2; ++n) {
                    const f32x4 a = acc[ai][0][m][n], b = acc[ai][1][m][n];
                    u32x2 w; w[0] = pk2(silu_f(a[0]) * b[0], silu_f(a[1]) * b[1]); w[1] = pk2(silu_f(a[2]) * b[2], silu_f(a[3]) * b[3]);
                    *(u32x2*)(hid + (size_t)row * DFF + pn * 128 + wc * 32 + n * 16 + fq * 4) = w;
                }
            }
    }
};
struct EpiResid {
    const float *lat_in, *cx_in; float *lat_out, *cx_out; const float* gate; float gs;
    DI void operator()(f32x4 (&acc)[2][2][4][2], int pm, int pn, char* smem) const {
        const int wid = TID() >> 6, lane = TID() & 63, wr = wid >> 2, wc = wid & 3, fr = lane & 15, fq = lane >> 4;
        const int row0 = pm * BM; const bool islat = row0 < NLAT;
        const size_t base = (size_t)(islat ? row0 : row0 - NLAT) * D + (size_t)(wr * 64 + fr) * D + pn * BM + wc * 32 + fq * 4;
        const float* in = (islat ? lat_in : cx_in) + base;
        float* out = (islat ? lat_out : cx_out) + base;
        const float* gt = gate + (size_t)(islat ? row0 / SEQ : 16) * MODW + pn * BM + wc * 32 + fq * 4;
        f32x4 gv[2][2];
#pragma unroll
        for (int bj = 0; bj < 2; ++bj)
#pragma unroll
            for (int n = 0; n < 2; ++n) gv[bj][n] = *(const f32x4*)(gt + bj * HALF + n * 16) * gs;
#pragma unroll
        for (int ai = 0; ai < 2; ++ai)
#pragma unroll
            for (int m = 0; m < 4; ++m) {
                const size_t ro = (size_t)(ai * HALF + m * 16) * D;
                f32x4 hv[2][2];
#pragma unroll
                for (int bj = 0; bj < 2; ++bj)
#pragma unroll
                    for (int n = 0; n < 2; ++n) hv[bj][n] = *(const f32x4*)(in + ro + bj * HALF + n * 16);
#pragma unroll
                for (int bj = 0; bj < 2; ++bj)
#pragma unroll
                    for (int n = 0; n < 2; ++n) *(f32x4*)(out + ro + bj * HALF + n * 16) = hv[bj][n] + gv[bj][n] * acc[ai][bj][m][n];
                if (m & 1) __builtin_amdgcn_sched_barrier(0);
            }
    }
};
constexpr int TS = 257;
struct EpiProj {
    const Params* pp; int l;
    DI void operator()(f32x4 (&acc)[2][2][4][2], int pm, int pn, char* smem) const {
        const Params& p = *pp;
        float* T = (float*)smem;
        const int tid = TID(), wid = tid >> 6, lane = tid & 63, wr = wid >> 2, wc = wid & 3, fr = lane & 15, fq = lane >> 4;
#pragma unroll
        for (int ai = 0; ai < 2; ++ai) {
            __syncthreads();
#pragma unroll
            for (int bj = 0; bj < 2; ++bj)
#pragma unroll
                for (int m = 0; m < 4; ++m)
#pragma unroll
                    for (int n = 0; n < 2; ++n)
#pragma unroll
                        for (int j = 0; j < 4; ++j) T[(wr * 64 + m * 16 + fr) * TS + bj * HALF + wc * 32 + n * 16 + fq * 4 + j] = acc[ai][bj][m][n][j];
            __syncthreads();
            const int rl = tid & 127, seg = tid >> 7, grow = pm * BM + ai * HALF + rl;
            const bool islat = grow < NLAT;
            const int b = islat ? grow / SEQ : (grow - NLAT) / CTX;
            const int pos = islat ? grow % SEQ : SEQ + (grow - NLAT) % CTX;
            const float* xr = T + rl * TS + seg * 64;
            if (pn == 0 || (pn == 2 && seg < 2)) {
                const float* g = (pn == 0 ? p.g_q_a : p.g_k_a) + l * 64;
                bf16_t* dst = pn == 0 ? p.QA + ((size_t)(b * 4 + seg) * KEYS + pos) * 64 : p.KA + ((size_t)(b * 2 + seg) * KEYS + pos) * 64;
                float ss = 0.f;
                for (int i = 0; i < 64; ++i) ss += xr[i] * xr[i];
                const float rstd = rsqrtf(ss * (1.f / 64.f) + EPS);
                const float* rp = p.ropeA + (size_t)(islat ? pos : 0) * 64;
                for (int i0 = 0; i0 < 32; i0 += 8) {
                    float o1[8], o2[8];
#pragma unroll
                    for (int i = 0; i < 8; ++i) {
                        const float a = xr[i0 + i] * rstd * g[i0 + i], bb = xr[i0 + i + 32] * rstd * g[i0 + i + 32];
                        float cs = 1.f, sn = 0.f;
                        if (islat) { cs = rp[(i0 + i) * 2]; sn = rp[(i0 + i) * 2 + 1]; }
                        o1[i] = a * cs - bb * sn; o2[i] = a * sn + bb * cs;
                    }
                    u32x4 w1, w2;
#pragma unroll
                    for (int i = 0; i < 4; ++i) { w1[i] = pk2(o1[2 * i], o1[2 * i + 1]); w2[i] = pk2(o2[2 * i], o2[2 * i + 1]); }
                    *(u32x4*)(dst + i0) = w1; *(u32x4*)(dst + 32 + i0) = w2;
                }
            } else if (pn == 1 || pn == 3) {
                bf16_t* base = (pn == 1 ? p.QC : p.KC);
                const float* rp = p.ropeC + (size_t)(islat ? pos : 0) * 32;
#pragma unroll
                for (int mp = 0; mp < 2; ++mp) {
                    bf16_t* dst = base + ((size_t)((b * 4 + seg) * 2 + mp) * KEYS + pos) * 32;
                    for (int i0 = 0; i0 < 16; i0 += 8) {
                        float o1[8], o2[8];
#pragma unroll
                        for (int i = 0; i < 8; ++i) {
                            const float a = xr[mp * 32 + i0 + i], bb = xr[mp * 32 + i0 + i + 16];
                            float cs = 1.f, sn = 0.f;
                            if (islat) { cs = rp[(i0 + i) * 2]; sn = rp[(i0 + i) * 2 + 1]; }
                            o1[i] = a * cs - bb * sn; o2[i] = a * sn + bb * cs;
                        }
                        u32x4 w1, w2;
#pragma unroll
                        for (int i = 0; i < 4; ++i) { w1[i] = pk2(o1[2 * i], o1[2 * i + 1]); w2[i] = pk2(o2[2 * i], o2[2 * i + 1]); }
                        *(u32x4*)(dst + i0) = w1; *(u32x4*)(dst + 16 + i0) = w2;
                    }
                }
            } else if (pn == 2 || pn == 4) {
                bf16_t* dst = pn == 2 ? p.VtA + ((size_t)(b * 2 + (seg - 2)) * 64) * KEYS + pos : p.VtC + ((size_t)(b * 4 + seg) * 64) * KEYS + pos;
                for (int d = 0; d < 64; ++d) dst[(size_t)d * KEYS] = f2bf(xr[d]);
            } else if (pn == 5) {
                bf16_t* dst = p.U + (size_t)grow * 256 + seg * 64;
                for (int i0 = 0; i0 < 64; i0 += 8) {
                    u32x4 w;
#pragma unroll
                    for (int i = 0; i < 4; ++i) w[i] = pk2(gelu_f(xr[i0 + 2 * i]), gelu_f(xr[i0 + 2 * i + 1]));
                    *(u32x4*)(dst + i0) = w;
                }
            } else if (pn == 6) {
                const float* xrow = T + rl * TS; float ss = 0.f;
                for (int i = 0; i < 256; ++i) { const float gv = gelu_f(xrow[i]); ss += gv * gv; }
                const float rstd = rsqrtf(ss * (1.f / 256.f) + EPS);
                const float* g = p.g_v_b + l * 256 + seg * 64;
                bf16_t* dst = p.VN + (size_t)grow * 256 + seg * 64;
                for (int i0 = 0; i0 < 64; i0 += 8) {
                    u32x4 w;
#pragma unroll
                    for (int i = 0; i < 4; ++i) w[i] = pk2(gelu_f(xr[i0 + 2 * i]) * rstd * g[i0 + 2 * i], gelu_f(xr[i0 + 2 * i + 1]) * rstd * g[i0 + 2 * i + 1]);
                    *(u32x4*)(dst + i0) = w;
                }
            } else {
                if (seg < 2) {
                    const float* gr = xr + 128;
                    bf16_t* dst = p.Y + (size_t)grow * 256 + (pn - 7) * 128 + seg * 64;
                    for (int i0 = 0; i0 < 64; i0 += 8) {
                        u32x4 w;
#pragma unroll
                        for (int i = 0; i < 4; ++i) w[i] = pk2(xr[i0 + 2 * i] * sigmoid_f(gr[i0 + 2 * i]), xr[i0 + 2 * i + 1] * sigmoid_f(gr[i0 + 2 * i + 1]));
                        *(u32x4*)(dst + i0) = w;
                    }
                }
            }
        }
        __syncthreads();
    }
};

template <class Epi>
DI void phase_gemm(const bf16_t* A, const bf16_t* Bt, int M, int N, int K, const Epi& epi, char* smem) {
    const int nM = M / BM, nN = N / BM, nwg = nM * nN;
    for (int L = blockIdx.x; L < nwg; L += gridDim.x) {
        int pm, pn; tile_order(L, nM, nN, pm, pn);
        f32x4 acc[2][2][4][2];
        gemm_tile(A, Bt, K, pm * BM, pn * BM, acc, (LAS unsigned char*)smem);
        epi(acc, pm, pn, smem);
    }
}

constexpr int VROW = 144;
template <int DQK>
DI void attn_core(const bf16_t* Q, const bf16_t* Kg, const bf16_t* Vt, int qpos0, int key_lo, int nkt, float sc, f32x16 (&O)[2], char* smem) {
    constexpr int KROW = DQK * 2 + 16, KBUF = 64 * KROW, VBUF = 64 * VROW, NKS = DQK / 16;
    char* kb_[2] = {smem, smem + KBUF};
    char* vb_[2] = {smem + 2 * KBUF, smem + 2 * KBUF + VBUF};
    const int tid = TID(), lane = tid & 63, wid = tid >> 6, r = lane & 31, h = lane >> 5;
    bf16x8 qf[NKS];
#pragma unroll
    for (int ks = 0; ks < NKS; ++ks) qf[ks] = *(const bf16x8*)(Q + (size_t)(qpos0 + wid * 32 + r) * DQK + ks * 16 + 8 * h);
#pragma unroll
    for (int i = 0; i < 16; ++i) { O[0][i] = 0.f; O[1][i] = 0.f; }
    float m_run = -1e30f, l_run = 0.f;
    constexpr int KCH = DQK / 8;
    const bool kact = tid < 64 * KCH;
    const int kkey = tid / KCH, kch = tid % KCH, vd = tid >> 3, vch = tid & 7;
    u32x4 kreg = {0, 0, 0, 0}, vreg;
    auto gload = [&](int t) {
        const int key0 = key_lo + t * 64;
        if (kact) kreg = *(const u32x4*)(Kg + (size_t)(key0 + kkey) * DQK + kch * 8);
        vreg = *(const u32x4*)(Vt + (size_t)vd * KEYS + key0 + vch * 8);
    };
    auto lstore = [&](int bsel) {
        if (kact) *(u32x4*)(kb_[bsel] + kkey * KROW + kch * 16) = kreg;
        *(u32x4*)(vb_[bsel] + vd * VROW + vch * 16) = vreg;
    };
    __syncthreads();
    gload(0); lstore(0);
    __syncthreads();
    for (int t = 0; t < nkt; ++t) {
        const int cur = t & 1;
        if (t + 1 < nkt) gload(t + 1);
        const char* kb = kb_[cur]; const char* vb = vb_[cur];
#pragma unroll
        for (int kk = 0; kk < 2; ++kk) {
            f32x16 s;
#pragma unroll
            for (int i = 0; i < 16; ++i) s[i] = 0.f;
#pragma unroll
            for (int ks = 0; ks < NKS; ++ks) {
                const bf16x8 kf = *(const bf16x8*)(kb + (kk * 32 + r) * KROW + ks * 32 + 16 * h);
                s = __builtin_amdgcn_mfma_f32_32x32x16_bf16(kf, qf[ks], s, 0, 0, 0);
            }
            float mx = s[0];
#pragma unroll
            for (int i = 1; i < 16; ++i) mx = fmaxf(mx, s[i]);
            mx = fmaxf(mx, __shfl_xor(mx, 32));
            const float m_new = fmaxf(m_run, mx * sc);
            const float alpha = __builtin_amdgcn_exp2f(m_run - m_new);
            m_run = m_new;
            float ps = 0.f;
#pragma unroll
            for (int i = 0; i < 16; ++i) { s[i] = __builtin_amdgcn_exp2f(s[i] * sc - m_new); ps += s[i]; }
            l_run = l_run * alpha + ps;
#pragma unroll
            for (int i = 0; i < 16; ++i) { O[0][i] *= alpha; O[1][i] *= alpha; }
#pragma unroll
            for (int st = 0; st < 2; ++st) {
                u32x4 pw;
#pragma unroll
                for (int i = 0; i < 4; ++i) pw[i] = pk2(s[8 * st + 2 * i], s[8 * st + 2 * i + 1]);
                const bf16x8 pf = __builtin_bit_cast(bf16x8, pw);
#pragma unroll
                for (int dt = 0; dt < 2; ++dt) {
                    const char* vp = vb + (dt * 32 + r) * VROW + (kk * 32 + 16 * st + 4 * h) * 2;
                    const u32x2 lo = *(const u32x2*)vp, hi = *(const u32x2*)(vp + 16);
                    u32x4 vw = {lo[0], lo[1], hi[0], hi[1]};
                    O[dt] = __builtin_amdgcn_mfma_f32_32x32x16_bf16(__builtin_bit_cast(bf16x8, vw), pf, O[dt], 0, 0, 0);
                }
            }
        }
        if (t + 1 < nkt) lstore(cur ^ 1);
        __syncthreads();
    }
    const float lt = l_run + __shfl_xor(l_run, 32);
    const float inv = 1.f / lt;
#pragma unroll
    for (int i = 0; i < 16; ++i) { O[0][i] *= inv; O[1][i] *= inv; }
}

DI void store_OT(const f32x16 (&O)[2], bf16_t* dst  , int h) {
#pragma unroll
    for (int dt = 0; dt < 2; ++dt)
#pragma unroll
        for (int gq = 0; gq < 4; ++gq) {
            u32x2 w; w[0] = pk2(O[dt][4 * gq], O[dt][4 * gq + 1]); w[1] = pk2(O[dt][4 * gq + 2], O[dt][4 * gq + 3]);
            *(u32x2*)(dst + dt * 32 + 8 * gq + 4 * h) = w;
        }
}

DI void attn_unit(const Params& p, int l, int uidx, bool isC, int nqb, char* smem) {
    const int qb = uidx % nqb, bh = uidx / nqb, head = bh & 3, b = bh >> 2;
    const int lane = TID() & 63, wid = TID() >> 6, r = lane & 31, h = lane >> 5;
    const int qpos0 = qb < 8 ? qb * 256 : SEQ, key_lo = qb < 8 ? 0 : SEQ, nkt = qb < 8 ? KEYS / 64 : CTX / 64;
    const int qpos = qpos0 + wid * 32 + r;
    const size_t grow = qpos < SEQ ? (size_t)b * SEQ + qpos : (size_t)NLAT + b * CTX + (qpos - SEQ);
    if (!isC) {
        f32x16 O[2];
        attn_core<64>(p.QA + (size_t)(b * 4 + head) * KEYS * 64, p.KA + (size_t)(b * 2 + (head >> 1)) * KEYS * 64, p.VtA + (size_t)(b * 2 + (head >> 1)) * 64 * KEYS,
                      qpos0, key_lo, nkt, 0.125f * 1.4426950408889634f, O, smem);
        store_OT(O, p.cat + grow * D + head * 64, h);
    } else {
        const float lam_init = 0.8f - 0.6f * __expf(-0.3f * (float)l);
        float d0 = 0.f, d1 = 0.f;
        const float* lp = p.lam_c + l * 128;
        for (int i = 0; i < 32; ++i) { d0 += lp[i] * lp[32 + i]; d1 += lp[64 + i] * lp[96 + i]; }
        const float lam = __expf(d0) - __expf(d1) + lam_init;
        const bf16_t* Vt = p.VtC + (size_t)(b * 4 + head) * 64 * KEYS;
        f32x16 O0[2], O1[2];
        attn_core<32>(p.QC + (size_t)((b * 4 + head) * 2 + 0) * KEYS * 32, p.KC + (size_t)((b * 4 + head) * 2 + 0) * KEYS * 32, Vt, qpos0, key_lo, nkt,
                      0.17677669529663687f * 1.4426950408889634f, O0, smem);
        attn_core<32>(p.QC + (size_t)((b * 4 + head) * 2 + 1) * KEYS * 32, p.KC + (size_t)((b * 4 + head) * 2 + 1) * KEYS * 32, Vt, qpos0, key_lo, nkt,
                      0.17677669529663687f * 1.4426950408889634f, O1, smem);
        float ss = 0.f;
#pragma unroll
        for (int dt = 0; dt < 2; ++dt)
#pragma unroll
            for (int i = 0; i < 16; ++i) { const float v = O0[dt][i] - lam * O1[dt][i]; O0[dt][i] = v; ss += v * v; }
        ss += __shfl_xor(ss, 32);
        const float rstd = rsqrtf(ss * (1.f / 64.f) + EPS) * (1.f - lam_init);
        const float* g = p.g_sub_c + l * 64;
#pragma unroll
        for (int dt = 0; dt < 2; ++dt)
#pragma unroll
            for (int i = 0; i < 16; ++i) O0[dt][i] *= rstd * g[dt * 32 + 8 * (i >> 2) + 4 * h + (i & 3)];
        store_OT(O0, p.cat + grow * D + 256 + head * 64, h);
    }
}

DI void gmlp_unit(const Params& p, int l, int uidx, char* smem) {
    const int g = uidx & 3, c = uidx >> 2, tid = TID(), lane = tid & 63, wid = tid >> 6, fr = lane & 15, fq = lane >> 4;
    bf16_t* vT = (bf16_t*)smem;
    constexpr int VS = 136;
    __syncthreads();
    {
        const int q = tid >> 2, d0 = (tid & 3) * 16;
        const bf16_t* src = p.VN + (size_t)(c * 128 + q) * 256 + g * 64 + d0;
        const bf16x8 a = *(const bf16x8*)src, bb = *(const bf16x8*)(src + 8);
#pragma unroll
        for (int j = 0; j < 8; ++j) { vT[(d0 + j) * VS + q] = (bf16_t)a[j]; vT[(d0 + 8 + j) * VS + q] = (bf16_t)bb[j]; }
    }
    __syncthreads();
    f32x4 acc[4];
#pragma unroll
    for (int n = 0; n < 4; ++n) acc[n] = (f32x4){0.f, 0.f, 0.f, 0.f};
    const bf16_t* wrow = p.Ws + ((size_t)(l * 4 + g) * 128 + wid * 16 + fr) * 128;
#pragma unroll
    for (int ks = 0; ks < 4; ++ks) {
        const bf16x8 af = *(const bf16x8*)(wrow + ks * 32 + fq * 8);
#pragma unroll
        for (int n = 0; n < 4; ++n) {
            const bf16x8 bfv = *(const bf16x8*)(vT + (n * 16 + fr) * VS + ks * 32 + fq * 8);
            acc[n] = __builtin_amdgcn_mfma_f32_16x16x32_bf16(bfv, af, acc[n], 0, 0, 0);
        }
    }
    const int prow = wid * 16 + fr; const size_t grow = (size_t)c * 128 + prow;
    const float bias = p.b_s_b[(l * 4 + g) * 128 + prow];
#pragma unroll
    for (int n = 0; n < 4; ++n) {
        const int col = g * 64 + n * 16 + fq * 4;
        const u32x2 uu = *(const u32x2*)(p.U + grow * 256 + col);
        u32x2 w;
        w[0] = pk2(bflo(uu[0]) * (acc[n][0] + bias), bfhi(uu[0]) * (acc[n][1] + bias));
        w[1] = pk2(bflo(uu[1]) * (acc[n][2] + bias), bfhi(uu[1]) * (acc[n][3] + bias));
        *(u32x2*)(p.cat + grow * D + 512 + col) = w;
    }
}

DI void conv_unit(const Params& p, int l, int uidx, char* smem) {
    const int tid = TID(), lane = tid & 63, wid = tid >> 6;
    bf16_t* yin = (bf16_t*)smem;
    float* co = (float*)(smem + 94 * 256 * 2);
    const int row0 = uidx * 64;
    int s0, s1;
    if (row0 < NLAT) { s0 = (row0 / SEQ) * SEQ; s1 = s0 + SEQ; } else { s0 = NLAT + ((row0 - NLAT) / CTX) * CTX; s1 = s0 + CTX; }
    __syncthreads();
    for (int i = tid; i < 94 * 32; i += NTHR) {
        const int rr = i >> 5, ch8 = (i & 31) * 8, gr = row0 - 15 + rr;
        u32x4 v = {0, 0, 0, 0};
        if (gr >= s0 && gr < s1) v = *(const u32x4*)(p.Y + (size_t)gr * 256 + ch8);
        *(u32x4*)(yin + rr * 256 + ch8) = v;
    }
    __syncthreads();
    {
        const int ch = tid & 255, th = tid >> 8;
        float w[31];
#pragma unroll
        for (int k = 0; k < 31; ++k) w[k] = p.w_dw_d[(size_t)(l * 31 + k) * 256 + ch];
        const float bias = p.b_dw_d[l * 256 + ch];
        for (int i = th * 32; i < th * 32 + 32; ++i) {
            float a = bias;
#pragma unroll
            for (int k = 0; k < 31; ++k) a += w[k] * bf2f(yin[(i + k) * 256 + ch]);
            co[i * 256 + ch] = a;
        }
    }
    __syncthreads();
#pragma unroll
    for (int j = 0; j < 8; ++j) {
        const int tk = wid * 8 + j;
        const f32x4 v = *(const f32x4*)(co + tk * 256 + lane * 4);
        const float ss = wave_sum(v[0] * v[0] + v[1] * v[1] + v[2] * v[2] + v[3] * v[3]);
        const float rstd = rsqrtf(ss * (1.f / 256.f) + EPS);
        const f32x4 g = *(const f32x4*)(p.g_conv_d + l * 256 + lane * 4);
        u32x2 w; w[0] = pk2(silu_f(v[0] * rstd * g[0]), silu_f(v[1] * rstd * g[1])); w[1] = pk2(silu_f(v[2] * rstd * g[2]), silu_f(v[3] * rstd * g[3]));
        *(u32x2*)(p.cat + (size_t)(row0 + tk) * D + 768 + lane * 4) = w;
    }
}

DI void phase_mixers(const Params& p, int l, bool withctx, char* smem) {
    const int nqb = withctx ? 9 : 8;
    const int nC = NB * 4 * nqb, nA = nC, nG = (withctx ? NTOK : NLAT) / 128 * 4, nV = (withctx ? NTOK : NLAT) / 64;
    const int total = nC + nA + nG + nV;
    for (int u = blockIdx.x; u < total; u += gridDim.x) {
        asm volatile("" : "+s"(l));
        if (u < nC) attn_unit(p, l, u, true, nqb, smem);
        else if (u < nC + nA) attn_unit(p, l, u - nC, false, nqb, smem);
        else if (u < nC + nA + nG) gmlp_unit(p, l, u - nC - nA, smem);
        else conv_unit(p, l, u - nC - nA - nG, smem);
    }
}

constexpr int PH_PER_LAYER = 10, N_PHASES = 1 + DEPTH * PH_PER_LAYER + 1;

typedef const __attribute__((address_space(4))) Params* KParamsPtr;
__global__ void __launch_bounds__(NTHR) mega(Params p_unused, int ph_lo, int ph_hi) {
    extern __shared__ __attribute__((aligned(16))) char smem[];
    for (int ph = ph_lo; ph < ph_hi; ++ph) {
        if (ph > ph_lo) cg::this_grid().sync();
        KParamsPtr kp = (KParamsPtr)__builtin_amdgcn_kernarg_segment_ptr();
        asm volatile("" : "+s"(kp));
        const Params& p = *(const Params*)kp;
        if (ph == 0) { phase_prologue(p, smem); continue; }
        if (ph == N_PHASES - 1) { phase_norm<true>(p, p.out, p.hc, p.g_final, nullptr, 0, NLAT); continue; }
        const int l = (ph - 1) / PH_PER_LAYER, s = (ph - 1) % PH_PER_LAYER;
        const bool last = l == DEPTH - 1;
        const float* mods_l = p.mods + (size_t)l * 17 * MODW;
        const bool first = (l == 0 && s <= 2);
        const float* lat_in = first ? p.x : p.out;
        const float* cx_in = first ? p.ctx : p.hc;
        if (s == 0 || s == 3 || s == 7) {
            const int j = s == 0 ? 0 : (s == 3 ? 1 : 2);
            phase_norm<false>(p, lat_in, cx_in, p.g_norm + (l * 3 + j) * D, mods_l, 3 * j, (s == 7 && last) ? NLAT : NTOK);
        } else if (s == 1 || s == 8) {
            EpiSwiglu e{p.hid};
            phase_gemm(p.xn, (s == 1 ? p.Wff1in : p.Wff2in) + (size_t)l * D * 2 * DFF, (s == 8 && last) ? NLAT : NTOK, 2 * DFF, D, e, smem);
        } else if (s == 2 || s == 6 || s == 9) {
            const bf16_t* A = s == 6 ? p.cat : p.hid;
            const bf16_t* Bt = s == 2 ? p.Wff1out + (size_t)l * D * DFF : (s == 9 ? p.Wff2out + (size_t)l * D * DFF : p.Wout + (size_t)l * D * D);
            const int K = s == 6 ? D : DFF, gi = s == 2 ? 2 : (s == 6 ? 5 : 8);
            EpiResid e{lat_in, cx_in, p.out, p.hc, mods_l + gi * D, s == 6 ? 1.0f : 0.5f};
            phase_gemm(A, Bt, (s != 2 && last) ? NLAT : NTOK, D, K, e, smem);
        } else if (s == 4) {
            EpiProj e{&p, l}; phase_gemm(p.xn, p.Win + (size_t)l * D * INC, NTOK, INC, D, e, smem);
        } else {
            phase_mixers(p, l, !last, smem);
        }
    }
}

extern "C" void kernel_launch(void* const* d_in, const int* in_sizes, int n_in, void* d_out, int out_size, void* d_ws, size_t ws_size, hipStream_t stream) {
    static int grid = 0;
    if (grid == 0) {
        int dev = 0, cus = 0, per_cu = 0;
        hipGetDevice(&dev);
        hipDeviceGetAttribute(&cus, hipDeviceAttributeMultiprocessorCount, dev);
        if (hipFuncSetAttribute((const void*)mega, hipFuncAttributeMaxDynamicSharedMemorySize, LDS_BYTES) != hipSuccess) fprintf(stderr, "hipFuncSetAttribute failed\n");
        if (hipOccupancyMaxActiveBlocksPerMultiprocessor(&per_cu, (const void*)mega, NTHR, LDS_BYTES) != hipSuccess || per_cu < 1) { fprintf(stderr, "occupancy query: %d\n", per_cu); per_cu = 1; }
        (void)hipGetLastError();
        grid = cus * per_cu;
        fprintf(stderr, "grid = %d (cus %d per_cu %d) ws_size %zu\n", grid, cus, per_cu, ws_size);
    }
    Params p{};
    const float** pin = (const float**)&p;
    for (int i = 0; i < 24; ++i) pin[i] = (const float*)d_in[i];
    p.out = (float*)d_out;
    char* w = (char*)d_ws; size_t off = 0;
    auto take = [&](size_t bytes) { char* r = w + off; off += (bytes + 255) & ~(size_t)255; return r; };
    p.Wff1in = (bf16_t*)take((size_t)DEPTH * D * 2 * DFF * 2);
    p.Wff1out = (bf16_t*)take((size_t)DEPTH * D * DFF * 2);
    p.Wff2in = (bf16_t*)take((size_t)DEPTH * D * 2 * DFF * 2);
    p.Wff2out = (bf16_t*)take((size_t)DEPTH * D * DFF * 2);
    p.Win = (bf16_t*)take((size_t)DEPTH * D * INC * 2);
    p.Wout = (bf16_t*)take((size_t)DEPTH * D * D * 2);
    p.Ws = (bf16_t*)take((size_t)DEPTH * 4 * 128 * 128 * 2);
    p.mods = (float*)take((size_t)DEPTH * 17 * MODW * 4);
    p.ropeA = (float*)take((size_t)SEQ * 32 * 2 * 4);
    p.ropeC = (float*)take((size_t)SEQ * 16 * 2 * 4);
    p.hc = (float*)take((size_t)NCTX * D * 4);
    p.xn = (bf16_t*)take((size_t)NTOK * D * 2);
    p.cat = p.xn;
    p.hid = (bf16_t*)take((size_t)NTOK * DFF * 2);
    {
        char* q = (char*)p.hid; size_t o2 = 0;
        auto take2 = [&](size_t bytes) { char* r = q + o2; o2 += (bytes + 255) & ~(size_t)255; return r; };
        p.QA = (bf16_t*)take2((size_t)NB * 4 * KEYS * 64 * 2);
        p.KA = (bf16_t*)take2((size_t)NB * 2 * KEYS * 64 * 2);
        p.VtA = (bf16_t*)take2((size_t)NB * 2 * 64 * KEYS * 2);
        p.QC = (bf16_t*)take2((size_t)NB * 4 * 2 * KEYS * 32 * 2);
        p.KC = (bf16_t*)take2((size_t)NB * 4 * 2 * KEYS * 32 * 2);
        p.VtC = (bf16_t*)take2((size_t)NB * 4 * 64 * KEYS * 2);
        p.U = (bf16_t*)take2((size_t)NTOK * 256 * 2);
        p.VN = (bf16_t*)take2((size_t)NTOK * 256 * 2);
        p.Y = (bf16_t*)take2((size_t)NTOK * 256 * 2);
    }
    if (off > ws_size) { fprintf(stderr, "workspace too small: need %zu have %zu\n", off, ws_size); return; }
#if N_LAUNCH_MODE == 1
    int lo = 0, hi = N_PHASES;
    void* args[] = {&p, &lo, &hi};
    hipError_t e = hipLaunchCooperativeKernel((const void*)mega, dim3(grid), dim3(NTHR), args, LDS_BYTES, stream);
    if (e != hipSuccess) fprintf(stderr, "cooperative launch failed: %s (grid %d)\n", hipGetErrorString(e), grid);
#else
    for (int ph = 0; ph < N_PHASES; ++ph) hipLaunchKernelGGL(mega, dim3(grid), dim3(NTHR), LDS_BYTES, stream, p, ph, ph + 1);
#endif
}
```

```cpp
#include <hip/hip_runtime.h>
#include <hip/hip_cooperative_groups.h>
#include <cstdint>
#include <cstdio>
#include <cmath>
namespace cg = cooperative_groups;

#ifndef N_LAUNCH_MODE
#define N_LAUNCH_MODE 1
#endif

typedef unsigned short bf16_t;
typedef short bf16x8 __attribute__((ext_vector_type(8)));
typedef short s16x4 __attribute__((ext_vector_type(4)));
typedef float f32x4 __attribute__((ext_vector_type(4)));
typedef float f32x2 __attribute__((ext_vector_type(2)));
typedef float f32x16 __attribute__((ext_vector_type(16)));
typedef unsigned u32x2 __attribute__((ext_vector_type(2)));
typedef unsigned u32x4 __attribute__((ext_vector_type(4)));
typedef __bf16 bf2_t __attribute__((ext_vector_type(2)));
#define DI __device__ __forceinline__

constexpr int D = 1024, NB = 16, SEQ = 2048, CTX = 256, NLAT = NB * SEQ, NCTX = NB * CTX, NTOK = NLAT + NCTX;
constexpr int DFF = 2816, INC = 2304, KEYS = SEQ + CTX, DEPTH = 2, MODW = 9 * D;
constexpr int NTHR = 512;
constexpr int LDS_BYTES = 135168;
constexpr float EPS = 1e-6f;

DI unsigned pk2(float a, float b) { f32x2 v = {a, b}; bf2_t r = __builtin_convertvector(v, bf2_t); return __builtin_bit_cast(unsigned, r); }
DI float bf2f(bf16_t v) { return __uint_as_float(((unsigned)v) << 16); }
DI float bflo(unsigned v) { return __uint_as_float(v << 16); }
DI float bfhi(unsigned v) { return __uint_as_float(v & 0xffff0000u); }
DI bf16_t f2bf(float a) { return (bf16_t)(pk2(a, 0.f) & 0xffffu); }
DI float silu_f(float x) { return x / (1.f + __expf(-x)); }
DI float sigmoid_f(float x) { return 1.f / (1.f + __expf(-x)); }
DI float gelu_f(float x) { float u = 1.5957691216057308f * (x + 0.044715f * x * x * x); return x / (1.f + __expf(-u)); }
DI int TID() { int t = __builtin_amdgcn_workitem_id_x(); asm volatile("" : "+v"(t)); return t; }
DI float wave_sum(float v) {
#pragma unroll
    for (int o = 32; o >= 1; o >>= 1) v += __shfl_xor(v, o);
    return v;
}

struct Params {
    const float *x, *c, *ctx, *c_ctx, *w_ada, *b_ada, *g_norm, *w_ff1_in, *w_ff1_out, *w_ff2_in, *w_ff2_out, *w_in, *w_out, *g_q_a, *g_k_a, *lam_c,
        *g_sub_c, *g_v_b, *w_s_b, *b_s_b, *w_dw_d, *b_dw_d, *g_conv_d, *g_final;
    float* out;
    bf16_t *Wff1in, *Wff1out, *Wff2in, *Wff2out, *Win, *Wout, *Ws;
    float *mods, *ropeA, *ropeC, *hc;
    bf16_t *xn, *hid, *QA, *KA, *VtA, *QC, *KC, *VtC, *U, *VN, *Y, *cat;
};

DI void sincos_d(double x, double& s, double& c) {
    double k = rint(x * 0.15915494309189535);
    double r = fma(-k, 6.283185307179586, x);
    r = fma(-k, 2.4492935982947064e-16, r);
    double r2 = r * r, as = 1.0, ac = 1.0;
#pragma unroll
    for (int n = 14; n >= 1; --n) {
        as = 1.0 - r2 / (double)((2 * n) * (2 * n + 1)) * as;
        ac = 1.0 - r2 / (double)((2 * n - 1) * (2 * n)) * ac;
    }
    s = r * as; c = ac;
}

constexpr int T_FFIN = (D / 64) * (2 * DFF / 64), T_FFOUT = (DFF / 64) * (D / 64), T_WIN = (D / 64) * (INC / 64), T_WOUT = (D / 64) * (D / 64);
constexpr int T_LAYER = 2 * T_FFIN + 2 * T_FFOUT + T_WIN + T_WOUT;
constexpr int U_TR = DEPTH * T_LAYER, U_WS = 32, U_ADA = 288, U_ROPE = 192;
constexpr int U_P0 = U_TR + U_WS + U_ADA + U_ROPE;

DI void transpose_unit(const float* src, bf16_t* dst, int K, int N, int perm, int ti, float* tile) {
    const int tn = N / 64, kt = ti / tn, nt = ti % tn, k0 = kt * 64, n0 = nt * 64;
    int sc0 = n0;
    if (perm == 1) { int t = n0 >> 8, j = n0 & 255; sc0 = j < 128 ? t * 128 + j : DFF + t * 128 + (j - 128); }
    else if (perm == 2 && n0 >= 1792) { int m = n0 - 1792, t = m >> 8, j = m & 255; sc0 = j < 128 ? 1792 + t * 128 + j : 2048 + t * 128 + (j - 128); }
    const int t = TID();
    {
        const int kk = t >> 4, c4 = (t & 15) * 4;
#pragma unroll
        for (int i = 0; i < 2; ++i) {
            const int k = kk + 32 * i;
            f32x4 v = *(const f32x4*)(src + (size_t)(k0 + k) * N + sc0 + c4);
            tile[k * 65 + c4 + 0] = v[0]; tile[k * 65 + c4 + 1] = v[1]; tile[k * 65 + c4 + 2] = v[2]; tile[k * 65 + c4 + 3] = v[3];
        }
    }
    __syncthreads();
    {
        const int n = t >> 3, k8 = (t & 7) * 8;
        u32x4 o;
        o[0] = pk2(tile[(k8 + 0) * 65 + n], tile[(k8 + 1) * 65 + n]);
        o[1] = pk2(tile[(k8 + 2) * 65 + n], tile[(k8 + 3) * 65 + n]);
        o[2] = pk2(tile[(k8 + 4) * 65 + n], tile[(k8 + 5) * 65 + n]);
        o[3] = pk2(tile[(k8 + 6) * 65 + n], tile[(k8 + 7) * 65 + n]);
        *(u32x4*)(dst + (size_t)(n0 + n) * K + k0 + k8) = o;
    }
    __syncthreads();
}

DI void phase_prologue(const Params& p, char* smem) {
    const int t = TID();
    for (int u = blockIdx.x; u < U_P0; u += gridDim.x) {
        if (u < U_TR) {
            const int l = u / T_LAYER; int r = u % T_LAYER;
            const float* src; bf16_t* dst; int K, N, perm;
            if (r < T_FFIN) { src = p.w_ff1_in + (size_t)l * D * 2 * DFF; dst = p.Wff1in + (size_t)l * D * 2 * DFF; K = D; N = 2 * DFF; perm = 1; }
            else if ((r -= T_FFIN) < T_FFOUT) { src = p.w_ff1_out + (size_t)l * D * DFF; dst = p.Wff1out + (size_t)l * D * DFF; K = DFF; N = D; perm = 0; }
            else if ((r -= T_FFOUT) < T_FFIN) { src = p.w_ff2_in + (size_t)l * D * 2 * DFF; dst = p.Wff2in + (size_t)l * D * 2 * DFF; K = D; N = 2 * DFF; perm = 1; }
            else if ((r -= T_FFIN) < T_FFOUT) { src = p.w_ff2_out + (size_t)l * D * DFF; dst = p.Wff2out + (size_t)l * D * DFF; K = DFF; N = D; perm = 0; }
            else if ((r -= T_FFOUT) < T_WIN) { src = p.w_in + (size_t)l * D * INC; dst = p.Win + (size_t)l * D * INC; K = D; N = INC; perm = 2; }
            else { r -= T_WIN; src = p.w_out + (size_t)l * D * D; dst = p.Wout + (size_t)l * D * D; K = D; N = D; perm = 0; }
            transpose_unit(src, dst, K, N, perm, r, (float*)smem);
        } else if (u < U_TR + U_WS) {
            const int e0 = (u - U_TR) * 4096 + t * 8;
            f32x4 a = *(const f32x4*)(p.w_s_b + e0), b = *(const f32x4*)(p.w_s_b + e0 + 4);
            u32x4 o; o[0] = pk2(a[0], a[1]); o[1] = pk2(a[2], a[3]); o[2] = pk2(b[0], b[1]); o[3] = pk2(b[2], b[3]);
            *(u32x4*)(p.Ws + e0) = o;
        } else if (u < U_TR + U_WS + U_ADA) {
            const int uu = u - U_TR - U_WS, l = uu / 144, col0 = (uu % 144) * 64;
            float* s = (float*)smem;
            float* red = s + 17 * 1024;
            for (int i = t; i < 17 * 1024; i += NTHR) { const int r = i >> 10, k = i & 1023; const float v = r < 16 ? p.c[r * D + k] : p.c_ctx[k]; s[i] = silu_f(v); }
            __syncthreads();
            const int col = t & 63, ks = t >> 6;
            float acc[17];
#pragma unroll
            for (int r = 0; r < 17; ++r) acc[r] = 0.f;
            const float* w = p.w_ada + (size_t)l * D * MODW + (size_t)(ks * 128) * MODW + col0 + col;
            for (int k = 0; k < 128; ++k) {
                const float wv = w[(size_t)k * MODW];
#pragma unroll
                for (int r = 0; r < 17; ++r) acc[r] += s[r * 1024 + ks * 128 + k] * wv;
            }
#pragma unroll
            for (int r = 0; r < 17; ++r) red[(ks * 17 + r) * 64 + col] = acc[r];
            __syncthreads();
            for (int i = t; i < 17 * 64; i += NTHR) {
                const int r = i >> 6, cc = i & 63; float sum = 0.f;
#pragma unroll
                for (int q = 0; q < 8; ++q) sum += red[(q * 17 + r) * 64 + cc];
                p.mods[((size_t)l * 17 + r) * MODW + col0 + cc] = sum + p.b_ada[(size_t)l * MODW + col0 + cc];
            }
            __syncthreads();
        } else {
            const int e = (u - U_TR - U_WS - U_ADA) * 512 + t;
            const int pos = e / 48, j = e % 48, row = pos >> 6, col = pos & 63;
            float ang; float* dst;
            if (j < 32) { const float inv = exp2f(-(float)(j & 15) * (13.287712379549449f / 16.f)); ang = (float)(j < 16 ? row : col) * inv; dst = p.ropeA + ((size_t)pos * 32 + j) * 2; }
            else { const int jj = j - 32; const float inv = exp2f(-(float)(jj & 7) * (13.287712379549449f / 8.f)); ang = (float)(jj < 8 ? row : col) * inv; dst = p.ropeC + ((size_t)pos * 16 + jj) * 2; }
            double sn, cs; sincos_d((double)ang, sn, cs);
            dst[0] = (float)cs; dst[1] = (float)sn;
        }
    }
}

template <bool FINAL>
DI void phase_norm(const Params& p, const float* lat, const float* cx, const float* g, const float* mods_l, int mi, int nrows) {
    const int wid = TID() >> 6, lane = TID() & 63;
    for (int u = blockIdx.x; u < nrows / 8; u += gridDim.x) {
        const int row = u * 8 + wid;
        const float* src = row < NLAT ? lat + (size_t)row * D : cx + (size_t)(row - NLAT) * D;
        const int mb = row < NLAT ? row / SEQ : 16;
        f32x4 v[4]; float ss = 0.f;
#pragma unroll
        for (int i = 0; i < 4; ++i) { v[i] = *(const f32x4*)(src + i * 256 + lane * 4); ss += v[i][0] * v[i][0] + v[i][1] * v[i][1] + v[i][2] * v[i][2] + v[i][3] * v[i][3]; }
        ss = wave_sum(ss);
        const float rstd = rsqrtf(ss * (1.f / D) + EPS);
        if (FINAL) {
#pragma unroll
            for (int i = 0; i < 4; ++i) { const int col = i * 256 + lane * 4; const f32x4 gv = *(const f32x4*)(g + col); *(f32x4*)(p.out + (size_t)row * D + col) = v[i] * rstd * gv; }
        } else {
            const float* sh = mods_l + (size_t)mb * MODW + mi * D; const float* scl = sh + D;
#pragma unroll
            for (int i = 0; i < 4; ++i) {
                const int col = i * 256 + lane * 4;
                const f32x4 gv = *(const f32x4*)(g + col), sv = *(const f32x4*)(scl + col), bv = *(const f32x4*)(sh + col);
                const f32x4 o = v[i] * rstd * gv * (1.f + sv) + bv;
                u32x2 w; w[0] = pk2(o[0], o[1]); w[1] = pk2(o[2], o[3]);
                *(u32x2*)(p.xn + (size_t)row * D + col) = w;
            }
        }
    }
}

constexpr int BM = 256, BK = 64, HALF = 128, HT = HALF * BK, NXCD = 8, WGM = 8;
DI int lds_byte(int r, int c) { const int st = (r >> 4) * 2 + (c >> 5), rr = r & 15, cc = c & 31, ob = rr * 64 + cc * 2; return st * 1024 + (ob ^ (((ob >> 9) & 1) << 5)); }
DI void stage_rc(int b, int& R, int& C) { const int st = b / 1024, sb = b % 1024, swz = sb ^ (((sb >> 9) & 1) << 5); R = (st >> 1) * 16 + swz / 64; C = (st & 1) * 32 + (swz % 64) / 2; }

#define LAS __attribute__((address_space(3)))
constexpr int HTB = HALF * BK * 2;
DI void gemm_tile(const bf16_t* A, const bf16_t* Bt, int K, int brow, int bcol, f32x4 (&acc)[2][2][4][2], LAS unsigned char* lds) {
    const int tid = TID(), wid = __builtin_amdgcn_readfirstlane(tid >> 6), lane = tid & 63, wr = wid >> 2, wc = wid & 3, fr = lane & 15, fq = lane >> 4;
    const int nt = K / BK;
    unsigned voff[2];
#pragma unroll
    for (int i = 0; i < 2; ++i) { int R, C; stage_rc(tid * 16 + i * 8192, R, C); voff[i] = (unsigned)(R * K + C) * 2u; }
    const size_t kstep = (size_t)(BK * 2), hstep = (size_t)HALF * K * 2;
    const unsigned ldsw = (unsigned)wid * 1024u;
    const int aoff = lds_byte(wr * 64 + fr, fq * 8), boff = lds_byte(wc * 32 + fr, fq * 8);
#define SA(b, h) (((b) * 2 + (h)) * HTB)
#define SB(b, h) ((4 + (b) * 2 + (h)) * HTB)
#define STAGE(bufoff, gbase) do { _Pragma("unroll") for (int _i = 0; _i < 2; ++_i) \
        __builtin_amdgcn_global_load_lds((const unsigned*)((const char*)(gbase) + voff[_i]), (LAS unsigned*)(lds + (bufoff) + ldsw + _i * 8192), 16, 0, 0); } while (0)
#define LDA(dst, b, h) do { _Pragma("unroll") for (int m = 0; m < 4; ++m) _Pragma("unroll") for (int k = 0; k < 2; ++k) dst[m][k] = *(const LAS bf16x8*)(lds + SA(b, h) + aoff + m * 2048 + k * 1024); } while (0)
#define LDB(dst, b, h) do { _Pragma("unroll") for (int n = 0; n < 2; ++n) _Pragma("unroll") for (int k = 0; k < 2; ++k) dst[n][k] = *(const LAS bf16x8*)(lds + SB(b, h) + boff + n * 2048 + k * 1024); } while (0)
#define MMA(ai, bj, At_, Bt_) do { __builtin_amdgcn_s_setprio(1); _Pragma("unroll") for (int m = 0; m < 4; ++m) _Pragma("unroll") for (int n = 0; n < 2; ++n) _Pragma("unroll") for (int k = 0; k < 2; ++k) \
        acc[ai][bj][m][n] = __builtin_amdgcn_mfma_f32_16x16x32_bf16(Bt_[n][k], At_[m][k], acc[ai][bj][m][n], 0, 0, 0); __builtin_amdgcn_s_setprio(0); } while (0)
#define WAIT_V(n) asm volatile("s_waitcnt vmcnt(" #n ")" ::: "memory")
#define WAIT_L(n) asm volatile("s_waitcnt lgkmcnt(" #n ")" ::: "memory")
#define BAR __builtin_amdgcn_s_barrier()
#define SCHED __builtin_amdgcn_sched_barrier(0)
#pragma unroll
    for (int a = 0; a < 2; ++a)
#pragma unroll
        for (int b = 0; b < 2; ++b)
#pragma unroll
            for (int m = 0; m < 4; ++m)
#pragma unroll
                for (int n = 0; n < 2; ++n) acc[a][b][m][n] = (f32x4){0.f, 0.f, 0.f, 0.f};
    bf16x8 At[4][2], B0[2][2], B1[2][2];
    const char* cA = (const char*)A + (size_t)brow * K * 2; const char* cB = (const char*)Bt + (size_t)bcol * K * 2;
    STAGE(SB(0, 0), cB); STAGE(SA(0, 0), cA); STAGE(SB(0, 1), cB + hstep); STAGE(SA(0, 1), cA + hstep);
    if (wr == 1) BAR;
    WAIT_V(4); BAR;
    STAGE(SB(1, 0), cB + kstep); STAGE(SA(1, 0), cA + kstep); STAGE(SB(1, 1), cB + hstep + kstep);
    WAIT_V(6); BAR;
    for (int t = 0; t < nt - 2; t += 2) {
        const char* a1 = cA + (size_t)(t + 1) * kstep; const char* a2 = cA + (size_t)(t + 2) * kstep; const char* b2 = cB + (size_t)(t + 2) * kstep;
        const char* a3 = a2 + kstep; const char* b3 = b2 + kstep;
        LDB(B0, 0, 0); SCHED; LDA(At, 0, 0); STAGE(SA(1, 1), a1 + hstep);
        WAIT_L(8); BAR; WAIT_L(0); MMA(0, 0, At, B0); BAR; SCHED;
        LDB(B1, 0, 1); STAGE(SB(0, 0), b2);
        BAR; WAIT_L(0); MMA(0, 1, At, B1); BAR;
        LDA(At, 0, 1); STAGE(SA(0, 0), a2);
        BAR; WAIT_L(0); MMA(1, 0, At, B0); BAR; SCHED;
        STAGE(SB(0, 1), b2 + hstep);
        WAIT_V(6); BAR; MMA(1, 1, At, B1); BAR;
        LDB(B0, 1, 0); SCHED; LDA(At, 1, 0); STAGE(SA(0, 1), a2 + hstep);
        WAIT_L(8); BAR; WAIT_L(0); MMA(0, 0, At, B0); BAR; SCHED;
        LDB(B1, 1, 1); STAGE(SB(1, 0), b3);
        BAR; WAIT_L(0); MMA(0, 1, At, B1); BAR;
        LDA(At, 1, 1); STAGE(SA(1, 0), a3);
        BAR; WAIT_L(0); MMA(1, 0, At, B0); BAR; SCHED;
        STAGE(SB(1, 1), b3 + hstep);
        WAIT_V(6); BAR; MMA(1, 1, At, B1); BAR;
    }
    { LDB(B0, 0, 0); LDA(At, 0, 0); STAGE(SA(1, 1), cA + (size_t)(nt - 1) * kstep + hstep);
      BAR; WAIT_L(0); MMA(0, 0, At, B0); BAR;
      LDB(B1, 0, 1); BAR; WAIT_L(0); MMA(0, 1, At, B1); BAR;
      LDA(At, 0, 1); WAIT_V(4); BAR; WAIT_L(0); MMA(1, 0, At, B0); MMA(1, 1, At, B1); BAR; }
    { LDB(B0, 1, 0); LDA(At, 1, 0); WAIT_V(2); BAR; WAIT_L(0); MMA(0, 0, At, B0); BAR;
      LDB(B1, 1, 1); WAIT_V(0); BAR; WAIT_L(0); MMA(0, 1, At, B1); BAR;
      LDA(At, 1, 1); BAR; WAIT_L(0); MMA(1, 0, At, B0); MMA(1, 1, At, B1); BAR; }
    if (wr == 0) BAR;
}

DI void tile_order(int L, int nM, int nN, int& pm, int& pn) {
    const int nwg = nM * nN; int wgid = L;
    { const int q = nwg / NXCD, r = nwg % NXCD, xcd = wgid % NXCD, off = wgid / NXCD; wgid = (xcd < r ? xcd * (q + 1) : r * (q + 1) + (xcd - r) * q) + off; }
    const int nig = WGM * nN, gid = wgid / nig, fm = gid * WGM, gsz = (nM - fm) < WGM ? (nM - fm) : WGM;
    pm = fm + ((wgid % nig) % gsz); pn = (wgid % nig) / gsz;
}

struct EpiSwiglu {
    bf16_t* hid;
    DI void operator()(f32x4 (&acc)[2][2][4][2], int pm, int pn, char* smem) const {
        const int wid = TID() >> 6, lane = TID() & 63, wr = wid >> 2, wc = wid & 3, fr = lane & 15, fq = lane >> 4;
#pragma unroll
        for (int ai = 0; ai < 2; ++ai)
#pragma unroll
            for (int m = 0; m < 4; ++m) {
                const int row = pm * BM + ai * HALF + wr * 64 + m * 16 + fr;
#pragma unroll
                for (int n = 0; n < 2; ++n) {
                    const f32x4 a = acc[ai][0][m][n], b = acc[ai][1][m][n];
                    u32x2 w; w[0] = pk2(silu_f(a[0]) * b[0], silu_f(a[1]) * b[1]); w[1] = pk2(silu_f(a[2]) * b[2], silu_f(a[3]) * b[3]);
                    *(u32x2*)(hid + (size_t)row * DFF + pn * 128 + wc * 32 + n * 16 + fq * 4) = w;
                }
            }
    }
};
struct EpiResid {
    const float *lat_in, *cx_in; float *lat_out, *cx_out; const float* gate; float gs;
    DI void operator()(f32x4 (&acc)[2][2][4][2], int pm, int pn, char* smem) const {
        const int wid = TID() >> 6, lane = TID() & 63, wr = wid >> 2, wc = wid & 3, fr = lane & 15, fq = lane >> 4;
        const int row0 = pm * BM; const bool islat = row0 < NLAT;
        const size_t base = (size_t)(islat ? row0 : row0 - NLAT) * D + (size_t)(wr * 64 + fr) * D + pn * BM + wc * 32 + fq * 4;
        const float* in = (islat ? lat_in : cx_in) + base;
        float* out = (islat ? lat_out : cx_out) + base;
        const float* gt = gate + (size_t)(islat ? row0 / SEQ : 16) * MODW + pn * BM + wc * 32 + fq * 4;
        f32x4 gv[2][2];
#pragma unroll
        for (int bj = 0; bj < 2; ++bj)
#pragma unroll
            for (int n = 0; n < 2; ++n) gv[bj][n] = *(const f32x4*)(gt + bj * HALF + n * 16) * gs;
#pragma unroll
        for (int ai = 0; ai < 2; ++ai)
#pragma unroll
            for (int m = 0; m < 4; ++m) {
                const size_t ro = (size_t)(ai * HALF + m * 16) * D;
                f32x4 hv[2][2];
#pragma unroll
                for (int bj = 0; bj < 2; ++bj)
#pragma unroll
                    for (int n = 0; n < 2; ++n) hv[bj][n] = *(const f32x4*)(in + ro + bj * HALF + n * 16);
#pragma unroll
                for (int bj = 0; bj < 2; ++bj)
#pragma unroll
                    for (int n = 0; n < 2; ++n) *(f32x4*)(out + ro + bj * HALF + n * 16) = hv[bj][n] + gv[bj][n] * acc[ai][bj][m][n];
                if (m & 1) __builtin_amdgcn_sched_barrier(0);
            }
    }
};
constexpr int TS = 257;
struct EpiProj {
    const Params* pp; int l;
    DI void operator()(f32x4 (&acc)[2][2][4][2], int pm, int pn, char* smem) const {
        const Params& p = *pp;
        float* T = (float*)smem;
        const int tid = TID(), wid = tid >> 6, lane = tid & 63, wr = wid >> 2, wc = wid & 3, fr = lane & 15, fq = lane >> 4;
#pragma unroll
        for (int ai = 0; ai < 2; ++ai) {
            __syncthreads();
#pragma unroll
            for (int bj = 0; bj < 2; ++bj)
#pragma unroll
                for (int m = 0; m < 4; ++m)
#pragma unroll
                    for (int n = 0; n < 2; ++n)
#pragma unroll
                        for (int j = 0; j < 4; ++j) T[(wr * 64 + m * 16 + fr) * TS + bj * HALF + wc * 32 + n * 16 + fq * 4 + j] = acc[ai][bj][m][n][j];
            __syncthreads();
            const int rl = tid & 127, seg = tid >> 7, grow = pm * BM + ai * HALF + rl;
            const bool islat = grow < NLAT;
            const int b = islat ? grow / SEQ : (grow - NLAT) / CTX;
            const int pos = islat ? grow % SEQ : SEQ + (grow - NLAT) % CTX;
            const float* xr = T + rl * TS + seg * 64;
            if (pn == 0 || (pn == 2 && seg < 2)) {
                const float* g = (pn == 0 ? p.g_q_a : p.g_k_a) + l * 64;
                bf16_t* dst = pn == 0 ? p.QA + ((size_t)(b * 4 + seg) * KEYS + pos) * 64 : p.KA + ((size_t)(b * 2 + seg) * KEYS + pos) * 64;
                float ss = 0.f;
                for (int i = 0; i < 64; ++i) ss += xr[i] * xr[i];
                const float rstd = rsqrtf(ss * (1.f / 64.f) + EPS);
                const float* rp = p.ropeA + (size_t)(islat ? pos : 0) * 64;
                for (int i0 = 0; i0 < 32; i0 += 8) {
                    float o1[8], o2[8];
#pragma unroll
                    for (int i = 0; i < 8; ++i) {
                        const float a = xr[i0 + i] * rstd * g[i0 + i], bb = xr[i0 + i + 32] * rstd * g[i0 + i + 32];
                        float cs = 1.f, sn = 0.f;
                        if (islat) { cs = rp[(i0 + i) * 2]; sn = rp[(i0 + i) * 2 + 1]; }
                        o1[i] = a * cs - bb * sn; o2[i] = a * sn + bb * cs;
                    }
                    u32x4 w1, w2;
#pragma unroll
                    for (int i = 0; i < 4; ++i) { w1[i] = pk2(o1[2 * i], o1[2 * i + 1]); w2[i] = pk2(o2[2 * i], o2[2 * i + 1]); }
                    *(u32x4*)(dst + i0) = w1; *(u32x4*)(dst + 32 + i0) = w2;
                }
            } else if (pn == 1 || pn == 3) {
                bf16_t* base = (pn == 1 ? p.QC : p.KC);
                const float* rp = p.ropeC + (size_t)(islat ? pos : 0) * 32;
#pragma unroll
                for (int mp = 0; mp < 2; ++mp) {
                    bf16_t* dst = base + ((size_t)((b * 4 + seg) * 2 + mp) * KEYS + pos) * 32;
                    for (int i0 = 0; i0 < 16; i0 += 8) {
                        float o1[8], o2[8];
#pragma unroll
                        for (int i = 0; i < 8; ++i) {
                            const float a = xr[mp * 32 + i0 + i], bb = xr[mp * 32 + i0 + i + 16];
                            float cs = 1.f, sn = 0.f;
                            if (islat) { cs = rp[(i0 + i) * 2]; sn = rp[(i0 + i) * 2 + 1]; }
                            o1[i] = a * cs - bb * sn; o2[i] = a * sn + bb * cs;
                        }
                        u32x4 w1, w2;
#pragma unroll
                        for (int i = 0; i < 4; ++i) { w1[i] = pk2(o1[2 * i], o1[2 * i + 1]); w2[i] = pk2(o2[2 * i], o2[2 * i + 1]); }
                        *(u32x4*)(dst + i0) = w1; *(u32x4*)(dst + 16 + i0) = w2;
                    }
                }
            } else if (pn == 2 || pn == 4) {
                bf16_t* dst = pn == 2 ? p.VtA + ((size_t)(b * 2 + (seg - 2)) * 64) * KEYS + pos : p.VtC + ((size_t)(b * 4 + seg) * 64) * KEYS + pos;
                for (int d = 0; d < 64; ++d) dst[(size_t)d * KEYS] = f2bf(xr[d]);
            } else if (pn == 5) {
                bf16_t* dst = p.U + (size_t)grow * 256 + seg * 64;
                for (int i0 = 0; i0 < 64; i0 += 8) {
                    u32x4 w;
#pragma unroll
                    for (int i = 0; i < 4; ++i) w[i] = pk2(gelu_f(xr[i0 + 2 * i]), gelu_f(xr[i0 + 2 * i + 1]));
                    *(u32x4*)(dst + i0) = w;
                }
            } else if (pn == 6) {
                const float* xrow = T + rl * TS; float ss = 0.f;
                for (int i = 0; i < 256; ++i) { const float gv = gelu_f(xrow[i]); ss += gv * gv; }
                const float rstd = rsqrtf(ss * (1.f / 256.f) + EPS);
                const float* g = p.g_v_b + l * 256 + seg * 64;
                bf16_t* dst = p.VN + (size_t)grow * 256 + seg * 64;
                for (int i0 = 0; i0 < 64; i0 += 8) {
                    u32x4 w;
#pragma unroll
                    for (int i = 0; i < 4; ++i) w[i] = pk2(gelu_f(xr[i0 + 2 * i]) * rstd * g[i0 + 2 * i], gelu_f(xr[i0 + 2 * i + 1]) * rstd * g[i0 + 2 * i + 1]);
                    *(u32x4*)(dst + i0) = w;
                }
            } else {
                if (seg < 2) {
                    const float* gr = xr + 128;
                    bf16_t* dst = p.Y + (size_t)grow * 256 + (pn - 7) * 128 + seg * 64;
                    for (int i0 = 0; i0 < 64; i0 += 8) {
                        u32x4 w;
#pragma unroll
                        for (int i = 0; i < 4; ++i) w[i] = pk2(xr[i0 + 2 * i] * sigmoid_f(gr[i0 + 2 * i]), xr[i0 + 2 * i + 1] * sigmoid_f(gr[i0 + 2 * i + 1]));
                        *(u32x4*)(dst + i0) = w;
                    }
                }
            }
        }
        __syncthreads();
    }
};

template <class Epi>
DI void phase_gemm(const bf16_t* A, const bf16_t* Bt, int M, int N, int K, const Epi& epi, char* smem) {
    const int nM = M / BM, nN = N / BM, nwg = nM * nN;
    for (int L = blockIdx.x; L < nwg; L += gridDim.x) {
        int pm, pn; tile_order(L, nM, nN, pm, pn);
        f32x4 acc[2][2][4][2];
        gemm_tile(A, Bt, K, pm * BM, pn * BM, acc, (LAS unsigned char*)smem);
        epi(acc, pm, pn, smem);
    }
}

constexpr int VROW = 144;
template <int DQK>
DI void attn_core(const bf16_t* Q, const bf16_t* Kg, const bf16_t* Vt, int qpos0, int key_lo, int nkt, float sc, f32x16 (&O)[2], char* smem) {
    constexpr int KROW = DQK * 2 + 16, KBUF = 64 * KROW, VBUF = 64 * VROW, NKS = DQK / 16;
    char* kb_[2] = {smem, smem + KBUF};
    char* vb_[2] = {smem + 2 * KBUF, smem + 2 * KBUF + VBUF};
    const int tid = TID(), lane = tid & 63, wid = tid >> 6, r = lane & 31, h = lane >> 5;
    bf16x8 qf[NKS];
#pragma unroll
    for (int ks = 0; ks < NKS; ++ks) qf[ks] = *(const bf16x8*)(Q + (size_t)(qpos0 + wid * 32 + r) * DQK + ks * 16 + 8 * h);
#pragma unroll
    for (int i = 0; i < 16; ++i) { O[0][i] = 0.f; O[1][i] = 0.f; }
    float m_run = -1e30f, l_run = 0.f;
    constexpr int KCH = DQK / 8;
    const bool kact = tid < 64 * KCH;
    const int kkey = tid / KCH, kch = tid % KCH, vd = tid >> 3, vch = tid & 7;
    u32x4 kreg = {0, 0, 0, 0}, vreg;
    auto gload = [&](int t) {
        const int key0 = key_lo + t * 64;
        if (kact) kreg = *(const u32x4*)(Kg + (size_t)(key0 + kkey) * DQK + kch * 8);
        vreg = *(const u32x4*)(Vt + (size_t)vd * KEYS + key0 + vch * 8);
    };
    auto lstore = [&](int bsel) {
        if (kact) *(u32x4*)(kb_[bsel] + kkey * KROW + kch * 16) = kreg;
        *(u32x4*)(vb_[bsel] + vd * VROW + vch * 16) = vreg;
    };
    __syncthreads();
    gload(0); lstore(0);
    __syncthreads();
    for (int t = 0; t < nkt; ++t) {
        const int cur = t & 1;
        if (t + 1 < nkt) gload(t + 1);
        const char* kb = kb_[cur]; const char* vb = vb_[cur];
#pragma unroll
        for (int kk = 0; kk < 2; ++kk) {
            f32x16 s;
#pragma unroll
            for (int i = 0; i < 16; ++i) s[i] = 0.f;
#pragma unroll
            for (int ks = 0; ks < NKS; ++ks) {
                const bf16x8 kf = *(const bf16x8*)(kb + (kk * 32 + r) * KROW + ks * 32 + 16 * h);
                s = __builtin_amdgcn_mfma_f32_32x32x16_bf16(kf, qf[ks], s, 0, 0, 0);
            }
            float mx = s[0];
#pragma unroll
            for (int i = 1; i < 16; ++i) mx = fmaxf(mx, s[i]);
            mx = fmaxf(mx, __shfl_xor(mx, 32));
            const float m_new = fmaxf(m_run, mx * sc);
            const float alpha = __builtin_amdgcn_exp2f(m_run - m_new);
            m_run = m_new;
            float ps = 0.f;
#pragma unroll
            for (int i = 0; i < 16; ++i) { s[i] = __builtin_amdgcn_exp2f(s[i] * sc - m_new); ps += s[i]; }
            l_run = l_run * alpha + ps;
#pragma unroll
            for (int i = 0; i < 16; ++i) { O[0][i] *= alpha; O[1][i] *= alpha; }
#pragma unroll
            for (int st = 0; st < 2; ++st) {
                u32x4 pw;
#pragma unroll
                for (int i = 0; i < 4; ++i) pw[i] = pk2(s[8 * st + 2 * i], s[8 * st + 2 * i + 1]);
                const bf16x8 pf = __builtin_bit_cast(bf16x8, pw);
#pragma unroll
                for (int dt = 0; dt < 2; ++dt) {
                    const char* vp = vb + (dt * 32 + r) * VROW + (kk * 32 + 16 * st + 4 * h) * 2;
                    const u32x2 lo = *(const u32x2*)vp, hi = *(const u32x2*)(vp + 16);
                    u32x4 vw = {lo[0], lo[1], hi[0], hi[1]};
                    O[dt] = __builtin_amdgcn_mfma_f32_32x32x16_bf16(__builtin_bit_cast(bf16x8, vw), pf, O[dt], 0, 0, 0);
                }
            }
        }
        if (t + 1 < nkt) lstore(cur ^ 1);
        __syncthreads();
    }
    const float lt = l_run + __shfl_xor(l_run, 32);
    const float inv = 1.f / lt;
#pragma unroll
    for (int i = 0; i < 16; ++i) { O[0][i] *= inv; O[1][i] *= inv; }
}

DI void store_OT(const f32x16 (&O)[2], bf16_t* dst  , int h) {
#pragma unroll
    for (int dt = 0; dt < 2; ++dt)
#pragma unroll
        for (int gq = 0; gq < 4; ++gq) {
            u32x2 w; w[0] = pk2(O[dt][4 * gq], O[dt][4 * gq + 1]); w[1] = pk2(O[dt][4 * gq + 2], O[dt][4 * gq + 3]);
            *(u32x2*)(dst + dt * 32 + 8 * gq + 4 * h) = w;
        }
}

DI void attn_unit(const Params& p, int l, int uidx, bool isC, int nqb, char* smem) {
    const int qb = uidx % nqb, bh = uidx / nqb, head = bh & 3, b = bh >> 2;
    const int lane = TID() & 63, wid = TID() >> 6, r = lane & 31, h = lane >> 5;
    const int qpos0 = qb < 8 ? qb * 256 : SEQ, key_lo = qb < 8 ? 0 : SEQ, nkt = qb < 8 ? KEYS / 64 : CTX / 64;
    const int qpos = qpos0 + wid * 32 + r;
    const size_t grow = qpos < SEQ ? (size_t)b * SEQ + qpos : (size_t)NLAT + b * CTX + (qpos - SEQ);
    if (!isC) {
        f32x16 O[2];
        attn_core<64>(p.QA + (size_t)(b * 4 + head) * KEYS * 64, p.KA + (size_t)(b * 2 + (head >> 1)) * KEYS * 64, p.VtA + (size_t)(b * 2 + (head >> 1)) * 64 * KEYS,
                      qpos0, key_lo, nkt, 0.125f * 1.4426950408889634f, O, smem);
        store_OT(O, p.cat + grow * D + head * 64, h);
    } else {
        const float lam_init = 0.8f - 0.6f * __expf(-0.3f * (float)l);
        float d0 = 0.f, d1 = 0.f;
        const float* lp = p.lam_c + l * 128;
        for (int i = 0; i < 32; ++i) { d0 += lp[i] * lp[32 + i]; d1 += lp[64 + i] * lp[96 + i]; }
        const float lam = __expf(d0) - __expf(d1) + lam_init;
        const bf16_t* Vt = p.VtC + (size_t)(b * 4 + head) * 64 * KEYS;
        f32x16 O0[2], O1[2];
        attn_core<32>(p.QC + (size_t)((b * 4 + head) * 2 + 0) * KEYS * 32, p.KC + (size_t)((b * 4 + head) * 2 + 0) * KEYS * 32, Vt, qpos0, key_lo, nkt,
                      0.17677669529663687f * 1.4426950408889634f, O0, smem);
        attn_core<32>(p.QC + (size_t)((b * 4 + head) * 2 + 1) * KEYS * 32, p.KC + (size_t)((b * 4 + head) * 2 + 1) * KEYS * 32, Vt, qpos0, key_lo, nkt,
                      0.17677669529663687f * 1.4426950408889634f, O1, smem);
        float ss = 0.f;
#pragma unroll
        for (int dt = 0; dt < 2; ++dt)
#pragma unroll
            for (int i = 0; i < 16; ++i) { const float v = O0[dt][i] - lam * O1[dt][i]; O0[dt][i] = v; ss += v * v; }
        ss += __shfl_xor(ss, 32);
        const float rstd = rsqrtf(ss * (1.f / 64.f) + EPS) * (1.f - lam_init);
        const float* g = p.g_sub_c + l * 64;
#pragma unroll
        for (int dt = 0; dt < 2; ++dt)
#pragma unroll
            for (int i = 0; i < 16; ++i) O0[dt][i] *= rstd * g[dt * 32 + 8 * (i >> 2) + 4 * h + (i & 3)];
        store_OT(O0, p.cat + grow * D + 256 + head * 64, h);
    }
}

DI void gmlp_unit(const Params& p, int l, int uidx, char* smem) {
    const int g = uidx & 3, c = uidx >> 2, tid = TID(), lane = tid & 63, wid = tid >> 6, fr = lane & 15, fq = lane >> 4;
    bf16_t* vT = (bf16_t*)smem;
    constexpr int VS = 136;
    __syncthreads();
    {
        const int q = tid >> 2, d0 = (tid & 3) * 16;
        const bf16_t* src = p.VN + (size_t)(c * 128 + q) * 256 + g * 64 + d0;
        const bf16x8 a = *(const bf16x8*)src, bb = *(const bf16x8*)(src + 8);
#pragma unroll
        for (int j = 0; j < 8; ++j) { vT[(d0 + j) * VS + q] = (bf16_t)a[j]; vT[(d0 + 8 + j) * VS + q] = (bf16_t)bb[j]; }
    }
    __syncthreads();
    f32x4 acc[4];
#pragma unroll
    for (int n = 0; n < 4; ++n) acc[n] = (f32x4){0.f, 0.f, 0.f, 0.f};
    const bf16_t* wrow = p.Ws + ((size_t)(l * 4 + g) * 128 + wid * 16 + fr) * 128;
#pragma unroll
    for (int ks = 0; ks < 4; ++ks) {
        const bf16x8 af = *(const bf16x8*)(wrow + ks * 32 + fq * 8);
#pragma unroll
        for (int n = 0; n < 4; ++n) {
            const bf16x8 bfv = *(const bf16x8*)(vT + (n * 16 + fr) * VS + ks * 32 + fq * 8);
            acc[n] = __builtin_amdgcn_mfma_f32_16x16x32_bf16(bfv, af, acc[n], 0, 0, 0);
        }
    }
    const int prow = wid * 16 + fr; const size_t grow = (size_t)c * 128 + prow;
    const float bias = p.b_s_b[(l * 4 + g) * 128 + prow];
#pragma unroll
    for (int n = 0; n < 4; ++n) {
        const int col = g * 64 + n * 16 + fq * 4;
        const u32x2 uu = *(const u32x2*)(p.U + grow * 256 + col);
        u32x2 w;
        w[0] = pk2(bflo(uu[0]) * (acc[n][0] + bias), bfhi(uu[0]) * (acc[n][1] + bias));
        w[1] = pk2(bflo(uu[1]) * (acc[n][2] + bias), bfhi(uu[1]) * (acc[n][3] + bias));
        *(u32x2*)(p.cat + grow * D + 512 + col) = w;
    }
}

DI void conv_unit(const Params& p, int l, int uidx, char* smem) {
    const int tid = TID(), lane = tid & 63, wid = tid >> 6;
    bf16_t* yin = (bf16_t*)smem;
    float* co = (float*)(smem + 94 * 256 * 2);
    const int row0 = uidx * 64;
    int s0, s1;
    if (row0 < NLAT) { s0 = (row0 / SEQ) * SEQ; s1 = s0 + SEQ; } else { s0 = NLAT + ((row0 - NLAT) / CTX) * CTX; s1 = s0 + CTX; }
    __syncthreads();
    for (int i = tid; i < 94 * 32; i += NTHR) {
        const int rr = i >> 5, ch8 = (i & 31) * 8, gr = row0 - 15 + rr;
        u32x4 v = {0, 0, 0, 0};
        if (gr >= s0 && gr < s1) v = *(const u32x4*)(p.Y + (size_t)gr * 256 + ch8);
        *(u32x4*)(yin + rr * 256 + ch8) = v;
    }
    __syncthreads();
    {
        const int ch = tid & 255, th = tid >> 8;
        float w[31];
#pragma unroll
        for (int k = 0; k < 31; ++k) w[k] = p.w_dw_d[(size_t)(l * 31 + k) * 256 + ch];
        const float bias = p.b_dw_d[l * 256 + ch];
        for (int i = th * 32; i < th * 32 + 32; ++i) {
            float a = bias;
#pragma unroll
            for (int k = 0; k < 31; ++k) a += w[k] * bf2f(yin[(i + k) * 256 + ch]);
            co[i * 256 + ch] = a;
        }
    }
    __syncthreads();
#pragma unroll
    for (int j = 0; j < 8; ++j) {
        const int tk = wid * 8 + j;
        const f32x4 v = *(const f32x4*)(co + tk * 256 + lane * 4);
        const float ss = wave_sum(v[0] * v[0] + v[1] * v[1] + v[2] * v[2] + v[3] * v[3]);
        const float rstd = rsqrtf(ss * (1.f / 256.f) + EPS);
        const f32x4 g = *(const f32x4*)(p.g_conv_d + l * 256 + lane * 4);
        u32x2 w; w[0] = pk2(silu_f(v[0] * rstd * g[0]), silu_f(v[1] * rstd * g[1])); w[1] = pk2(silu_f(v[2] * rstd * g[2]), silu_f(v[3] * rstd * g[3]));
        *(u32x2*)(p.cat + (size_t)(row0 + tk) * D + 768 + lane * 4) = w;
    }
}

DI void phase_mixers(const Params& p, int l, bool withctx, char* smem) {
    const int nqb = withctx ? 9 : 8;
    const int nC = NB * 4 * nqb, nA = nC, nG = (withctx ? NTOK : NLAT) / 128 * 4, nV = (withctx ? NTOK : NLAT) / 64;
    const int total = nC + nA + nG + nV;
    for (int u = blockIdx.x; u < total; u += gridDim.x) {
        asm volatile("" : "+s"(l));
        if (u < nC) attn_unit(p, l, u, true, nqb, smem);
        else if (u < nC + nA) attn_unit(p, l, u - nC, false, nqb, smem);
        else if (u < nC + nA + nG) gmlp_unit(p, l, u - nC - nA, smem);
        else conv_unit(p, l, u - nC - nA - nG, smem);
    }
}

constexpr int PH_PER_LAYER = 10, N_PHASES = 1 + DEPTH * PH_PER_LAYER + 1;

typedef const __attribute__((address_space(4))) Params* KParamsPtr;
__global__ void __launch_bounds__(NTHR) mega(Params p_unused, int ph_lo, int ph_hi) {
    extern __shared__ __attribute__((aligned(16))) char smem[];
    for (int ph = ph_lo; ph < ph_hi; ++ph) {
        if (ph > ph_lo) cg::this_grid().sync();
        KParamsPtr kp = (KParamsPtr)__builtin_amdgcn_kernarg_segment_ptr();
        asm volatile("" : "+s"(kp));
        const Params& p = *(const Params*)kp;
        if (ph == 0) { phase_prologue(p, smem); continue; }
        if (ph == N_PHASES - 1) { phase_norm<true>(p, p.out, p.hc, p.g_final, nullptr, 0, NLAT); continue; }
        const int l = (ph - 1) / PH_PER_LAYER, s = (ph - 1) % PH_PER_LAYER;
        const bool last = l == DEPTH - 1;
        const float* mods_l = p.mods + (size_t)l * 17 * MODW;
        const bool first = (l == 0 && s <= 2);
        const float* lat_in = first ? p.x : p.out;
        const float* cx_in = first ? p.ctx : p.hc;
        if (s == 0 || s == 3 || s == 7) {
            const int j = s == 0 ? 0 : (s == 3 ? 1 : 2);
            phase_norm<false>(p, lat_in, cx_in, p.g_norm + (l * 3 + j) * D, mods_l, 3 * j, (s == 7 && last) ? NLAT : NTOK);
        } else if (s == 1 || s == 8) {
            EpiSwiglu e{p.hid};
            phase_gemm(p.xn, (s == 1 ? p.Wff1in : p.Wff2in) + (size_t)l * D * 2 * DFF, (s == 8 && last) ? NLAT : NTOK, 2 * DFF, D, e, smem);
        } else if (s == 2 || s == 6 || s == 9) {
            const bf16_t* A = s == 6 ? p.cat : p.hid;
            const bf16_t* Bt = s == 2 ? p.Wff1out + (size_t)l * D * DFF : (s == 9 ? p.Wff2out + (size_t)l * D * DFF : p.Wout + (size_t)l * D * D);
            const int K = s == 6 ? D : DFF, gi = s == 2 ? 2 : (s == 6 ? 5 : 8);
            EpiResid e{lat_in, cx_in, p.out, p.hc, mods_l + gi * D, s == 6 ? 1.0f : 0.5f};
            phase_gemm(A, Bt, (s != 2 && last) ? NLAT : NTOK, D, K, e, smem);
        } else if (s == 4) {
            EpiProj e{&p, l}; phase_gemm(p.xn, p.Win + (size_t)l * D * INC, NTOK, INC, D, e, smem);
        } else {
            phase_mixers(p, l, !last, smem);
        }
    }
}

extern "C" void kernel_launch(void* const* d_in, const int* in_sizes, int n_in, void* d_out, int out_size, void* d_ws, size_t ws_size, hipStream_t stream) {
    static int grid = 0;
    if (grid == 0) {
        int dev = 0, cus = 0, per_cu = 0;
        hipGetDevice(&dev);
        hipDeviceGetAttribute(&cus, hipDeviceAttributeMultiprocessorCount, dev);
        if (hipFuncSetAttribute((const void*)mega, hipFuncAttributeMaxDynamicSharedMemorySize, LDS_BYTES) != hipSuccess) fprintf(stderr, "hipFuncSetAttribute failed\n");
        if (hipOccupancyMaxActiveBlocksPerMultiprocessor(&per_cu, (const void*)mega, NTHR, LDS_BYTES) != hipSuccess || per_cu < 1) { fprintf(stderr, "occupancy query: %d\n", per_cu); per_cu = 1; }
        (void)hipGetLastError();
        grid = cus * per_cu;
        fprintf(stderr, "grid = %d (cus %d per_cu %d) ws_size %zu\n", grid, cus, per_cu, ws_size);
    }
    Params p{};
    const float** pin = (const float**)&p;
    for (int i = 0; i < 24; ++i) pin[i] = (const float*)d_in[i];
    p.out = (float*)d_out;
    char* w = (char*)d_ws; size_t off = 0;
    auto take = [&](size_t bytes) { char* r = w + off; off += (bytes + 255) & ~(size_t)255; return r; };
    p.Wff1in = (bf16_t*)take((size_t)DEPTH * D * 2 * DFF * 2);
    p.Wff1out = (bf16_t*)take((size_t)DEPTH * D * DFF * 2);
    p.Wff2in = (bf16_t*)take((size_t)DEPTH * D * 2 * DFF * 2);
    p.Wff2out = (bf16_t*)take((size_t)DEPTH * D * DFF * 2);
    p.Win = (bf16_t*)take((size_t)DEPTH * D * INC * 2);
    p.Wout = (bf16_t*)take((size_t)DEPTH * D * D * 2);
    p.Ws = (bf16_t*)take((size_t)DEPTH * 4 * 128 * 128 * 2);
    p.mods = (float*)take((size_t)DEPTH * 17 * MODW * 4);
    p.ropeA = (float*)take((size_t)SEQ * 32 * 2 * 4);
    p.ropeC = (float*)take((size_t)SEQ * 16 * 2 * 4);
    p.hc = (float*)take((size_t)NCTX * D * 4);
    p.xn = (bf16_t*)take((size_t)NTOK * D * 2);
    p.cat = p.xn;
    p.hid = (bf16_t*)take((size_t)NTOK * DFF * 2);
    {
        char* q = (char*)p.hid; size_t o2 = 0;
        auto take2 = [&](size_t bytes) { char* r = q + o2; o2 += (bytes + 255) & ~(size_t)255; return r; };
        p.QA = (bf16_t*)take2((size_t)NB * 4 * KEYS * 64 * 2);
        p.KA = (bf16_t*)take2((size_t)NB * 2 * KEYS * 64 * 2);
        p.VtA = (bf16_t*)take2((size_t)NB * 2 * 64 * KEYS * 2);
        p.QC = (bf16_t*)take2((size_t)NB * 4 * 2 * KEYS * 32 * 2);
        p.KC = (bf16_t*)take2((size_t)NB * 4 * 2 * KEYS * 32 * 2);
        p.VtC = (bf16_t*)take2((size_t)NB * 4 * 64 * KEYS * 2);
        p.U = (bf16_t*)take2((size_t)NTOK * 256 * 2);
        p.VN = (bf16_t*)take2((size_t)NTOK * 256 * 2);
        p.Y = (bf16_t*)take2((size_t)NTOK * 256 * 2);
    }
    if (off > ws_size) { fprintf(stderr, "workspace too small: need %zu have %zu\n", off, ws_size); return; }
#if N_LAUNCH_MODE == 1
    int lo = 0, hi = N_PHASES;
    void* args[] = {&p, &lo, &hi};
    hipError_t e = hipLaunchCooperativeKernel((const void*)mega, dim3(grid), dim3(NTHR), args, LDS_BYTES, stream);
    if (e != hipSuccess) fprintf(stderr, "cooperative launch failed: %s (grid %d)\n", hipGetErrorString(e), grid);
#else
    for (int ph = 0; ph < N_PHASES; ++ph) hipLaunchKernelGGL(mega, dim3(grid), dim3(NTHR), LDS_BYTES, stream, p, ph, ph + 1);
#endif
}
```

```cpp
#include <hip/hip_runtime.h>
#include <hip/hip_cooperative_groups.h>
#include <cstdint>
#include <cstdio>
#include <cmath>
namespace cg = cooperative_groups;

#ifndef N_LAUNCH_MODE
#define N_LAUNCH_MODE 1
#endif

typedef unsigned short bf16_t;
typedef short bf16x8 __attribute__((ext_vector_type(8)));
typedef short s16x4 __attribute__((ext_vector_type(4)));
typedef float f32x4 __attribute__((ext_vector_type(4)));
typedef float f32x2 __attribute__((ext_vector_type(2)));
typedef float f32x16 __attribute__((ext_vector_type(16)));
typedef unsigned u32x2 __attribute__((ext_vector_type(2)));
typedef unsigned u32x4 __attribute__((ext_vector_type(4)));
typedef __bf16 bf2_t __attribute__((ext_vector_type(2)));
#define DI __device__ __forceinline__

constexpr int D = 1024, NB = 16, SEQ = 2048, CTX = 256, NLAT = NB * SEQ, NCTX = NB * CTX, NTOK = NLAT + NCTX;
constexpr int DFF = 2816, INC = 2304, KEYS = SEQ + CTX, DEPTH = 2, MODW = 9 * D;
constexpr int NTHR = 512;
constexpr int LDS_BYTES = 135168;
constexpr float EPS = 1e-6f;

DI unsigned pk2(float a, float b) { f32x2 v = {a, b}; bf2_t r = __builtin_convertvector(v, bf2_t); return __builtin_bit_cast(unsigned, r); }
DI float bf2f(bf16_t v) { return __uint_as_float(((unsigned)v) << 16); }
DI float bflo(unsigned v) { return __uint_as_float(v << 16); }
DI float bfhi(unsigned v) { return __uint_as_float(v & 0xffff0000u); }
DI bf16_t f2bf(float a) { return (bf16_t)(pk2(a, 0.f) & 0xffffu); }
DI float silu_f(float x) { return x / (1.f + __expf(-x)); }
DI float sigmoid_f(float x) { return 1.f / (1.f + __expf(-x)); }
DI float gelu_f(float x) { float u = 1.5957691216057308f * (x + 0.044715f * x * x * x); return x / (1.f + __expf(-u)); }
DI int TID() { int t = __builtin_amdgcn_workitem_id_x(); asm volatile("" : "+v"(t)); return t; }
DI float wave_sum(float v) {
#pragma unroll
    for (int o = 32; o >= 1; o >>= 1) v += __shfl_xor(v, o);
    return v;
}

struct Params {
    const float *x, *c, *ctx, *c_ctx, *w_ada, *b_ada, *g_norm, *w_ff1_in, *w_ff1_out, *w_ff2_in, *w_ff2_out, *w_in, *w_out, *g_q_a, *g_k_a, *lam_c,
        *g_sub_c, *g_v_b, *w_s_b, *b_s_b, *w_dw_d, *b_dw_d, *g_conv_d, *g_final;
    float* out;
    bf16_t *Wff1in, *Wff1out, *Wff2in, *Wff2out, *Win, *Wout, *Ws;
    float *mods, *ropeA, *ropeC, *hc;
    bf16_t *xn, *hid, *QA, *KA, *VtA, *QC, *KC, *VtC, *U, *VN, *Y, *cat;
    unsigned* bar;
};

DI void sincos_d(double x, double& s, double& c) {
    double k = rint(x * 0.15915494309189535);
    double r = fma(-k, 6.283185307179586, x);
    r = fma(-k, 2.4492935982947064e-16, r);
    double r2 = r * r, as = 1.0, ac = 1.0;
#pragma unroll
    for (int n = 14; n >= 1; --n) {
        as = 1.0 - r2 / (double)((2 * n) * (2 * n + 1)) * as;
        ac = 1.0 - r2 / (double)((2 * n - 1) * (2 * n)) * ac;
    }
    s = r * as; c = ac;
}

constexpr int T_FFIN = (D / 64) * (2 * DFF / 64), T_FFOUT = (DFF / 64) * (D / 64), T_WIN = (D / 64) * (INC / 64), T_WOUT = (D / 64) * (D / 64);
constexpr int T_LAYER = 2 * T_FFIN + 2 * T_FFOUT + T_WIN + T_WOUT;
constexpr int U_TR = DEPTH * T_LAYER, U_WS = 32, U_ADA = 288, U_ROPE = 192;
constexpr int U_P0 = U_TR + U_WS + U_ADA + U_ROPE;

DI void transpose_unit(const float* src, bf16_t* dst, int K, int N, int perm, int ti, float* tile) {
    const int tn = N / 64, kt = ti / tn, nt = ti % tn, k0 = kt * 64, n0 = nt * 64;
    int sc0 = n0;
    if (perm == 1) { int t = n0 >> 8, j = n0 & 255; sc0 = j < 128 ? t * 128 + j : DFF + t * 128 + (j - 128); }
    else if (perm == 2 && n0 >= 1792) { int m = n0 - 1792, t = m >> 8, j = m & 255; sc0 = j < 128 ? 1792 + t * 128 + j : 2048 + t * 128 + (j - 128); }
    const int t = TID();
    {
        const int kk = t >> 4, c4 = (t & 15) * 4;
#pragma unroll
        for (int i = 0; i < 2; ++i) {
            const int k = kk + 32 * i;
            f32x4 v = *(const f32x4*)(src + (size_t)(k0 + k) * N + sc0 + c4);
            tile[k * 65 + c4 + 0] = v[0]; tile[k * 65 + c4 + 1] = v[1]; tile[k * 65 + c4 + 2] = v[2]; tile[k * 65 + c4 + 3] = v[3];
        }
    }
    __syncthreads();
    {
        const int n = t >> 3, k8 = (t & 7) * 8;
        u32x4 o;
        o[0] = pk2(tile[(k8 + 0) * 65 + n], tile[(k8 + 1) * 65 + n]);
        o[1] = pk2(tile[(k8 + 2) * 65 + n], tile[(k8 + 3) * 65 + n]);
        o[2] = pk2(tile[(k8 + 4) * 65 + n], tile[(k8 + 5) * 65 + n]);
        o[3] = pk2(tile[(k8 + 6) * 65 + n], tile[(k8 + 7) * 65 + n]);
        *(u32x4*)(dst + (size_t)(n0 + n) * K + k0 + k8) = o;
    }
    __syncthreads();
}

DI void phase_prologue(const Params& p, char* smem) {
    const int t = TID();
    for (int u = blockIdx.x; u < U_P0; u += gridDim.x) {
        if (u < U_TR) {
            const int l = u / T_LAYER; int r = u % T_LAYER;
            const float* src; bf16_t* dst; int K, N, perm;
            if (r < T_FFIN) { src = p.w_ff1_in + (size_t)l * D * 2 * DFF; dst = p.Wff1in + (size_t)l * D * 2 * DFF; K = D; N = 2 * DFF; perm = 1; }
            else if ((r -= T_FFIN) < T_FFOUT) { src = p.w_ff1_out + (size_t)l * D * DFF; dst = p.Wff1out + (size_t)l * D * DFF; K = DFF; N = D; perm = 0; }
            else if ((r -= T_FFOUT) < T_FFIN) { src = p.w_ff2_in + (size_t)l * D * 2 * DFF; dst = p.Wff2in + (size_t)l * D * 2 * DFF; K = D; N = 2 * DFF; perm = 1; }
            else if ((r -= T_FFIN) < T_FFOUT) { src = p.w_ff2_out + (size_t)l * D * DFF; dst = p.Wff2out + (size_t)l * D * DFF; K = DFF; N = D; perm = 0; }
            else if ((r -= T_FFOUT) < T_WIN) { src = p.w_in + (size_t)l * D * INC; dst = p.Win + (size_t)l * D * INC; K = D; N = INC; perm = 2; }
            else { r -= T_WIN; src = p.w_out + (size_t)l * D * D; dst = p.Wout + (size_t)l * D * D; K = D; N = D; perm = 0; }
            transpose_unit(src, dst, K, N, perm, r, (float*)smem);
        } else if (u < U_TR + U_WS) {
            const int e0 = (u - U_TR) * 4096 + t * 8;
            f32x4 a = *(const f32x4*)(p.w_s_b + e0), b = *(const f32x4*)(p.w_s_b + e0 + 4);
            u32x4 o; o[0] = pk2(a[0], a[1]); o[1] = pk2(a[2], a[3]); o[2] = pk2(b[0], b[1]); o[3] = pk2(b[2], b[3]);
            *(u32x4*)(p.Ws + e0) = o;
        } else if (u < U_TR + U_WS + U_ADA) {
            const int uu = u - U_TR - U_WS, l = uu / 144, col0 = (uu % 144) * 64;
            float* s = (float*)smem;
            float* red = s + 17 * 1024;
            for (int i = t; i < 17 * 1024; i += NTHR) { const int r = i >> 10, k = i & 1023; const float v = r < 16 ? p.c[r * D + k] : p.c_ctx[k]; s[i] = silu_f(v); }
            __syncthreads();
            const int col = t & 63, ks = t >> 6;
            float acc[17];
#pragma unroll
            for (int r = 0; r < 17; ++r) acc[r] = 0.f;
            const float* w = p.w_ada + (size_t)l * D * MODW + (size_t)(ks * 128) * MODW + col0 + col;
            for (int k = 0; k < 128; ++k) {
                const float wv = w[(size_t)k * MODW];
#pragma unroll
                for (int r = 0; r < 17; ++r) acc[r] += s[r * 1024 + ks * 128 + k] * wv;
            }
#pragma unroll
            for (int r = 0; r < 17; ++r) red[(ks * 17 + r) * 64 + col] = acc[r];
            __syncthreads();
            for (int i = t; i < 17 * 64; i += NTHR) {
                const int r = i >> 6, cc = i & 63; float sum = 0.f;
#pragma unroll
                for (int q = 0; q < 8; ++q) sum += red[(q * 17 + r) * 64 + cc];
                p.mods[((size_t)l * 17 + r) * MODW + col0 + cc] = sum + p.b_ada[(size_t)l * MODW + col0 + cc];
            }
            __syncthreads();
        } else {
            const int e = (u - U_TR - U_WS - U_ADA) * 512 + t;
            const int pos = e / 48, j = e % 48, row = pos >> 6, col = pos & 63;
            float ang; float* dst;
            if (j < 32) { const float inv = exp2f(-(float)(j & 15) * (13.287712379549449f / 16.f)); ang = (float)(j < 16 ? row : col) * inv; dst = p.ropeA + ((size_t)pos * 32 + j) * 2; }
            else { const int jj = j - 32; const float inv = exp2f(-(float)(jj & 7) * (13.287712379549449f / 8.f)); ang = (float)(jj < 8 ? row : col) * inv; dst = p.ropeC + ((size_t)pos * 16 + jj) * 2; }
            double sn, cs; sincos_d((double)ang, sn, cs);
            dst[0] = (float)cs; dst[1] = (float)sn;
        }
    }
}

template <bool FINAL>
DI void phase_norm(const Params& p, const float* lat, const float* cx, const float* g, const float* mods_l, int mi, int nrows) {
    const int wid = TID() >> 6, lane = TID() & 63;
    for (int u = blockIdx.x; u < nrows / 8; u += gridDim.x) {
        const int row = u * 8 + wid;
        const float* src = row < NLAT ? lat + (size_t)row * D : cx + (size_t)(row - NLAT) * D;
        const int mb = row < NLAT ? row / SEQ : 16;
        f32x4 v[4]; float ss = 0.f;
#pragma unroll
        for (int i = 0; i < 4; ++i) { v[i] = *(const f32x4*)(src + i * 256 + lane * 4); ss += v[i][0] * v[i][0] + v[i][1] * v[i][1] + v[i][2] * v[i][2] + v[i][3] * v[i][3]; }
        ss = wave_sum(ss);
        const float rstd = rsqrtf(ss * (1.f / D) + EPS);
        if (FINAL) {
#pragma unroll
            for (int i = 0; i < 4; ++i) { const int col = i * 256 + lane * 4; const f32x4 gv = *(const f32x4*)(g + col); *(f32x4*)(p.out + (size_t)row * D + col) = v[i] * rstd * gv; }
        } else {
            const float* sh = mods_l + (size_t)mb * MODW + mi * D; const float* scl = sh + D;
#pragma unroll
            for (int i = 0; i < 4; ++i) {
                const int col = i * 256 + lane * 4;
                const f32x4 gv = *(const f32x4*)(g + col), sv = *(const f32x4*)(scl + col), bv = *(const f32x4*)(sh + col);
                const f32x4 o = v[i] * rstd * gv * (1.f + sv) + bv;
                u32x2 w; w[0] = pk2(o[0], o[1]); w[1] = pk2(o[2], o[3]);
                *(u32x2*)(p.xn + (size_t)row * D + col) = w;
            }
        }
    }
}

constexpr int BM = 256, BK = 64, HALF = 128, HT = HALF * BK, NXCD = 8, WGM = 8;
DI int lds_byte(int r, int c) { const int st = (r >> 4) * 2 + (c >> 5), rr = r & 15, cc = c & 31, ob = rr * 64 + cc * 2; return st * 1024 + (ob ^ (((ob >> 9) & 1) << 5)); }
DI void stage_rc(int b, int& R, int& C) { const int st = b / 1024, sb = b % 1024, swz = sb ^ (((sb >> 9) & 1) << 5); R = (st >> 1) * 16 + swz / 64; C = (st & 1) * 32 + (swz % 64) / 2; }

#define LAS __attribute__((address_space(3)))
constexpr int HTB = HALF * BK * 2;
DI void gemm_tile(const bf16_t* A, const bf16_t* Bt, int K, int brow, int bcol, f32x4 (&acc)[2][2][4][2], LAS unsigned char* lds) {
    const int tid = TID(), wid = __builtin_amdgcn_readfirstlane(tid >> 6), lane = tid & 63, wr = wid >> 2, wc = wid & 3, fr = lane & 15, fq = lane >> 4;
    const int nt = K / BK;
    unsigned voff[2];
#pragma unroll
    for (int i = 0; i < 2; ++i) { int R, C; stage_rc(tid * 16 + i * 8192, R, C); voff[i] = (unsigned)(R * K + C) * 2u; }
    const size_t kstep = (size_t)(BK * 2), hstep = (size_t)HALF * K * 2;
    const unsigned ldsw = (unsigned)wid * 1024u;
    const int aoff = lds_byte(wr * 64 + fr, fq * 8), boff = lds_byte(wc * 32 + fr, fq * 8);
#define SA(b, h) (((b) * 2 + (h)) * HTB)
#define SB(b, h) ((4 + (b) * 2 + (h)) * HTB)
#define STAGE(bufoff, gbase) do { _Pragma("unroll") for (int _i = 0; _i < 2; ++_i) \
        __builtin_amdgcn_global_load_lds((const unsigned*)((const char*)(gbase) + voff[_i]), (LAS unsigned*)(lds + (bufoff) + ldsw + _i * 8192), 16, 0, 0); } while (0)
#define LDA(dst, b, h) do { _Pragma("unroll") for (int m = 0; m < 4; ++m) _Pragma("unroll") for (int k = 0; k < 2; ++k) dst[m][k] = *(const LAS bf16x8*)(lds + SA(b, h) + aoff + m * 2048 + k * 1024); } while (0)
#define LDB(dst, b, h) do { _Pragma("unroll") for (int n = 0; n < 2; ++n) _Pragma("unroll") for (int k = 0; k < 2; ++k) dst[n][k] = *(const LAS bf16x8*)(lds + SB(b, h) + boff + n * 2048 + k * 1024); } while (0)
#define MMA(ai, bj, At_, Bt_) do { __builtin_amdgcn_s_setprio(1); _Pragma("unroll") for (int m = 0; m < 4; ++m) _Pragma("unroll") for (int n = 0; n < 2; ++n) _Pragma("unroll") for (int k = 0; k < 2; ++k) \
        acc[ai][bj][m][n] = __builtin_amdgcn_mfma_f32_16x16x32_bf16(Bt_[n][k], At_[m][k], acc[ai][bj][m][n], 0, 0, 0); __builtin_amdgcn_s_setprio(0); } while (0)
#define WAIT_V(n) asm volatile("s_waitcnt vmcnt(" #n ")" ::: "memory")
#define WAIT_L(n) asm volatile("s_waitcnt lgkmcnt(" #n ")" ::: "memory")
#define BAR __builtin_amdgcn_s_barrier()
#define SCHED __builtin_amdgcn_sched_barrier(0)
#pragma unroll
    for (int a = 0; a < 2; ++a)
#pragma unroll
        for (int b = 0; b < 2; ++b)
#pragma unroll
            for (int m = 0; m < 4; ++m)
#pragma unroll
                for (int n = 0; n < 2; ++n) acc[a][b][m][n] = (f32x4){0.f, 0.f, 0.f, 0.f};
    bf16x8 At[4][2], B0[2][2], B1[2][2];
    const char* cA = (const char*)A + (size_t)brow * K * 2; const char* cB = (const char*)Bt + (size_t)bcol * K * 2;
    STAGE(SB(0, 0), cB); STAGE(SA(0, 0), cA); STAGE(SB(0, 1), cB + hstep); STAGE(SA(0, 1), cA + hstep);
    if (wr == 1) BAR;
    WAIT_V(4); BAR;
    STAGE(SB(1, 0), cB + kstep); STAGE(SA(1, 0), cA + kstep); STAGE(SB(1, 1), cB + hstep + kstep);
    WAIT_V(6); BAR;
    for (int t = 0; t < nt - 2; t += 2) {
        const char* a1 = cA + (size_t)(t + 1) * kstep; const char* a2 = cA + (size_t)(t + 2) * kstep; const char* b2 = cB + (size_t)(t + 2) * kstep;
        const char* a3 = a2 + kstep; const char* b3 = b2 + kstep;
        LDB(B0, 0, 0); SCHED; LDA(At, 0, 0); STAGE(SA(1, 1), a1 + hstep);
        WAIT_L(8); BAR; WAIT_L(0); MMA(0, 0, At, B0); BAR; SCHED;
        LDB(B1, 0, 1); STAGE(SB(0, 0), b2);
        BAR; WAIT_L(0); MMA(0, 1, At, B1); BAR;
        LDA(At, 0, 1); STAGE(SA(0, 0), a2);
        BAR; WAIT_L(0); MMA(1, 0, At, B0); BAR; SCHED;
        STAGE(SB(0, 1), b2 + hstep);
        WAIT_V(6); BAR; MMA(1, 1, At, B1); BAR;
        LDB(B0, 1, 0); SCHED; LDA(At, 1, 0); STAGE(SA(0, 1), a2 + hstep);
        WAIT_L(8); BAR; WAIT_L(0); MMA(0, 0, At, B0); BAR; SCHED;
        LDB(B1, 1, 1); STAGE(SB(1, 0), b3);
        BAR; WAIT_L(0); MMA(0, 1, At, B1); BAR;
        LDA(At, 1, 1); STAGE(SA(1, 0), a3);
        BAR; WAIT_L(0); MMA(1, 0, At, B0); BAR; SCHED;
        STAGE(SB(1, 1), b3 + hstep);
        WAIT_V(6); BAR; MMA(1, 1, At, B1); BAR;
    }
    { LDB(B0, 0, 0); LDA(At, 0, 0); STAGE(SA(1, 1), cA + (size_t)(nt - 1) * kstep + hstep);
      BAR; WAIT_L(0); MMA(0, 0, At, B0); BAR;
      LDB(B1, 0, 1); BAR; WAIT_L(0); MMA(0, 1, At, B1); BAR;
      LDA(At, 0, 1); WAIT_V(4); BAR; WAIT_L(0); MMA(1, 0, At, B0); MMA(1, 1, At, B1); BAR; }
    { LDB(B0, 1, 0); LDA(At, 1, 0); WAIT_V(2); BAR; WAIT_L(0); MMA(0, 0, At, B0); BAR;
      LDB(B1, 1, 1); WAIT_V(0); BAR; WAIT_L(0); MMA(0, 1, At, B1); BAR;
      LDA(At, 1, 1); BAR; WAIT_L(0); MMA(1, 0, At, B0); MMA(1, 1, At, B1); BAR; }
    if (wr == 0) BAR;
}

DI void tile_order(int L, int nM, int nN, int& pm, int& pn) {
    const int nwg = nM * nN; int wgid = L;
    { const int q = nwg / NXCD, r = nwg % NXCD, xcd = wgid % NXCD, off = wgid / NXCD; wgid = (xcd < r ? xcd * (q + 1) : r * (q + 1) + (xcd - r) * q) + off; }
    const int nig = WGM * nN, gid = wgid / nig, fm = gid * WGM, gsz = (nM - fm) < WGM ? (nM - fm) : WGM;
    pm = fm + ((wgid % nig) % gsz); pn = (wgid % nig) / gsz;
}

struct EpiSwiglu {
    bf16_t* hid;
    DI void operator()(f32x4 (&acc)[2][2][4][2], int pm, int pn, char* smem) const {
        const int wid = TID() >> 6, lane = TID() & 63, wr = wid >> 2, wc = wid & 3, fr = lane & 15, fq = lane >> 4;
#pragma unroll
        for (int ai = 0; ai < 2; ++ai)
#pragma unroll
            for (int m = 0; m < 4; ++m) {
                const int row = pm * BM + ai * HALF + wr * 64 + m * 16 + fr;
#pragma unroll
                for (int n = 0; n < 2; ++n) {
                    const f32x4 a = acc[ai][0][m][n], b = acc[ai][1][m][n];
                    u32x2 w; w[0] = pk2(silu_f(a[0]) * b[0], silu_f(a[1]) * b[1]); w[1] = pk2(silu_f(a[2]) * b[2], silu_f(a[3]) * b[3]);
                    *(u32x2*)(hid + (size_t)row * DFF + pn * 128 + wc * 32 + n * 16 + fq * 4) = w;
                }
            }
    }
};
struct EpiResid {
    const float *lat_in, *cx_in; float *lat_out, *cx_out; const float* gate; float gs;
    DI void operator()(f32x4 (&acc)[2][2][4][2], int pm, int pn, char* smem) const {
        const int wid = TID() >> 6, lane = TID() & 63, wr = wid >> 2, wc = wid & 3, fr = lane & 15, fq = lane >> 4;
        const int row0 = pm * BM; const bool islat = row0 < NLAT;
        const size_t base = (size_t)(islat ? row0 : row0 - NLAT) * D + (size_t)(wr * 64 + fr) * D + pn * BM + wc * 32 + fq * 4;
        const float* in = (islat ? lat_in : cx_in) + base;
        float* out = (islat ? lat_out : cx_out) + base;
        const float* gt = gate + (size_t)(islat ? row0 / SEQ : 16) * MODW + pn * BM + wc * 32 + fq * 4;
        f32x4 gv[2][2];
#pragma unroll
        for (int bj = 0; bj < 2; ++bj)
#pragma unroll
            for (int n = 0; n < 2; ++n) gv[bj][n] = *(const f32x4*)(gt + bj * HALF + n * 16) * gs;
#pragma unroll
        for (int ai = 0; ai < 2; ++ai)
#pragma unroll
            for (int m = 0; m < 4; ++m) {
                const size_t ro = (size_t)(ai * HALF + m * 16) * D;
                f32x4 hv[2][2];
#pragma unroll
                for (int bj = 0; bj < 2; ++bj)
#pragma unroll
                    for (int n = 0; n < 2; ++n) hv[bj][n] = *(const f32x4*)(in + ro + bj * HALF + n * 16);
#pragma unroll
                for (int bj = 0; bj < 2; ++bj)
#pragma unroll
                    for (int n = 0; n < 2; ++n) *(f32x4*)(out + ro + bj * HALF + n * 16) = hv[bj][n] + gv[bj][n] * acc[ai][bj][m][n];
                if (m & 1) __builtin_amdgcn_sched_barrier(0);
            }
    }
};
constexpr int TS = 257;
struct EpiProj {
    const Params* pp; int l;
    DI void operator()(f32x4 (&acc)[2][2][4][2], int pm, int pn, char* smem) const {
        const Params& p = *pp;
        float* T = (float*)smem;
        const int tid = TID(), wid = tid >> 6, lane = tid & 63, wr = wid >> 2, wc = wid & 3, fr = lane & 15, fq = lane >> 4;
#pragma unroll
        for (int ai = 0; ai < 2; ++ai) {
            __syncthreads();
#pragma unroll
            for (int bj = 0; bj < 2; ++bj)
#pragma unroll
                for (int m = 0; m < 4; ++m)
#pragma unroll
                    for (int n = 0; n < 2; ++n)
#pragma unroll
                        for (int j = 0; j < 4; ++j) T[(wr * 64 + m * 16 + fr) * TS + bj * HALF + wc * 32 + n * 16 + fq * 4 + j] = acc[ai][bj][m][n][j];
            __syncthreads();
            const int rl = tid & 127, seg = tid >> 7, grow = pm * BM + ai * HALF + rl;
            const bool islat = grow < NLAT;
            const int b = islat ? grow / SEQ : (grow - NLAT) / CTX;
            const int pos = islat ? grow % SEQ : SEQ + (grow - NLAT) % CTX;
            const float* xr = T + rl * TS + seg * 64;
            if (pn == 0 || (pn == 2 && seg < 2)) {
                const float* g = (pn == 0 ? p.g_q_a : p.g_k_a) + l * 64;
                bf16_t* dst = pn == 0 ? p.QA + ((size_t)(b * 4 + seg) * KEYS + pos) * 64 : p.KA + ((size_t)(b * 2 + seg) * KEYS + pos) * 64;
                float ss = 0.f;
                for (int i = 0; i < 64; ++i) ss += xr[i] * xr[i];
                const float rstd = rsqrtf(ss * (1.f / 64.f) + EPS);
                const float* rp = p.ropeA + (size_t)(islat ? pos : 0) * 64;
                for (int i0 = 0; i0 < 32; i0 += 8) {
                    float o1[8], o2[8];
#pragma unroll
                    for (int i = 0; i < 8; ++i) {
                        const float a = xr[i0 + i] * rstd * g[i0 + i], bb = xr[i0 + i + 32] * rstd * g[i0 + i + 32];
                        float cs = 1.f, sn = 0.f;
                        if (islat) { cs = rp[(i0 + i) * 2]; sn = rp[(i0 + i) * 2 + 1]; }
                        o1[i] = a * cs - bb * sn; o2[i] = a * sn + bb * cs;
                    }
                    u32x4 w1, w2;
#pragma unroll
                    for (int i = 0; i < 4; ++i) { w1[i] = pk2(o1[2 * i], o1[2 * i + 1]); w2[i] = pk2(o2[2 * i], o2[2 * i + 1]); }
                    *(u32x4*)(dst + i0) = w1; *(u32x4*)(dst + 32 + i0) = w2;
                }
            } else if (pn == 1 || pn == 3) {
                bf16_t* base = (pn == 1 ? p.QC : p.KC);
                const float* rp = p.ropeC + (size_t)(islat ? pos : 0) * 32;
#pragma unroll
                for (int mp = 0; mp < 2; ++mp) {
                    bf16_t* dst = base + ((size_t)((b * 4 + seg) * 2 + mp) * KEYS + pos) * 32;
                    for (int i0 = 0; i0 < 16; i0 += 8) {
                        float o1[8], o2[8];
#pragma unroll
                        for (int i = 0; i < 8; ++i) {
                            const float a = xr[mp * 32 + i0 + i], bb = xr[mp * 32 + i0 + i + 16];
                            float cs = 1.f, sn = 0.f;
                            if (islat) { cs = rp[(i0 + i) * 2]; sn = rp[(i0 + i) * 2 + 1]; }
                            o1[i] = a * cs - bb * sn; o2[i] = a * sn + bb * cs;
                        }
                        u32x4 w1, w2;
#pragma unroll
                        for (int i = 0; i < 4; ++i) { w1[i] = pk2(o1[2 * i], o1[2 * i + 1]); w2[i] = pk2(o2[2 * i], o2[2 * i + 1]); }
                        *(u32x4*)(dst + i0) = w1; *(u32x4*)(dst + 16 + i0) = w2;
                    }
                }
            } else if (pn == 2 || pn == 4) {
                bf16_t* dst = pn == 2 ? p.VtA + ((size_t)(b * 2 + (seg - 2)) * 64) * KEYS + pos : p.VtC + ((size_t)(b * 4 + seg) * 64) * KEYS + pos;
                for (int d = 0; d < 64; ++d) dst[(size_t)d * KEYS] = f2bf(xr[d]);
            } else if (pn == 5) {
                bf16_t* dst = p.U + (size_t)grow * 256 + seg * 64;
                for (int i0 = 0; i0 < 64; i0 += 8) {
                    u32x4 w;
#pragma unroll
                    for (int i = 0; i < 4; ++i) w[i] = pk2(gelu_f(xr[i0 + 2 * i]), gelu_f(xr[i0 + 2 * i + 1]));
                    *(u32x4*)(dst + i0) = w;
                }
            } else if (pn == 6) {
                const float* xrow = T + rl * TS; float ss = 0.f;
                for (int i = 0; i < 256; ++i) { const float gv = gelu_f(xrow[i]); ss += gv * gv; }
                const float rstd = rsqrtf(ss * (1.f / 256.f) + EPS);
                const float* g = p.g_v_b + l * 256 + seg * 64;
                bf16_t* dst = p.VN + (size_t)grow * 256 + seg * 64;
                for (int i0 = 0; i0 < 64; i0 += 8) {
                    u32x4 w;
#pragma unroll
                    for (int i = 0; i < 4; ++i) w[i] = pk2(gelu_f(xr[i0 + 2 * i]) * rstd * g[i0 + 2 * i], gelu_f(xr[i0 + 2 * i + 1]) * rstd * g[i0 + 2 * i + 1]);
                    *(u32x4*)(dst + i0) = w;
                }
            } else {
                if (seg < 2) {
                    const float* gr = xr + 128;
                    bf16_t* dst = p.Y + (size_t)grow * 256 + (pn - 7) * 128 + seg * 64;
                    for (int i0 = 0; i0 < 64; i0 += 8) {
                        u32x4 w;
#pragma unroll
                        for (int i = 0; i < 4; ++i) w[i] = pk2(xr[i0 + 2 * i] * sigmoid_f(gr[i0 + 2 * i]), xr[i0 + 2 * i + 1] * sigmoid_f(gr[i0 + 2 * i + 1]));
                        *(u32x4*)(dst + i0) = w;
                    }
                }
            }
        }
        __syncthreads();
    }
};

template <class Epi>
DI void phase_gemm(const bf16_t* A, const bf16_t* Bt, int M, int N, int K, const Epi& epi, char* smem) {
    const int nM = M / BM, nN = N / BM, nwg = nM * nN;
    for (int L = blockIdx.x; L < nwg; L += gridDim.x) {
        int pm, pn; tile_order(L, nM, nN, pm, pn);
        f32x4 acc[2][2][4][2];
        gemm_tile(A, Bt, K, pm * BM, pn * BM, acc, (LAS unsigned char*)smem);
        epi(acc, pm, pn, smem);
    }
}

constexpr int VROW = 144;
template <int DQK>
DI void attn_core(const bf16_t* Q, const bf16_t* Kg, const bf16_t* Vt, int qpos0, int key_lo, int nkt, float sc, f32x16 (&O)[2], char* smem) {
    constexpr int KROW = DQK * 2 + 16, KBUF = 64 * KROW, VBUF = 64 * VROW, NKS = DQK / 16;
    char* kb_[2] = {smem, smem + KBUF};
    char* vb_[2] = {smem + 2 * KBUF, smem + 2 * KBUF + VBUF};
    const int tid = TID(), lane = tid & 63, wid = tid >> 6, r = lane & 31, h = lane >> 5;
    bf16x8 qf[NKS];
#pragma unroll
    for (int ks = 0; ks < NKS; ++ks) qf[ks] = *(const bf16x8*)(Q + (size_t)(qpos0 + wid * 32 + r) * DQK + ks * 16 + 8 * h);
#pragma unroll
    for (int i = 0; i < 16; ++i) { O[0][i] = 0.f; O[1][i] = 0.f; }
    float m_run = -1e30f, l_run = 0.f;
    constexpr int KCH = DQK / 8;
    const bool kact = tid < 64 * KCH;
    const int kkey = tid / KCH, kch = tid % KCH, vd = tid >> 3, vch = tid & 7;
    u32x4 kreg = {0, 0, 0, 0}, vreg;
    auto gload = [&](int t) {
        const int key0 = key_lo + t * 64;
        if (kact) kreg = *(const u32x4*)(Kg + (size_t)(key0 + kkey) * DQK + kch * 8);
        vreg = *(const u32x4*)(Vt + (size_t)vd * KEYS + key0 + vch * 8);
    };
    auto lstore = [&](int bsel) {
        if (kact) *(u32x4*)(kb_[bsel] + kkey * KROW + kch * 16) = kreg;
        *(u32x4*)(vb_[bsel] + vd * VROW + vch * 16) = vreg;
    };
    __syncthreads();
    gload(0); lstore(0);
    __syncthreads();
    for (int t = 0; t < nkt; ++t) {
        const int cur = t & 1;
        if (t + 1 < nkt) gload(t + 1);
        const char* kb = kb_[cur]; const char* vb = vb_[cur];
#pragma unroll
        for (int kk = 0; kk < 2; ++kk) {
            f32x16 s;
#pragma unroll
            for (int i = 0; i < 16; ++i) s[i] = 0.f;
#pragma unroll
            for (int ks = 0; ks < NKS; ++ks) {
                const bf16x8 kf = *(const bf16x8*)(kb + (kk * 32 + r) * KROW + ks * 32 + 16 * h);
                s = __builtin_amdgcn_mfma_f32_32x32x16_bf16(kf, qf[ks], s, 0, 0, 0);
            }
            float mx = s[0];
#pragma unroll
            for (int i = 1; i < 16; ++i) mx = fmaxf(mx, s[i]);
            mx = fmaxf(mx, __shfl_xor(mx, 32));
            const float m_new = fmaxf(m_run, mx * sc);
            const float alpha = __builtin_amdgcn_exp2f(m_run - m_new);
            m_run = m_new;
            float ps = 0.f;
#pragma unroll
            for (int i = 0; i < 16; ++i) { s[i] = __builtin_amdgcn_exp2f(s[i] * sc - m_new); ps += s[i]; }
            l_run = l_run * alpha + ps;
#pragma unroll
            for (int i = 0; i < 16; ++i) { O[0][i] *= alpha; O[1][i] *= alpha; }
#pragma unroll
            for (int st = 0; st < 2; ++st) {
                u32x4 pw;
#pragma unroll
                for (int i = 0; i < 4; ++i) pw[i] = pk2(s[8 * st + 2 * i], s[8 * st + 2 * i + 1]);
                const bf16x8 pf = __builtin_bit_cast(bf16x8, pw);
#pragma unroll
                for (int dt = 0; dt < 2; ++dt) {
                    const char* vp = vb + (dt * 32 + r) * VROW + (kk * 32 + 16 * st + 4 * h) * 2;
                    const u32x2 lo = *(const u32x2*)vp, hi = *(const u32x2*)(vp + 16);
                    u32x4 vw = {lo[0], lo[1], hi[0], hi[1]};
                    O[dt] = __builtin_amdgcn_mfma_f32_32x32x16_bf16(__builtin_bit_cast(bf16x8, vw), pf, O[dt], 0, 0, 0);
                }
            }
        }
        if (t + 1 < nkt) lstore(cur ^ 1);
        __syncthreads();
    }
    const float lt = l_run + __shfl_xor(l_run, 32);
    const float inv = 1.f / lt;
#pragma unroll
    for (int i = 0; i < 16; ++i) { O[0][i] *= inv; O[1][i] *= inv; }
}

DI void store_OT(const f32x16 (&O)[2], bf16_t* dst  , int h) {
#pragma unroll
    for (int dt = 0; dt < 2; ++dt)
#pragma unroll
        for (int gq = 0; gq < 4; ++gq) {
            u32x2 w; w[0] = pk2(O[dt][4 * gq], O[dt][4 * gq + 1]); w[1] = pk2(O[dt][4 * gq + 2], O[dt][4 * gq + 3]);
            *(u32x2*)(dst + dt * 32 + 8 * gq + 4 * h) = w;
        }
}

DI void attn_unit(const Params& p, int l, int uidx, bool isC, int nqb, char* smem) {
    const int qb = uidx % nqb, bh = uidx / nqb, head = bh & 3, b = bh >> 2;
    const int lane = TID() & 63, wid = TID() >> 6, r = lane & 31, h = lane >> 5;
    const int qpos0 = qb < 8 ? qb * 256 : SEQ, key_lo = qb < 8 ? 0 : SEQ, nkt = qb < 8 ? KEYS / 64 : CTX / 64;
    const int qpos = qpos0 + wid * 32 + r;
    const size_t grow = qpos < SEQ ? (size_t)b * SEQ + qpos : (size_t)NLAT + b * CTX + (qpos - SEQ);
    if (!isC) {
        f32x16 O[2];
        attn_core<64>(p.QA + (size_t)(b * 4 + head) * KEYS * 64, p.KA + (size_t)(b * 2 + (head >> 1)) * KEYS * 64, p.VtA + (size_t)(b * 2 + (head >> 1)) * 64 * KEYS,
                      qpos0, key_lo, nkt, 0.125f * 1.4426950408889634f, O, smem);
        store_OT(O, p.cat + grow * D + head * 64, h);
    } else {
        const float lam_init = 0.8f - 0.6f * __expf(-0.3f * (float)l);
        float d0 = 0.f, d1 = 0.f;
        const float* lp = p.lam_c + l * 128;
        for (int i = 0; i < 32; ++i) { d0 += lp[i] * lp[32 + i]; d1 += lp[64 + i] * lp[96 + i]; }
        const float lam = __expf(d0) - __expf(d1) + lam_init;
        const bf16_t* Vt = p.VtC + (size_t)(b * 4 + head) * 64 * KEYS;
        f32x16 O0[2], O1[2];
        attn_core<32>(p.QC + (size_t)((b * 4 + head) * 2 + 0) * KEYS * 32, p.KC + (size_t)((b * 4 + head) * 2 + 0) * KEYS * 32, Vt, qpos0, key_lo, nkt,
                      0.17677669529663687f * 1.4426950408889634f, O0, smem);
        attn_core<32>(p.QC + (size_t)((b * 4 + head) * 2 + 1) * KEYS * 32, p.KC + (size_t)((b * 4 + head) * 2 + 1) * KEYS * 32, Vt, qpos0, key_lo, nkt,
                      0.17677669529663687f * 1.4426950408889634f, O1, smem);
        float ss = 0.f;
#pragma unroll
        for (int dt = 0; dt < 2; ++dt)
#pragma unroll
            for (int i = 0; i < 16; ++i) { const float v = O0[dt][i] - lam * O1[dt][i]; O0[dt][i] = v; ss += v * v; }
        ss += __shfl_xor(ss, 32);
        const float rstd = rsqrtf(ss * (1.f / 64.f) + EPS) * (1.f - lam_init);
        const float* g = p.g_sub_c + l * 64;
#pragma unroll
        for (int dt = 0; dt < 2; ++dt)
#pragma unroll
            for (int i = 0; i < 16; ++i) O0[dt][i] *= rstd * g[dt * 32 + 8 * (i >> 2) + 4 * h + (i & 3)];
        store_OT(O0, p.cat + grow * D + 256 + head * 64, h);
    }
}

DI void gmlp_unit(const Params& p, int l, int uidx, char* smem) {
    const int g = uidx & 3, c = uidx >> 2, tid = TID(), lane = tid & 63, wid = tid >> 6, fr = lane & 15, fq = lane >> 4;
    bf16_t* vT = (bf16_t*)smem;
    constexpr int VS = 136;
    __syncthreads();
    {
        const int q = tid >> 2, d0 = (tid & 3) * 16;
        const bf16_t* src = p.VN + (size_t)(c * 128 + q) * 256 + g * 64 + d0;
        const bf16x8 a = *(const bf16x8*)src, bb = *(const bf16x8*)(src + 8);
#pragma unroll
        for (int j = 0; j < 8; ++j) { vT[(d0 + j) * VS + q] = (bf16_t)a[j]; vT[(d0 + 8 + j) * VS + q] = (bf16_t)bb[j]; }
    }
    __syncthreads();
    f32x4 acc[4];
#pragma unroll
    for (int n = 0; n < 4; ++n) acc[n] = (f32x4){0.f, 0.f, 0.f, 0.f};
    const bf16_t* wrow = p.Ws + ((size_t)(l * 4 + g) * 128 + wid * 16 + fr) * 128;
#pragma unroll
    for (int ks = 0; ks < 4; ++ks) {
        const bf16x8 af = *(const bf16x8*)(wrow + ks * 32 + fq * 8);
#pragma unroll
        for (int n = 0; n < 4; ++n) {
            const bf16x8 bfv = *(const bf16x8*)(vT + (n * 16 + fr) * VS + ks * 32 + fq * 8);
            acc[n] = __builtin_amdgcn_mfma_f32_16x16x32_bf16(bfv, af, acc[n], 0, 0, 0);
        }
    }
    const int prow = wid * 16 + fr; const size_t grow = (size_t)c * 128 + prow;
    const float bias = p.b_s_b[(l * 4 + g) * 128 + prow];
#pragma unroll
    for (int n = 0; n < 4; ++n) {
        const int col = g * 64 + n * 16 + fq * 4;
        const u32x2 uu = *(const u32x2*)(p.U + grow * 256 + col);
        u32x2 w;
        w[0] = pk2(bflo(uu[0]) * (acc[n][0] + bias), bfhi(uu[0]) * (acc[n][1] + bias));
        w[1] = pk2(bflo(uu[1]) * (acc[n][2] + bias), bfhi(uu[1]) * (acc[n][3] + bias));
        *(u32x2*)(p.cat + grow * D + 512 + col) = w;
    }
}

DI void conv_unit(const Params& p, int l, int uidx, char* smem) {
    const int tid = TID(), lane = tid & 63, wid = tid >> 6;
    bf16_t* yin = (bf16_t*)smem;
    float* co = (float*)(smem + 94 * 256 * 2);
    const int row0 = uidx * 64;
    int s0, s1;
    if (row0 < NLAT) { s0 = (row0 / SEQ) * SEQ; s1 = s0 + SEQ; } else { s0 = NLAT + ((row0 - NLAT) / CTX) * CTX; s1 = s0 + CTX; }
    __syncthreads();
    for (int i = tid; i < 94 * 32; i += NTHR) {
        const int rr = i >> 5, ch8 = (i & 31) * 8, gr = row0 - 15 + rr;
        u32x4 v = {0, 0, 0, 0};
        if (gr >= s0 && gr < s1) v = *(const u32x4*)(p.Y + (size_t)gr * 256 + ch8);
        *(u32x4*)(yin + rr * 256 + ch8) = v;
    }
    __syncthreads();
    {
        const int ch = tid & 255, th = tid >> 8;
        float w[31];
#pragma unroll
        for (int k = 0; k < 31; ++k) w[k] = p.w_dw_d[(size_t)(l * 31 + k) * 256 + ch];
        const float bias = p.b_dw_d[l * 256 + ch];
        for (int i = th * 32; i < th * 32 + 32; ++i) {
            float a = bias;
#pragma unroll
            for (int k = 0; k < 31; ++k) a += w[k] * bf2f(yin[(i + k) * 256 + ch]);
            co[i * 256 + ch] = a;
        }
    }
    __syncthreads();
#pragma unroll
    for (int j = 0; j < 8; ++j) {
        const int tk = wid * 8 + j;
        const f32x4 v = *(const f32x4*)(co + tk * 256 + lane * 4);
        const float ss = wave_sum(v[0] * v[0] + v[1] * v[1] + v[2] * v[2] + v[3] * v[3]);
        const float rstd = rsqrtf(ss * (1.f / 256.f) + EPS);
        const f32x4 g = *(const f32x4*)(p.g_conv_d + l * 256 + lane * 4);
        u32x2 w; w[0] = pk2(silu_f(v[0] * rstd * g[0]), silu_f(v[1] * rstd * g[1])); w[1] = pk2(silu_f(v[2] * rstd * g[2]), silu_f(v[3] * rstd * g[3]));
        *(u32x2*)(p.cat + (size_t)(row0 + tk) * D + 768 + lane * 4) = w;
    }
}

DI void phase_mixers(const Params& p, int l, bool withctx, char* smem) {
    const int nqb = withctx ? 9 : 8;
    const int nC = NB * 4 * nqb, nA = nC, nG = (withctx ? NTOK : NLAT) / 128 * 4, nV = (withctx ? NTOK : NLAT) / 64;
    const int total = nC + nA + nG + nV;
    for (int u = blockIdx.x; u < total; u += gridDim.x) {
        asm volatile("" : "+s"(l));
        if (u < nC) attn_unit(p, l, u, true, nqb, smem);
        else if (u < nC + nA) attn_unit(p, l, u - nC, false, nqb, smem);
        else if (u < nC + nA + nG) gmlp_unit(p, l, u - nC - nA, smem);
        else conv_unit(p, l, u - nC - nA - nG, smem);
    }
}

#define XB_TMO      128
#define XB_XCNT(j)  (256  + 64 * (j))
#define XB_XSUB(j)  (1280 + 64 * (j))
#define XB_XGEN(j)  (2304 + 64 * (j))
#define XB_TOP      3328
#define XB_TOPGEN   3392
#define XCD_BAR_WORDS 3456
#define XB_SPIN_CAP (1u << 22)
DI unsigned xb_ld(unsigned* p) { return __hip_atomic_load(p, __ATOMIC_RELAXED, __HIP_MEMORY_SCOPE_AGENT); }
DI unsigned xb_add(unsigned* p, unsigned v) { return __hip_atomic_fetch_add(p, v, __ATOMIC_RELAXED, __HIP_MEMORY_SCOPE_AGENT); }
DI unsigned xb_xcc_id() { return (unsigned)__builtin_amdgcn_s_getreg((3 << 11) | 20) & 0xFu; }
#define XB_SPIN(cond, bar) do { unsigned _sp = 0; while (cond) { __builtin_amdgcn_s_sleep(1); \
    if ((++_sp & 255u) == 0u) { if (xb_ld(&(bar)[XB_TMO])) break; if (_sp > XB_SPIN_CAP) { atomicAdd(&(bar)[XB_TMO], 1u); break; } } } } while (0)
DI void xcd_barrier_complete(unsigned* bar, unsigned x, unsigned& nloc, unsigned& nx) {
    const unsigned G = gridDim.x;
    unsigned sum, cnt, mine, sp = 0u;
    for (;;) {
        sum = 0u; cnt = 0u; mine = 0u;
#pragma unroll
        for (unsigned j = 0; j < 16; ++j) { const unsigned c = xb_ld(&bar[XB_XCNT(j)]); sum += c; cnt += (c > 0u) ? 1u : 0u; mine = (j == x) ? c : mine; }
        if (sum == G) break;
        __builtin_amdgcn_s_sleep(1);
        if ((++sp & 255u) == 0u) { if (xb_ld(&bar[XB_TMO])) break; if (sp > XB_SPIN_CAP) { atomicAdd(&bar[XB_TMO], 1u); break; } }
    }
    nloc = mine > 0u ? mine : 1u; nx = cnt > 0u ? cnt : 1u;
}
DI void xcd_barrier(unsigned* bar, volatile LAS unsigned* st) {
    asm volatile("s_waitcnt vmcnt(0)" ::: "memory");
    __syncthreads();
    if (__builtin_amdgcn_workitem_id_x() == 0) {
        __builtin_amdgcn_s_waitcnt(0);
        const unsigned x = xb_xcc_id();
        unsigned nloc = st[0], nx = st[1];
        if (nloc == 0u) { xcd_barrier_complete(bar, x, nloc, nx); st[0] = nloc; st[1] = nx; }
        const unsigned old = xb_add(&bar[XB_XSUB(x)], 1u);
        const unsigned gen = old / nloc;
        if (old + 1u == (gen + 1u) * nloc) {
            __builtin_amdgcn_fence(__ATOMIC_RELEASE, "agent");
            asm volatile("s_waitcnt vmcnt(0)" ::: "memory");
            const unsigned og = xb_add(&bar[XB_TOP], 1u);
            const unsigned tg = og / nx;
            if (og + 1u == (tg + 1u) * nx) xb_add(&bar[XB_TOPGEN], 1u);
            else XB_SPIN(xb_ld(&bar[XB_TOPGEN]) == tg, bar);
            __builtin_amdgcn_fence(__ATOMIC_ACQUIRE, "agent");
            xb_add(&bar[XB_XGEN(x)], 1u);
            asm volatile("s_waitcnt vmcnt(0)" ::: "memory");
        } else {
            XB_SPIN(xb_ld(&bar[XB_XGEN(x)]) == gen, bar);
            __builtin_amdgcn_fence(__ATOMIC_ACQUIRE, "agent");
            asm volatile("s_waitcnt vmcnt(0)" ::: "memory");
        }
    }
    __syncthreads();
}

constexpr int PH_PER_LAYER = 10, N_PHASES = 1 + DEPTH * PH_PER_LAYER + 1;

typedef const __attribute__((address_space(4))) Params* KParamsPtr;
__global__ void __launch_bounds__(NTHR) mega(Params p_unused, int ph_lo, int ph_hi) {
    extern __shared__ __attribute__((aligned(16))) char smem[];
    volatile LAS unsigned* xst = (volatile LAS unsigned*)(smem + LDS_BYTES - 16);
    if (ph_hi - ph_lo > 1) {
        if (__builtin_amdgcn_workitem_id_x() == 0) {
            xst[0] = 0u; xst[1] = 0u;
            KParamsPtr kp0 = (KParamsPtr)__builtin_amdgcn_kernarg_segment_ptr();
            (void)xb_add(&kp0->bar[XB_XCNT(xb_xcc_id())], 1u);
        }
        __syncthreads();
    }
#ifndef PROBE_PH
#define PROBE_PH -1
#endif
    for (int it = ph_lo; it < ph_hi + (PROBE_PH >= 0 ? 1 : 0); ++it) {
        const int ph = (PROBE_PH >= 0 && it > PROBE_PH) ? it - 1 : it;
        if (it == ph_lo + 1) cg::this_grid().sync();
        else if (it > ph_lo) { KParamsPtr kpb = (KParamsPtr)__builtin_amdgcn_kernarg_segment_ptr(); asm volatile("" : "+s"(kpb)); xcd_barrier(kpb->bar, xst); }
        KParamsPtr kp = (KParamsPtr)__builtin_amdgcn_kernarg_segment_ptr();
        asm volatile("" : "+s"(kp));
        const Params& p = *(const Params*)kp;
        if (ph == 0) { phase_prologue(p, smem); continue; }
        if (ph == N_PHASES - 1) { phase_norm<true>(p, p.out, p.hc, p.g_final, nullptr, 0, NLAT); continue; }
        const int l = (ph - 1) / PH_PER_LAYER, s = (ph - 1) % PH_PER_LAYER;
        const bool last = l == DEPTH - 1;
        const float* mods_l = p.mods + (size_t)l * 17 * MODW;
        const bool first = (l == 0 && s <= 2);
        const float* lat_in = first ? p.x : p.out;
        const float* cx_in = first ? p.ctx : p.hc;
        if (s == 0 || s == 3 || s == 7) {
            const int j = s == 0 ? 0 : (s == 3 ? 1 : 2);
            phase_norm<false>(p, lat_in, cx_in, p.g_norm + (l * 3 + j) * D, mods_l, 3 * j, (s == 7 && last) ? NLAT : NTOK);
        } else if (s == 1 || s == 8) {
            EpiSwiglu e{p.hid};
            phase_gemm(p.xn, (s == 1 ? p.Wff1in : p.Wff2in) + (size_t)l * D * 2 * DFF, (s == 8 && last) ? NLAT : NTOK, 2 * DFF, D, e, smem);
        } else if (s == 2 || s == 6 || s == 9) {
            const bf16_t* A = s == 6 ? p.cat : p.hid;
            const bf16_t* Bt = s == 2 ? p.Wff1out + (size_t)l * D * DFF : (s == 9 ? p.Wff2out + (size_t)l * D * DFF : p.Wout + (size_t)l * D * D);
            const int K = s == 6 ? D : DFF, gi = s == 2 ? 2 : (s == 6 ? 5 : 8);
            EpiResid e{lat_in, cx_in, p.out, p.hc, mods_l + gi * D, s == 6 ? 1.0f : 0.5f};
            phase_gemm(A, Bt, (s != 2 && last) ? NLAT : NTOK, D, K, e, smem);
        } else if (s == 4) {
            EpiProj e{&p, l}; phase_gemm(p.xn, p.Win + (size_t)l * D * INC, NTOK, INC, D, e, smem);
        } else {
            phase_mixers(p, l, !last, smem);
        }
    }
}

extern "C" void kernel_launch(void* const* d_in, const int* in_sizes, int n_in, void* d_out, int out_size, void* d_ws, size_t ws_size, hipStream_t stream) {
    static int grid = 0;
    if (grid == 0) {
        int dev = 0, cus = 0, per_cu = 0;
        hipGetDevice(&dev);
        hipDeviceGetAttribute(&cus, hipDeviceAttributeMultiprocessorCount, dev);
        if (hipFuncSetAttribute((const void*)mega, hipFuncAttributeMaxDynamicSharedMemorySize, LDS_BYTES) != hipSuccess) fprintf(stderr, "hipFuncSetAttribute failed\n");
        if (hipOccupancyMaxActiveBlocksPerMultiprocessor(&per_cu, (const void*)mega, NTHR, LDS_BYTES) != hipSuccess || per_cu < 1) { fprintf(stderr, "occupancy query: %d\n", per_cu); per_cu = 1; }
        (void)hipGetLastError();
        grid = cus * per_cu;
        fprintf(stderr, "grid = %d (cus %d per_cu %d) ws_size %zu\n", grid, cus, per_cu, ws_size);
    }
    Params p{};
    const float** pin = (const float**)&p;
    for (int i = 0; i < 24; ++i) pin[i] = (const float*)d_in[i];
    p.out = (float*)d_out;
    char* w = (char*)d_ws; size_t off = 0;
    auto take = [&](size_t bytes) { char* r = w + off; off += (bytes + 255) & ~(size_t)255; return r; };
    p.Wff1in = (bf16_t*)take((size_t)DEPTH * D * 2 * DFF * 2);
    p.Wff1out = (bf16_t*)take((size_t)DEPTH * D * DFF * 2);
    p.Wff2in = (bf16_t*)take((size_t)DEPTH * D * 2 * DFF * 2);
    p.Wff2out = (bf16_t*)take((size_t)DEPTH * D * DFF * 2);
    p.Win = (bf16_t*)take((size_t)DEPTH * D * INC * 2);
    p.Wout = (bf16_t*)take((size_t)DEPTH * D * D * 2);
    p.Ws = (bf16_t*)take((size_t)DEPTH * 4 * 128 * 128 * 2);
    p.mods = (float*)take((size_t)DEPTH * 17 * MODW * 4);
    p.ropeA = (float*)take((size_t)SEQ * 32 * 2 * 4);
    p.ropeC = (float*)take((size_t)SEQ * 16 * 2 * 4);
    p.bar = (unsigned*)take((size_t)XCD_BAR_WORDS * 4);
    p.hc = (float*)take((size_t)NCTX * D * 4);
    p.xn = (bf16_t*)take((size_t)NTOK * D * 2);
    p.cat = p.xn;
    p.hid = (bf16_t*)take((size_t)NTOK * DFF * 2);
    {
        char* q = (char*)p.hid; size_t o2 = 0;
        auto take2 = [&](size_t bytes) { char* r = q + o2; o2 += (bytes + 255) & ~(size_t)255; return r; };
        p.QA = (bf16_t*)take2((size_t)NB * 4 * KEYS * 64 * 2);
        p.KA = (bf16_t*)take2((size_t)NB * 2 * KEYS * 64 * 2);
        p.VtA = (bf16_t*)take2((size_t)NB * 2 * 64 * KEYS * 2);
        p.QC = (bf16_t*)take2((size_t)NB * 4 * 2 * KEYS * 32 * 2);
        p.KC = (bf16_t*)take2((size_t)NB * 4 * 2 * KEYS * 32 * 2);
        p.VtC = (bf16_t*)take2((size_t)NB * 4 * 64 * KEYS * 2);
        p.U = (bf16_t*)take2((size_t)NTOK * 256 * 2);
        p.VN = (bf16_t*)take2((size_t)NTOK * 256 * 2);
        p.Y = (bf16_t*)take2((size_t)NTOK * 256 * 2);
    }
    if (off > ws_size) { fprintf(stderr, "workspace too small: need %zu have %zu\n", off, ws_size); return; }
#if N_LAUNCH_MODE == 1
    if (hipMemsetAsync(p.bar, 0, (size_t)XCD_BAR_WORDS * 4, stream) != hipSuccess) fprintf(stderr, "memset of barrier words failed\n");
    int lo = 0, hi = N_PHASES;
    void* args[] = {&p, &lo, &hi};
    hipError_t e = hipLaunchCooperativeKernel((const void*)mega, dim3(grid), dim3(NTHR), args, LDS_BYTES, stream);
    if (e != hipSuccess) fprintf(stderr, "cooperative launch failed: %s (grid %d)\n", hipGetErrorString(e), grid);
#else
    for (int ph = 0; ph < N_PHASES; ++ph) hipLaunchKernelGGL(mega, dim3(grid), dim3(NTHR), LDS_BYTES, stream, p, ph, ph + 1);
#endif
}
```

```cpp
#include <hip/hip_runtime.h>
#include <hip/hip_cooperative_groups.h>
#include <cstdint>
#include <cstdio>
#include <cmath>
namespace cg = cooperative_groups;

#ifndef N_LAUNCH_MODE
#define N_LAUNCH_MODE 1
#endif

typedef unsigned short bf16_t;
typedef short bf16x8 __attribute__((ext_vector_type(8)));
typedef short s16x4 __attribute__((ext_vector_type(4)));
typedef float f32x4 __attribute__((ext_vector_type(4)));
typedef float f32x2 __attribute__((ext_vector_type(2)));
typedef float f32x16 __attribute__((ext_vector_type(16)));
typedef unsigned u32x2 __attribute__((ext_vector_type(2)));
typedef unsigned u32x4 __attribute__((ext_vector_type(4)));
typedef __bf16 bf2_t __attribute__((ext_vector_type(2)));
#define DI __device__ __forceinline__

constexpr int D = 1024, NB = 16, SEQ = 2048, CTX = 256, NLAT = NB * SEQ, NCTX = NB * CTX, NTOK = NLAT + NCTX;
constexpr int DFF = 2816, INC = 2304, KEYS = SEQ + CTX, DEPTH = 2, MODW = 9 * D;
constexpr int NTHR = 512;
constexpr int LDS_BYTES = 135168;
constexpr float EPS = 1e-6f;

DI unsigned pk2(float a, float b) { f32x2 v = {a, b}; bf2_t r = __builtin_convertvector(v, bf2_t); return __builtin_bit_cast(unsigned, r); }
DI float bf2f(bf16_t v) { return __uint_as_float(((unsigned)v) << 16); }
DI float bflo(unsigned v) { return __uint_as_float(v << 16); }
DI float bfhi(unsigned v) { return __uint_as_float(v & 0xffff0000u); }
DI bf16_t f2bf(float a) { return (bf16_t)(pk2(a, 0.f) & 0xffffu); }
DI float silu_f(float x) { return x / (1.f + __expf(-x)); }
DI float sigmoid_f(float x) { return 1.f / (1.f + __expf(-x)); }
DI float gelu_f(float x) { float u = 1.5957691216057308f * (x + 0.044715f * x * x * x); return x / (1.f + __expf(-u)); }
DI int TID() { int t = __builtin_amdgcn_workitem_id_x(); asm volatile("" : "+v"(t)); return t; }
DI float wave_sum(float v) {
#pragma unroll
    for (int o = 32; o >= 1; o >>= 1) v += __shfl_xor(v, o);
    return v;
}

struct Params {
    const float *x, *c, *ctx, *c_ctx, *w_ada, *b_ada, *g_norm, *w_ff1_in, *w_ff1_out, *w_ff2_in, *w_ff2_out, *w_in, *w_out, *g_q_a, *g_k_a, *lam_c,
        *g_sub_c, *g_v_b, *w_s_b, *b_s_b, *w_dw_d, *b_dw_d, *g_conv_d, *g_final;
    float* out;
    bf16_t *Wff1in, *Wff1out, *Wff2in, *Wff2out, *Win, *Wout, *Ws;
    float *mods, *ropeA, *ropeC, *hc;
    bf16_t *xn, *hid, *QA, *KA, *VtA, *QC, *KC, *VtC, *U, *VN, *Y, *cat;
    unsigned* bar;
};

DI void sincos_d(double x, double& s, double& c) {
    double k = rint(x * 0.15915494309189535);
    double r = fma(-k, 6.283185307179586, x);
    r = fma(-k, 2.4492935982947064e-16, r);
    double r2 = r * r, as = 1.0, ac = 1.0;
#pragma unroll
    for (int n = 14; n >= 1; --n) {
        as = 1.0 - r2 / (double)((2 * n) * (2 * n + 1)) * as;
        ac = 1.0 - r2 / (double)((2 * n - 1) * (2 * n)) * ac;
    }
    s = r * as; c = ac;
}

constexpr int T_FFIN = (D / 64) * (2 * DFF / 64), T_FFOUT = (DFF / 64) * (D / 64), T_WIN = (D / 64) * (INC / 64), T_WOUT = (D / 64) * (D / 64);
constexpr int T_LAYER = 2 * T_FFIN + 2 * T_FFOUT + T_WIN + T_WOUT;
constexpr int U_TR = DEPTH * T_LAYER, U_WS = 32, U_ADA = 288, U_ROPE = 192;
constexpr int U_P0 = U_TR + U_WS + U_ADA + U_ROPE;

DI void transpose_unit(const float* src, bf16_t* dst, int K, int N, int perm, int ti, float* tile) {
    const int tn = N / 64, kt = ti / tn, nt = ti % tn, k0 = kt * 64, n0 = nt * 64;
    int sc0 = n0;
    if (perm == 1) { int t = n0 >> 8, j = n0 & 255; sc0 = j < 128 ? t * 128 + j : DFF + t * 128 + (j - 128); }
    else if (perm == 2 && n0 >= 1792) { int m = n0 - 1792, t = m >> 8, j = m & 255; sc0 = j < 128 ? 1792 + t * 128 + j : 2048 + t * 128 + (j - 128); }
    const int t = TID();
    {
        const int kk = t >> 4, c4 = (t & 15) * 4;
#pragma unroll
        for (int i = 0; i < 2; ++i) {
            const int k = kk + 32 * i;
            f32x4 v = *(const f32x4*)(src + (size_t)(k0 + k) * N + sc0 + c4);
            tile[k * 65 + c4 + 0] = v[0]; tile[k * 65 + c4 + 1] = v[1]; tile[k * 65 + c4 + 2] = v[2]; tile[k * 65 + c4 + 3] = v[3];
        }
    }
    __syncthreads();
    {
        const int n = t >> 3, k8 = (t & 7) * 8;
        u32x4 o;
        o[0] = pk2(tile[(k8 + 0) * 65 + n], tile[(k8 + 1) * 65 + n]);
        o[1] = pk2(tile[(k8 + 2) * 65 + n], tile[(k8 + 3) * 65 + n]);
        o[2] = pk2(tile[(k8 + 4) * 65 + n], tile[(k8 + 5) * 65 + n]);
        o[3] = pk2(tile[(k8 + 6) * 65 + n], tile[(k8 + 7) * 65 + n]);
        *(u32x4*)(dst + (size_t)(n0 + n) * K + k0 + k8) = o;
    }
    __syncthreads();
}

DI void phase_prologue(const Params& p, char* smem) {
    const int t = TID();
    for (int u = blockIdx.x; u < U_P0; u += gridDim.x) {
        if (u < U_TR) {
            const int l = u / T_LAYER; int r = u % T_LAYER;
            const float* src; bf16_t* dst; int K, N, perm;
            if (r < T_FFIN) { src = p.w_ff1_in + (size_t)l * D * 2 * DFF; dst = p.Wff1in + (size_t)l * D * 2 * DFF; K = D; N = 2 * DFF; perm = 1; }
            else if ((r -= T_FFIN) < T_FFOUT) { src = p.w_ff1_out + (size_t)l * D * DFF; dst = p.Wff1out + (size_t)l * D * DFF; K = DFF; N = D; perm = 0; }
            else if ((r -= T_FFOUT) < T_FFIN) { src = p.w_ff2_in + (size_t)l * D * 2 * DFF; dst = p.Wff2in + (size_t)l * D * 2 * DFF; K = D; N = 2 * DFF; perm = 1; }
            else if ((r -= T_FFIN) < T_FFOUT) { src = p.w_ff2_out + (size_t)l * D * DFF; dst = p.Wff2out + (size_t)l * D * DFF; K = DFF; N = D; perm = 0; }
            else if ((r -= T_FFOUT) < T_WIN) { src = p.w_in + (size_t)l * D * INC; dst = p.Win + (size_t)l * D * INC; K = D; N = INC; perm = 2; }
            else { r -= T_WIN; src = p.w_out + (size_t)l * D * D; dst = p.Wout + (size_t)l * D * D; K = D; N = D; perm = 0; }
            transpose_unit(src, dst, K, N, perm, r, (float*)smem);
        } else if (u < U_TR + U_WS) {
            const int e0 = (u - U_TR) * 4096 + t * 8;
            f32x4 a = *(const f32x4*)(p.w_s_b + e0), b = *(const f32x4*)(p.w_s_b + e0 + 4);
            u32x4 o; o[0] = pk2(a[0], a[1]); o[1] = pk2(a[2], a[3]); o[2] = pk2(b[0], b[1]); o[3] = pk2(b[2], b[3]);
            *(u32x4*)(p.Ws + e0) = o;
        } else if (u < U_TR + U_WS + U_ADA) {
            const int uu = u - U_TR - U_WS, l = uu / 144, col0 = (uu % 144) * 64;
            float* s = (float*)smem;
            float* red = s + 17 * 1024;
            for (int i = t; i < 17 * 1024; i += NTHR) { const int r = i >> 10, k = i & 1023; const float v = r < 16 ? p.c[r * D + k] : p.c_ctx[k]; s[i] = silu_f(v); }
            __syncthreads();
            const int col = t & 63, ks = t >> 6;
            float acc[17];
#pragma unroll
            for (int r = 0; r < 17; ++r) acc[r] = 0.f;
            const float* w = p.w_ada + (size_t)l * D * MODW + (size_t)(ks * 128) * MODW + col0 + col;
            for (int k = 0; k < 128; ++k) {
                const float wv = w[(size_t)k * MODW];
#pragma unroll
                for (int r = 0; r < 17; ++r) acc[r] += s[r * 1024 + ks * 128 + k] * wv;
            }
#pragma unroll
            for (int r = 0; r < 17; ++r) red[(ks * 17 + r) * 64 + col] = acc[r];
            __syncthreads();
            for (int i = t; i < 17 * 64; i += NTHR) {
                const int r = i >> 6, cc = i & 63; float sum = 0.f;
#pragma unroll
                for (int q = 0; q < 8; ++q) sum += red[(q * 17 + r) * 64 + cc];
                p.mods[((size_t)l * 17 + r) * MODW + col0 + cc] = sum + p.b_ada[(size_t)l * MODW + col0 + cc];
            }
            __syncthreads();
        } else {
            const int e = (u - U_TR - U_WS - U_ADA) * 512 + t;
            const int pos = e / 48, j = e % 48, row = pos >> 6, col = pos & 63;
            float ang; float* dst;
            if (j < 32) { const float inv = exp2f(-(float)(j & 15) * (13.287712379549449f / 16.f)); ang = (float)(j < 16 ? row : col) * inv; dst = p.ropeA + ((size_t)pos * 32 + j) * 2; }
            else { const int jj = j - 32; const float inv = exp2f(-(float)(jj & 7) * (13.287712379549449f / 8.f)); ang = (float)(jj < 8 ? row : col) * inv; dst = p.ropeC + ((size_t)pos * 16 + jj) * 2; }
            double sn, cs; sincos_d((double)ang, sn, cs);
            dst[0] = (float)cs; dst[1] = (float)sn;
        }
    }
}

template <bool FINAL>
DI void phase_norm(const Params& p, const float* lat, const float* cx, const float* g, const float* mods_l, int mi, int nrows) {
    const int wid = TID() >> 6, lane = TID() & 63;
    for (int u = blockIdx.x; u < nrows / 8; u += gridDim.x) {
        const int row = u * 8 + wid;
        const float* src = row < NLAT ? lat + (size_t)row * D : cx + (size_t)(row - NLAT) * D;
        const int mb = row < NLAT ? row / SEQ : 16;
        f32x4 v[4]; float ss = 0.f;
#pragma unroll
        for (int i = 0; i < 4; ++i) { v[i] = *(const f32x4*)(src + i * 256 + lane * 4); ss += v[i][0] * v[i][0] + v[i][1] * v[i][1] + v[i][2] * v[i][2] + v[i][3] * v[i][3]; }
        ss = wave_sum(ss);
        const float rstd = rsqrtf(ss * (1.f / D) + EPS);
        if (FINAL) {
#pragma unroll
            for (int i = 0; i < 4; ++i) { const int col = i * 256 + lane * 4; const f32x4 gv = *(const f32x4*)(g + col); *(f32x4*)(p.out + (size_t)row * D + col) = v[i] * rstd * gv; }
        } else {
            const float* sh = mods_l + (size_t)mb * MODW + mi * D; const float* scl = sh + D;
#pragma unroll
            for (int i = 0; i < 4; ++i) {
                const int col = i * 256 + lane * 4;
                const f32x4 gv = *(const f32x4*)(g + col), sv = *(const f32x4*)(scl + col), bv = *(const f32x4*)(sh + col);
                const f32x4 o = v[i] * rstd * gv * (1.f + sv) + bv;
                u32x2 w; w[0] = pk2(o[0], o[1]); w[1] = pk2(o[2], o[3]);
                *(u32x2*)(p.xn + (size_t)row * D + col) = w;
            }
        }
    }
}

constexpr int BM = 256, BK = 64, HALF = 128, HT = HALF * BK, NXCD = 8, WGM = 8;
DI int lds_byte(int r, int c) { const int st = (r >> 4) * 2 + (c >> 5), rr = r & 15, cc = c & 31, ob = rr * 64 + cc * 2; return st * 1024 + (ob ^ (((ob >> 9) & 1) << 5)); }
DI void stage_rc(int b, int& R, int& C) { const int st = b / 1024, sb = b % 1024, swz = sb ^ (((sb >> 9) & 1) << 5); R = (st >> 1) * 16 + swz / 64; C = (st & 1) * 32 + (swz % 64) / 2; }

#define LAS __attribute__((address_space(3)))
constexpr int HTB = HALF * BK * 2;
DI void gemm_tile(const bf16_t* A, const bf16_t* Bt, int K, int brow, int bcol, f32x4 (&acc)[2][2][4][2], LAS unsigned char* lds) {
    const int tid = TID(), wid = __builtin_amdgcn_readfirstlane(tid >> 6), lane = tid & 63, wr = wid >> 2, wc = wid & 3, fr = lane & 15, fq = lane >> 4;
    const int nt = K / BK;
    unsigned voff[2];
#pragma unroll
    for (int i = 0; i < 2; ++i) { int R, C; stage_rc(tid * 16 + i * 8192, R, C); voff[i] = (unsigned)(R * K + C) * 2u; }
    const size_t kstep = (size_t)(BK * 2), hstep = (size_t)HALF * K * 2;
    const unsigned ldsw = (unsigned)wid * 1024u;
    const int aoff = lds_byte(wr * 64 + fr, fq * 8), boff = lds_byte(wc * 32 + fr, fq * 8);
#define SA(b, h) (((b) * 2 + (h)) * HTB)
#define SB(b, h) ((4 + (b) * 2 + (h)) * HTB)
#define STAGE(bufoff, gbase) do { _Pragma("unroll") for (int _i = 0; _i < 2; ++_i) \
        __builtin_amdgcn_global_load_lds((const unsigned*)((const char*)(gbase) + voff[_i]), (LAS unsigned*)(lds + (bufoff) + ldsw + _i * 8192), 16, 0, 0); } while (0)
#define LDA(dst, b, h) do { _Pragma("unroll") for (int m = 0; m < 4; ++m) _Pragma("unroll") for (int k = 0; k < 2; ++k) dst[m][k] = *(const LAS bf16x8*)(lds + SA(b, h) + aoff + m * 2048 + k * 1024); } while (0)
#define LDB(dst, b, h) do { _Pragma("unroll") for (int n = 0; n < 2; ++n) _Pragma("unroll") for (int k = 0; k < 2; ++k) dst[n][k] = *(const LAS bf16x8*)(lds + SB(b, h) + boff + n * 2048 + k * 1024); } while (0)
#define MMA(ai, bj, At_, Bt_) do { __builtin_amdgcn_s_setprio(1); _Pragma("unroll") for (int m = 0; m < 4; ++m) _Pragma("unroll") for (int n = 0; n < 2; ++n) _Pragma("unroll") for (int k = 0; k < 2; ++k) \
        acc[ai][bj][m][n] = __builtin_amdgcn_mfma_f32_16x16x32_bf16(Bt_[n][k], At_[m][k], acc[ai][bj][m][n], 0, 0, 0); __builtin_amdgcn_s_setprio(0); } while (0)
#define WAIT_V(n) asm volatile("s_waitcnt vmcnt(" #n ")" ::: "memory")
#define WAIT_L(n) asm volatile("s_waitcnt lgkmcnt(" #n ")" ::: "memory")
#define BAR __builtin_amdgcn_s_barrier()
#define SCHED __builtin_amdgcn_sched_barrier(0)
#pragma unroll
    for (int a = 0; a < 2; ++a)
#pragma unroll
        for (int b = 0; b < 2; ++b)
#pragma unroll
            for (int m = 0; m < 4; ++m)
#pragma unroll
                for (int n = 0; n < 2; ++n) acc[a][b][m][n] = (f32x4){0.f, 0.f, 0.f, 0.f};
    bf16x8 At[4][2], B0[2][2], B1[2][2];
    const char* cA = (const char*)A + (size_t)brow * K * 2; const char* cB = (const char*)Bt + (size_t)bcol * K * 2;
    STAGE(SB(0, 0), cB); STAGE(SA(0, 0), cA); STAGE(SB(0, 1), cB + hstep); STAGE(SA(0, 1), cA + hstep);
    if (wr == 1) BAR;
    WAIT_V(4); BAR;
    STAGE(SB(1, 0), cB + kstep); STAGE(SA(1, 0), cA + kstep); STAGE(SB(1, 1), cB + hstep + kstep);
    WAIT_V(6); BAR;
    for (int t = 0; t < nt - 2; t += 2) {
        const char* a1 = cA + (size_t)(t + 1) * kstep; const char* a2 = cA + (size_t)(t + 2) * kstep; const char* b2 = cB + (size_t)(t + 2) * kstep;
        const char* a3 = a2 + kstep; const char* b3 = b2 + kstep;
        LDB(B0, 0, 0); SCHED; LDA(At, 0, 0); STAGE(SA(1, 1), a1 + hstep);
        WAIT_L(8); BAR; WAIT_L(0); MMA(0, 0, At, B0); BAR; SCHED;
        LDB(B1, 0, 1); STAGE(SB(0, 0), b2);
        BAR; WAIT_L(0); MMA(0, 1, At, B1); BAR;
        LDA(At, 0, 1); STAGE(SA(0, 0), a2);
        BAR; WAIT_L(0); MMA(1, 0, At, B0); BAR; SCHED;
        STAGE(SB(0, 1), b2 + hstep);
        WAIT_V(6); BAR; MMA(1, 1, At, B1); BAR;
        LDB(B0, 1, 0); SCHED; LDA(At, 1, 0); STAGE(SA(0, 1), a2 + hstep);
        WAIT_L(8); BAR; WAIT_L(0); MMA(0, 0, At, B0); BAR; SCHED;
        LDB(B1, 1, 1); STAGE(SB(1, 0), b3);
        BAR; WAIT_L(0); MMA(0, 1, At, B1); BAR;
        LDA(At, 1, 1); STAGE(SA(1, 0), a3);
        BAR; WAIT_L(0); MMA(1, 0, At, B0); BAR; SCHED;
        STAGE(SB(1, 1), b3 + hstep);
        WAIT_V(6); BAR; MMA(1, 1, At, B1); BAR;
    }
    { LDB(B0, 0, 0); LDA(At, 0, 0); STAGE(SA(1, 1), cA + (size_t)(nt - 1) * kstep + hstep);
      BAR; WAIT_L(0); MMA(0, 0, At, B0); BAR;
      LDB(B1, 0, 1); BAR; WAIT_L(0); MMA(0, 1, At, B1); BAR;
      LDA(At, 0, 1); WAIT_V(4); BAR; WAIT_L(0); MMA(1, 0, At, B0); MMA(1, 1, At, B1); BAR; }
    { LDB(B0, 1, 0); LDA(At, 1, 0); WAIT_V(2); BAR; WAIT_L(0); MMA(0, 0, At, B0); BAR;
      LDB(B1, 1, 1); WAIT_V(0); BAR; WAIT_L(0); MMA(0, 1, At, B1); BAR;
      LDA(At, 1, 1); BAR; WAIT_L(0); MMA(1, 0, At, B0); MMA(1, 1, At, B1); BAR; }
    if (wr == 0) BAR;
}

DI void tile_order(int L, int nM, int nN, int& pm, int& pn) {
    const int nwg = nM * nN; int wgid = L;
    { const int q = nwg / NXCD, r = nwg % NXCD, xcd = wgid % NXCD, off = wgid / NXCD; wgid = (xcd < r ? xcd * (q + 1) : r * (q + 1) + (xcd - r) * q) + off; }
    const int nig = WGM * nN, gid = wgid / nig, fm = gid * WGM, gsz = (nM - fm) < WGM ? (nM - fm) : WGM;
    pm = fm + ((wgid % nig) % gsz); pn = (wgid % nig) / gsz;
}

struct EpiSwiglu {
    bf16_t* hid;
    DI void operator()(f32x4 (&acc)[2][2][4][2], int pm, int pn, char* smem) const {
        const int wid = TID() >> 6, lane = TID() & 63, wr = wid >> 2, wc = wid & 3, fr = lane & 15, fq = lane >> 4;
#pragma unroll
        for (int ai = 0; ai < 2; ++ai)
#pragma unroll
            for (int m = 0; m < 4; ++m) {
                const int row = pm * BM + ai * HALF + wr * 64 + m * 16 + fr;
#pragma unroll
                for (int n = 0; n < 2; ++n) {
                    const f32x4 a = acc[ai][0][m][n], b = acc[ai][1][m][n];
                    u32x2 w; w[0] = pk2(silu_f(a[0]) * b[0], silu_f(a[1]) * b[1]); w[1] = pk2(silu_f(a[2]) * b[2], silu_f(a[3]) * b[3]);
                    *(u32x2*)(hid + (size_t)row * DFF + pn * 128 + wc * 32 + n * 16 + fq * 4) = w;
                }
            }
    }
};
struct EpiResid {
    const float *lat_in, *cx_in; float *lat_out, *cx_out; const float* gate; float gs;
    DI void operator()(f32x4 (&acc)[2][2][4][2], int pm, int pn, char* smem) const {
        const int wid = TID() >> 6, lane = TID() & 63, wr = wid >> 2, wc = wid & 3, fr = lane & 15, fq = lane >> 4;
        const int row0 = pm * BM; const bool islat = row0 < NLAT;
        const size_t base = (size_t)(islat ? row0 : row0 - NLAT) * D + (size_t)(wr * 64 + fr) * D + pn * BM + wc * 32 + fq * 4;
        const float* in = (islat ? lat_in : cx_in) + base;
        float* out = (islat ? lat_out : cx_out) + base;
        const float* gt = gate + (size_t)(islat ? row0 / SEQ : 16) * MODW + pn * BM + wc * 32 + fq * 4;
        f32x4 gv[2][2];
#pragma unroll
        for (int bj = 0; bj < 2; ++bj)
#pragma unroll
            for (int n = 0; n < 2; ++n) gv[bj][n] = *(const f32x4*)(gt + bj * HALF + n * 16) * gs;
#pragma unroll
        for (int ai = 0; ai < 2; ++ai)
#pragma unroll
            for (int m = 0; m < 4; ++m) {
                const size_t ro = (size_t)(ai * HALF + m * 16) * D;
                f32x4 hv[2][2];
#pragma unroll
                for (int bj = 0; bj < 2; ++bj)
#pragma unroll
                    for (int n = 0; n < 2; ++n) hv[bj][n] = *(const f32x4*)(in + ro + bj * HALF + n * 16);
#pragma unroll
                for (int bj = 0; bj < 2; ++bj)
#pragma unroll
                    for (int n = 0; n < 2; ++n) *(f32x4*)(out + ro + bj * HALF + n * 16) = hv[bj][n] + gv[bj][n] * acc[ai][bj][m][n];
                if (m & 1) __builtin_amdgcn_sched_barrier(0);
            }
    }
};
constexpr int TS = 257;
struct EpiProj {
    const Params* pp; int l;
    DI void operator()(f32x4 (&acc)[2][2][4][2], int pm, int pn, char* smem) const {
        const Params& p = *pp;
        float* T = (float*)smem;
        const int tid = TID(), wid = tid >> 6, lane = tid & 63, wr = wid >> 2, wc = wid & 3, fr = lane & 15, fq = lane >> 4;
#pragma unroll
        for (int ai = 0; ai < 2; ++ai) {
            __syncthreads();
#pragma unroll
            for (int bj = 0; bj < 2; ++bj)
#pragma unroll
                for (int m = 0; m < 4; ++m)
#pragma unroll
                    for (int n = 0; n < 2; ++n)
#pragma unroll
                        for (int j = 0; j < 4; ++j) T[(wr * 64 + m * 16 + fr) * TS + bj * HALF + wc * 32 + n * 16 + fq * 4 + j] = acc[ai][bj][m][n][j];
            __syncthreads();
            const int rl = tid & 127, seg = tid >> 7, grow = pm * BM + ai * HALF + rl;
            const bool islat = grow < NLAT;
            const int b = islat ? grow / SEQ : (grow - NLAT) / CTX;
            const int pos = islat ? grow % SEQ : SEQ + (grow - NLAT) % CTX;
            const float* xr = T + rl * TS + seg * 64;
            if (pn == 0 || (pn == 2 && seg < 2)) {
                const float* g = (pn == 0 ? p.g_q_a : p.g_k_a) + l * 64;
                bf16_t* dst = pn == 0 ? p.QA + ((size_t)(b * 4 + seg) * KEYS + pos) * 64 : p.KA + ((size_t)(b * 2 + seg) * KEYS + pos) * 64;
                float ss = 0.f;
                for (int i = 0; i < 64; ++i) ss += xr[i] * xr[i];
                const float rstd = rsqrtf(ss * (1.f / 64.f) + EPS);
                const float* rp = p.ropeA + (size_t)(islat ? pos : 0) * 64;
                for (int i0 = 0; i0 < 32; i0 += 8) {
                    float o1[8], o2[8];
#pragma unroll
                    for (int i = 0; i < 8; ++i) {
                        const float a = xr[i0 + i] * rstd * g[i0 + i], bb = xr[i0 + i + 32] * rstd * g[i0 + i + 32];
                        float cs = 1.f, sn = 0.f;
                        if (islat) { cs = rp[(i0 + i) * 2]; sn = rp[(i0 + i) * 2 + 1]; }
                        o1[i] = a * cs - bb * sn; o2[i] = a * sn + bb * cs;
                    }
                    u32x4 w1, w2;
#pragma unroll
                    for (int i = 0; i < 4; ++i) { w1[i] = pk2(o1[2 * i], o1[2 * i + 1]); w2[i] = pk2(o2[2 * i], o2[2 * i + 1]); }
                    *(u32x4*)(dst + i0) = w1; *(u32x4*)(dst + 32 + i0) = w2;
                }
            } else if (pn == 1 || pn == 3) {
                bf16_t* base = (pn == 1 ? p.QC : p.KC);
                const float* rp = p.ropeC + (size_t)(islat ? pos : 0) * 32;
#pragma unroll
                for (int mp = 0; mp < 2; ++mp) {
                    bf16_t* dst = base + ((size_t)((b * 4 + seg) * 2 + mp) * KEYS + pos) * 32;
                    for (int i0 = 0; i0 < 16; i0 += 8) {
                        float o1[8], o2[8];
#pragma unroll
                        for (int i = 0; i < 8; ++i) {
                            const float a = xr[mp * 32 + i0 + i], bb = xr[mp * 32 + i0 + i + 16];
                            float cs = 1.f, sn = 0.f;
                            if (islat) { cs = rp[(i0 + i) * 2]; sn = rp[(i0 + i) * 2 + 1]; }
                            o1[i] = a * cs - bb * sn; o2[i] = a * sn + bb * cs;
                        }
                        u32x4 w1, w2;
#pragma unroll
                        for (int i = 0; i < 4; ++i) { w1[i] = pk2(o1[2 * i], o1[2 * i + 1]); w2[i] = pk2(o2[2 * i], o2[2 * i + 1]); }
                        *(u32x4*)(dst + i0) = w1; *(u32x4*)(dst + 16 + i0) = w2;
                    }
                }
            } else if (pn == 2 || pn == 4) {
                bf16_t* dst = pn == 2 ? p.VtA + ((size_t)(b * 2 + (seg - 2)) * 64) * KEYS + pos : p.VtC + ((size_t)(b * 4 + seg) * 64) * KEYS + pos;
                for (int d = 0; d < 64; ++d) dst[(size_t)d * KEYS] = f2bf(xr[d]);
            } else if (pn == 5) {
                bf16_t* dst = p.U + (size_t)grow * 256 + seg * 64;
                for (int i0 = 0; i0 < 64; i0 += 8) {
                    u32x4 w;
#pragma unroll
                    for (int i = 0; i < 4; ++i) w[i] = pk2(gelu_f(xr[i0 + 2 * i]), gelu_f(xr[i0 + 2 * i + 1]));
                    *(u32x4*)(dst + i0) = w;
                }
            } else if (pn == 6) {
                const float* xrow = T + rl * TS; float ss = 0.f;
                for (int i = 0; i < 256; ++i) { const float gv = gelu_f(xrow[i]); ss += gv * gv; }
                const float rstd = rsqrtf(ss * (1.f / 256.f) + EPS);
                const float* g = p.g_v_b + l * 256 + seg * 64;
                bf16_t* dst = p.VN + (size_t)grow * 256 + seg * 64;
                for (int i0 = 0; i0 < 64; i0 += 8) {
                    u32x4 w;
#pragma unroll
                    for (int i = 0; i < 4; ++i) w[i] = pk2(gelu_f(xr[i0 + 2 * i]) * rstd * g[i0 + 2 * i], gelu_f(xr[i0 + 2 * i + 1]) * rstd * g[i0 + 2 * i + 1]);
                    *(u32x4*)(dst + i0) = w;
                }
            } else {
                if (seg < 2) {
                    const float* gr = xr + 128;
                    bf16_t* dst = p.Y + (size_t)grow * 256 + (pn - 7) * 128 + seg * 64;
                    for (int i0 = 0; i0 < 64; i0 += 8) {
                        u32x4 w;
#pragma unroll
                        for (int i = 0; i < 4; ++i) w[i] = pk2(xr[i0 + 2 * i] * sigmoid_f(gr[i0 + 2 * i]), xr[i0 + 2 * i + 1] * sigmoid_f(gr[i0 + 2 * i + 1]));
                        *(u32x4*)(dst + i0) = w;
                    }
                }
            }
        }
        __syncthreads();
    }
};

template <class Epi>
DI void phase_gemm(const bf16_t* A, const bf16_t* Bt, int M, int N, int K, const Epi& epi, char* smem) {
    const int nM = M / BM, nN = N / BM, nwg = nM * nN;
    for (int L = blockIdx.x; L < nwg; L += gridDim.x) {
        int pm, pn; tile_order(L, nM, nN, pm, pn);
        f32x4 acc[2][2][4][2];
        gemm_tile(A, Bt, K, pm * BM, pn * BM, acc, (LAS unsigned char*)smem);
        epi(acc, pm, pn, smem);
    }
}

constexpr int VROW = 144;
template <int DQK>
DI void attn_core(const bf16_t* Q, const bf16_t* Kg, const bf16_t* Vt, int qpos0, int key_lo, int nkt, float sc, f32x16 (&O)[2], char* smem) {
    constexpr int KROW = DQK * 2 + 16, KBUF = 64 * KROW, VBUF = 64 * VROW, NKS = DQK / 16;
    LAS char* lds = (LAS char*)smem;
    const int tid = TID(), lane = tid & 63, wid = tid >> 6, r = lane & 31, h = lane >> 5;
    bf16x8 qf[NKS];
#pragma unroll
    for (int ks = 0; ks < NKS; ++ks) qf[ks] = *(const bf16x8*)(Q + (size_t)(qpos0 + wid * 32 + r) * DQK + ks * 16 + 8 * h);
#pragma unroll
    for (int i = 0; i < 16; ++i) { O[0][i] = 0.f; O[1][i] = 0.f; }
    float m_run = -1e30f, l_run = 0.f;
    constexpr int KCH = DQK / 8;
    const bool kact = tid < 64 * KCH;
    const int kkey = tid / KCH, kch = tid % KCH, vd = tid >> 3, vch = tid & 7;
    const int kst = kkey * KROW + kch * 16, vst = 2 * KBUF + vd * VROW + vch * 16;
    const int krd = r * KROW + 16 * h, vrd = 2 * KBUF + r * VROW + 8 * h;
    const bf16_t* kg = Kg + (size_t)(key_lo + kkey) * DQK + kch * 8;
    const bf16_t* vg = Vt + (size_t)vd * KEYS + key_lo + vch * 8;
    u32x4 kreg = {0, 0, 0, 0}, vreg;
    __syncthreads();
    if (kact) kreg = *(const u32x4*)kg;
    vreg = *(const u32x4*)vg;
    if (kact) *(LAS u32x4*)(lds + kst) = kreg;
    *(LAS u32x4*)(lds + vst) = vreg;
    __syncthreads();
    for (int t = 0; t < nkt; ++t) {
        const int cur = t & 1;
        if (t + 1 < nkt) {
            if (kact) kreg = *(const u32x4*)(kg + (size_t)(t + 1) * 64 * DQK);
            vreg = *(const u32x4*)(vg + (t + 1) * 64);
        }
        const LAS char* kb = lds + cur * KBUF + krd; const LAS char* vb = lds + cur * VBUF + vrd;
#pragma unroll
        for (int kk = 0; kk < 2; ++kk) {
            f32x16 s;
#pragma unroll
            for (int i = 0; i < 16; ++i) s[i] = 0.f;
#pragma unroll
            for (int ks = 0; ks < NKS; ++ks) {
                const bf16x8 kf = *(const LAS bf16x8*)(kb + kk * 32 * KROW + ks * 32);
                s = __builtin_amdgcn_mfma_f32_32x32x16_bf16(kf, qf[ks], s, 0, 0, 0);
            }
            float mx = fmaxf(fmaxf(fmaxf(s[0], s[1]), fmaxf(s[2], s[3])), fmaxf(fmaxf(s[4], s[5]), fmaxf(s[6], s[7])));
            mx = fmaxf(mx, fmaxf(fmaxf(fmaxf(s[8], s[9]), fmaxf(s[10], s[11])), fmaxf(fmaxf(s[12], s[13]), fmaxf(s[14], s[15]))));
            mx = fmaxf(mx, __shfl_xor(mx, 32));
            const float m_new = fmaxf(m_run, mx * sc);
            if (__builtin_amdgcn_ballot_w64(m_new > m_run) != 0ull) {
                const float alpha = __builtin_amdgcn_exp2f(m_run - m_new);
                m_run = m_new; l_run *= alpha;
#pragma unroll
                for (int i = 0; i < 16; ++i) { O[0][i] *= alpha; O[1][i] *= alpha; }
            }
            float ps = 0.f;
#pragma unroll
            for (int i = 0; i < 16; ++i) { s[i] = __builtin_amdgcn_exp2f(s[i] * sc - m_run); ps += s[i]; }
            l_run += ps;
#pragma unroll
            for (int st = 0; st < 2; ++st) {
                u32x4 pw;
#pragma unroll
                for (int i = 0; i < 4; ++i) pw[i] = pk2(s[8 * st + 2 * i], s[8 * st + 2 * i + 1]);
                const bf16x8 pf = __builtin_bit_cast(bf16x8, pw);
#pragma unroll
                for (int dt = 0; dt < 2; ++dt) {
                    const LAS char* vp = vb + dt * 32 * VROW + (kk * 32 + 16 * st) * 2;
                    const u32x2 lo = *(const LAS u32x2*)vp, hi = *(const LAS u32x2*)(vp + 16);
                    u32x4 vw = {lo[0], lo[1], hi[0], hi[1]};
                    O[dt] = __builtin_amdgcn_mfma_f32_32x32x16_bf16(__builtin_bit_cast(bf16x8, vw), pf, O[dt], 0, 0, 0);
                }
            }
        }
        if (t + 1 < nkt) {
            if (kact) *(LAS u32x4*)(lds + (cur ^ 1) * KBUF + kst) = kreg;
            *(LAS u32x4*)(lds + (cur ^ 1) * VBUF + vst) = vreg;
        }
        __syncthreads();
    }
    const float lt = l_run + __shfl_xor(l_run, 32);
    const float inv = 1.f / lt;
#pragma unroll
    for (int i = 0; i < 16; ++i) { O[0][i] *= inv; O[1][i] *= inv; }
}

DI void store_OT(const f32x16 (&O)[2], bf16_t* dst  , int h) {
#pragma unroll
    for (int dt = 0; dt < 2; ++dt)
#pragma unroll
        for (int gq = 0; gq < 4; ++gq) {
            u32x2 w; w[0] = pk2(O[dt][4 * gq], O[dt][4 * gq + 1]); w[1] = pk2(O[dt][4 * gq + 2], O[dt][4 * gq + 3]);
            *(u32x2*)(dst + dt * 32 + 8 * gq + 4 * h) = w;
        }
}

DI void attn_unit(const Params& p, int l, int uidx, bool isC, int nqb, char* smem) {
    const int qb = uidx % nqb, bh = uidx / nqb, head = bh & 3, b = bh >> 2;
    const int lane = TID() & 63, wid = TID() >> 6, r = lane & 31, h = lane >> 5;
    const int qpos0 = qb < 8 ? qb * 256 : SEQ, key_lo = qb < 8 ? 0 : SEQ, nkt = qb < 8 ? KEYS / 64 : CTX / 64;
    const int qpos = qpos0 + wid * 32 + r;
    const size_t grow = qpos < SEQ ? (size_t)b * SEQ + qpos : (size_t)NLAT + b * CTX + (qpos - SEQ);
    if (!isC) {
        f32x16 O[2];
        attn_core<64>(p.QA + (size_t)(b * 4 + head) * KEYS * 64, p.KA + (size_t)(b * 2 + (head >> 1)) * KEYS * 64, p.VtA + (size_t)(b * 2 + (head >> 1)) * 64 * KEYS,
                      qpos0, key_lo, nkt, 0.125f * 1.4426950408889634f, O, smem);
        store_OT(O, p.cat + grow * D + head * 64, h);
    } else {
        const float lam_init = 0.8f - 0.6f * __expf(-0.3f * (float)l);
        float d0 = 0.f, d1 = 0.f;
        const float* lp = p.lam_c + l * 128;
        for (int i = 0; i < 32; ++i) { d0 += lp[i] * lp[32 + i]; d1 += lp[64 + i] * lp[96 + i]; }
        const float lam = __expf(d0) - __expf(d1) + lam_init;
        const bf16_t* Vt = p.VtC + (size_t)(b * 4 + head) * 64 * KEYS;
        f32x16 O0[2], O1[2];
        attn_core<32>(p.QC + (size_t)((b * 4 + head) * 2 + 0) * KEYS * 32, p.KC + (size_t)((b * 4 + head) * 2 + 0) * KEYS * 32, Vt, qpos0, key_lo, nkt,
                      0.17677669529663687f * 1.4426950408889634f, O0, smem);
        attn_core<32>(p.QC + (size_t)((b * 4 + head) * 2 + 1) * KEYS * 32, p.KC + (size_t)((b * 4 + head) * 2 + 1) * KEYS * 32, Vt, qpos0, key_lo, nkt,
                      0.17677669529663687f * 1.4426950408889634f, O1, smem);
        float ss = 0.f;
#pragma unroll
        for (int dt = 0; dt < 2; ++dt)
#pragma unroll
            for (int i = 0; i < 16; ++i) { const float v = O0[dt][i] - lam * O1[dt][i]; O0[dt][i] = v; ss += v * v; }
        ss += __shfl_xor(ss, 32);
        const float rstd = rsqrtf(ss * (1.f / 64.f) + EPS) * (1.f - lam_init);
        const float* g = p.g_sub_c + l * 64;
#pragma unroll
        for (int dt = 0; dt < 2; ++dt)
#pragma unroll
            for (int i = 0; i < 16; ++i) O0[dt][i] *= rstd * g[dt * 32 + 8 * (i >> 2) + 4 * h + (i & 3)];
        store_OT(O0, p.cat + grow * D + 256 + head * 64, h);
    }
}

DI void gmlp_unit(const Params& p, int l, int uidx, char* smem) {
    const int g = uidx & 3, c = uidx >> 2, tid = TID(), lane = tid & 63, wid = tid >> 6, fr = lane & 15, fq = lane >> 4;
    bf16_t* vT = (bf16_t*)smem;
    constexpr int VS = 136;
    __syncthreads();
    {
        const int q = tid >> 2, d0 = (tid & 3) * 16;
        const bf16_t* src = p.VN + (size_t)(c * 128 + q) * 256 + g * 64 + d0;
        const bf16x8 a = *(const bf16x8*)src, bb = *(const bf16x8*)(src + 8);
#pragma unroll
        for (int j = 0; j < 8; ++j) { vT[(d0 + j) * VS + q] = (bf16_t)a[j]; vT[(d0 + 8 + j) * VS + q] = (bf16_t)bb[j]; }
    }
    __syncthreads();
    f32x4 acc[4];
#pragma unroll
    for (int n = 0; n < 4; ++n) acc[n] = (f32x4){0.f, 0.f, 0.f, 0.f};
    const bf16_t* wrow = p.Ws + ((size_t)(l * 4 + g) * 128 + wid * 16 + fr) * 128;
#pragma unroll
    for (int ks = 0; ks < 4; ++ks) {
        const bf16x8 af = *(const bf16x8*)(wrow + ks * 32 + fq * 8);
#pragma unroll
        for (int n = 0; n < 4; ++n) {
            const bf16x8 bfv = *(const bf16x8*)(vT + (n * 16 + fr) * VS + ks * 32 + fq * 8);
            acc[n] = __builtin_amdgcn_mfma_f32_16x16x32_bf16(bfv, af, acc[n], 0, 0, 0);
        }
    }
    const int prow = wid * 16 + fr; const size_t grow = (size_t)c * 128 + prow;
    const float bias = p.b_s_b[(l * 4 + g) * 128 + prow];
#pragma unroll
    for (int n = 0; n < 4; ++n) {
        const int col = g * 64 + n * 16 + fq * 4;
        const u32x2 uu = *(const u32x2*)(p.U + grow * 256 + col);
        u32x2 w;
        w[0] = pk2(bflo(uu[0]) * (acc[n][0] + bias), bfhi(uu[0]) * (acc[n][1] + bias));
        w[1] = pk2(bflo(uu[1]) * (acc[n][2] + bias), bfhi(uu[1]) * (acc[n][3] + bias));
        *(u32x2*)(p.cat + grow * D + 512 + col) = w;
    }
}

DI void conv_unit(const Params& p, int l, int uidx, char* smem) {
    const int tid = TID(), lane = tid & 63, wid = tid >> 6;
    bf16_t* yin = (bf16_t*)smem;
    float* co = (float*)(smem + 94 * 256 * 2);
    const int row0 = uidx * 64;
    int s0, s1;
    if (row0 < NLAT) { s0 = (row0 / SEQ) * SEQ; s1 = s0 + SEQ; } else { s0 = NLAT + ((row0 - NLAT) / CTX) * CTX; s1 = s0 + CTX; }
    __syncthreads();
    for (int i = tid; i < 94 * 32; i += NTHR) {
        const int rr = i >> 5, ch8 = (i & 31) * 8, gr = row0 - 15 + rr;
        u32x4 v = {0, 0, 0, 0};
        if (gr >= s0 && gr < s1) v = *(const u32x4*)(p.Y + (size_t)gr * 256 + ch8);
        *(u32x4*)(yin + rr * 256 + ch8) = v;
    }
    __syncthreads();
    {
        const int ch = tid & 255, th = tid >> 8;
        float w[31];
#pragma unroll
        for (int k = 0; k < 31; ++k) w[k] = p.w_dw_d[(size_t)(l * 31 + k) * 256 + ch];
        const float bias = p.b_dw_d[l * 256 + ch];
        for (int i = th * 32; i < th * 32 + 32; ++i) {
            float a = bias;
#pragma unroll
            for (int k = 0; k < 31; ++k) a += w[k] * bf2f(yin[(i + k) * 256 + ch]);
            co[i * 256 + ch] = a;
        }
    }
    __syncthreads();
#pragma unroll
    for (int j = 0; j < 8; ++j) {
        const int tk = wid * 8 + j;
        const f32x4 v = *(const f32x4*)(co + tk * 256 + lane * 4);
        const float ss = wave_sum(v[0] * v[0] + v[1] * v[1] + v[2] * v[2] + v[3] * v[3]);
        const float rstd = rsqrtf(ss * (1.f / 256.f) + EPS);
        const f32x4 g = *(const f32x4*)(p.g_conv_d + l * 256 + lane * 4);
        u32x2 w; w[0] = pk2(silu_f(v[0] * rstd * g[0]), silu_f(v[1] * rstd * g[1])); w[1] = pk2(silu_f(v[2] * rstd * g[2]), silu_f(v[3] * rstd * g[3]));
        *(u32x2*)(p.cat + (size_t)(row0 + tk) * D + 768 + lane * 4) = w;
    }
}

DI void phase_mixers(const Params& p, int l, bool withctx, char* smem) {
    const int nqb = withctx ? 9 : 8;
    const int nC = NB * 4 * nqb, nA = nC, nG = (withctx ? NTOK : NLAT) / 128 * 4, nV = (withctx ? NTOK : NLAT) / 64;
    const int total = nC + nA + nG + nV;
    for (int u = blockIdx.x; u < total; u += gridDim.x) {
        asm volatile("" : "+s"(l));
        if (u < nC) attn_unit(p, l, u, true, nqb, smem);
        else if (u < nC + nA) attn_unit(p, l, u - nC, false, nqb, smem);
        else if (u < nC + nA + nG) gmlp_unit(p, l, u - nC - nA, smem);
        else conv_unit(p, l, u - nC - nA - nG, smem);
    }
#ifndef PROBE_MIX
#define PROBE_MIX 0
#endif
    if (PROBE_MIX) {
        const int lo = PROBE_MIX == 1 ? 0 : (PROBE_MIX == 2 ? nC : (PROBE_MIX == 3 ? nC + nA : nC + nA + nG));
        const int hi = PROBE_MIX == 1 ? nC : (PROBE_MIX == 2 ? nC + nA : (PROBE_MIX == 3 ? nC + nA + nG : total));
        for (int u = lo + blockIdx.x; u < hi; u += gridDim.x) {
            asm volatile("" : "+s"(l));
            if (u < nC) attn_unit(p, l, u, true, nqb, smem);
            else if (u < nC + nA) attn_unit(p, l, u - nC, false, nqb, smem);
            else if (u < nC + nA + nG) gmlp_unit(p, l, u - nC - nA, smem);
            else conv_unit(p, l, u - nC - nA - nG, smem);
        }
    }
}

#define XB_TMO      128
#define XB_XCNT(j)  (256  + 64 * (j))
#define XB_XSUB(j)  (1280 + 64 * (j))
#define XB_XGEN(j)  (2304 + 64 * (j))
#define XB_TOP      3328
#define XB_TOPGEN   3392
#define XCD_BAR_WORDS 3456
#define XB_SPIN_CAP (1u << 22)
DI unsigned xb_ld(unsigned* p) { return __hip_atomic_load(p, __ATOMIC_RELAXED, __HIP_MEMORY_SCOPE_AGENT); }
DI unsigned xb_add(unsigned* p, unsigned v) { return __hip_atomic_fetch_add(p, v, __ATOMIC_RELAXED, __HIP_MEMORY_SCOPE_AGENT); }
DI unsigned xb_xcc_id() { return (unsigned)__builtin_amdgcn_s_getreg((3 << 11) | 20) & 0xFu; }
#define XB_SPIN(cond, bar) do { unsigned _sp = 0; while (cond) { __builtin_amdgcn_s_sleep(1); \
    if ((++_sp & 255u) == 0u) { if (xb_ld(&(bar)[XB_TMO])) break; if (_sp > XB_SPIN_CAP) { atomicAdd(&(bar)[XB_TMO], 1u); break; } } } } while (0)
DI void xcd_barrier_complete(unsigned* bar, unsigned x, unsigned& nloc, unsigned& nx) {
    const unsigned G = gridDim.x;
    unsigned sum, cnt, mine, sp = 0u;
    for (;;) {
        sum = 0u; cnt = 0u; mine = 0u;
#pragma unroll
        for (unsigned j = 0; j < 16; ++j) { const unsigned c = xb_ld(&bar[XB_XCNT(j)]); sum += c; cnt += (c > 0u) ? 1u : 0u; mine = (j == x) ? c : mine; }
        if (sum == G) break;
        __builtin_amdgcn_s_sleep(1);
        if ((++sp & 255u) == 0u) { if (xb_ld(&bar[XB_TMO])) break; if (sp > XB_SPIN_CAP) { atomicAdd(&bar[XB_TMO], 1u); break; } }
    }
    nloc = mine > 0u ? mine : 1u; nx = cnt > 0u ? cnt : 1u;
}
DI void xcd_barrier(unsigned* bar, volatile LAS unsigned* st) {
    asm volatile("s_waitcnt vmcnt(0)" ::: "memory");
    __syncthreads();
    if (__builtin_amdgcn_workitem_id_x() == 0) {
        __builtin_amdgcn_s_waitcnt(0);
        const unsigned x = xb_xcc_id();
        unsigned nloc = st[0], nx = st[1];
        if (nloc == 0u) { xcd_barrier_complete(bar, x, nloc, nx); st[0] = nloc; st[1] = nx; }
        const unsigned old = xb_add(&bar[XB_XSUB(x)], 1u);
        const unsigned gen = old / nloc;
        if (old + 1u == (gen + 1u) * nloc) {
            __builtin_amdgcn_fence(__ATOMIC_RELEASE, "agent");
            asm volatile("s_waitcnt vmcnt(0)" ::: "memory");
            const unsigned og = xb_add(&bar[XB_TOP], 1u);
            const unsigned tg = og / nx;
            if (og + 1u == (tg + 1u) * nx) xb_add(&bar[XB_TOPGEN], 1u);
            else XB_SPIN(xb_ld(&bar[XB_TOPGEN]) == tg, bar);
            __builtin_amdgcn_fence(__ATOMIC_ACQUIRE, "agent");
            xb_add(&bar[XB_XGEN(x)], 1u);
            asm volatile("s_waitcnt vmcnt(0)" ::: "memory");
        } else {
            XB_SPIN(xb_ld(&bar[XB_XGEN(x)]) == gen, bar);
            __builtin_amdgcn_fence(__ATOMIC_ACQUIRE, "agent");
            asm volatile("s_waitcnt vmcnt(0)" ::: "memory");
        }
    }
    __syncthreads();
}

constexpr int PH_PER_LAYER = 10, N_PHASES = 1 + DEPTH * PH_PER_LAYER + 1;

typedef const __attribute__((address_space(4))) Params* KParamsPtr;
__global__ void __launch_bounds__(NTHR) mega(Params p_unused, int ph_lo, int ph_hi) {
    extern __shared__ __attribute__((aligned(16))) char smem[];
    volatile LAS unsigned* xst = (volatile LAS unsigned*)(smem + LDS_BYTES - 16);
    if (ph_hi - ph_lo > 1) {
        if (__builtin_amdgcn_workitem_id_x() == 0) {
            xst[0] = 0u; xst[1] = 0u;
            KParamsPtr kp0 = (KParamsPtr)__builtin_amdgcn_kernarg_segment_ptr();
            (void)xb_add(&kp0->bar[XB_XCNT(xb_xcc_id())], 1u);
        }
        __syncthreads();
    }
#ifndef PROBE_PH
#define PROBE_PH -1
#endif
    for (int it = ph_lo; it < ph_hi + (PROBE_PH >= 0 ? 1 : 0); ++it) {
        const int ph = (PROBE_PH >= 0 && it > PROBE_PH) ? it - 1 : it;
        if (it == ph_lo + 1) cg::this_grid().sync();
        else if (it > ph_lo) { KParamsPtr kpb = (KParamsPtr)__builtin_amdgcn_kernarg_segment_ptr(); asm volatile("" : "+s"(kpb)); xcd_barrier(kpb->bar, xst); }
        KParamsPtr kp = (KParamsPtr)__builtin_amdgcn_kernarg_segment_ptr();
        asm volatile("" : "+s"(kp));
        const Params& p = *(const Params*)kp;
        if (ph == 0) { phase_prologue(p, smem); continue; }
        if (ph == N_PHASES - 1) { phase_norm<true>(p, p.out, p.hc, p.g_final, nullptr, 0, NLAT); continue; }
        const int l = (ph - 1) / PH_PER_LAYER, s = (ph - 1) % PH_PER_LAYER;
        const bool last = l == DEPTH - 1;
        const float* mods_l = p.mods + (size_t)l * 17 * MODW;
        const bool first = (l == 0 && s <= 2);
        const float* lat_in = first ? p.x : p.out;
        const float* cx_in = first ? p.ctx : p.hc;
        if (s == 0 || s == 3 || s == 7) {
            const int j = s == 0 ? 0 : (s == 3 ? 1 : 2);
            phase_norm<false>(p, lat_in, cx_in, p.g_norm + (l * 3 + j) * D, mods_l, 3 * j, (s == 7 && last) ? NLAT : NTOK);
        } else if (s == 1 || s == 8) {
            EpiSwiglu e{p.hid};
            phase_gemm(p.xn, (s == 1 ? p.Wff1in : p.Wff2in) + (size_t)l * D * 2 * DFF, (s == 8 && last) ? NLAT : NTOK, 2 * DFF, D, e, smem);
        } else if (s == 2 || s == 6 || s == 9) {
            const bf16_t* A = s == 6 ? p.cat : p.hid;
            const bf16_t* Bt = s == 2 ? p.Wff1out + (size_t)l * D * DFF : (s == 9 ? p.Wff2out + (size_t)l * D * DFF : p.Wout + (size_t)l * D * D);
            const int K = s == 6 ? D : DFF, gi = s == 2 ? 2 : (s == 6 ? 5 : 8);
            EpiResid e{lat_in, cx_in, p.out, p.hc, mods_l + gi * D, s == 6 ? 1.0f : 0.5f};
            phase_gemm(A, Bt, (s != 2 && last) ? NLAT : NTOK, D, K, e, smem);
        } else if (s == 4) {
            EpiProj e{&p, l}; phase_gemm(p.xn, p.Win + (size_t)l * D * INC, NTOK, INC, D, e, smem);
        } else {
            phase_mixers(p, l, !last, smem);
        }
    }
}

extern "C" void kernel_launch(void* const* d_in, const int* in_sizes, int n_in, void* d_out, int out_size, void* d_ws, size_t ws_size, hipStream_t stream) {
    static int grid = 0;
    if (grid == 0) {
        int dev = 0, cus = 0, per_cu = 0;
        hipGetDevice(&dev);
        hipDeviceGetAttribute(&cus, hipDeviceAttributeMultiprocessorCount, dev);
        if (hipFuncSetAttribute((const void*)mega, hipFuncAttributeMaxDynamicSharedMemorySize, LDS_BYTES) != hipSuccess) fprintf(stderr, "hipFuncSetAttribute failed\n");
        if (hipOccupancyMaxActiveBlocksPerMultiprocessor(&per_cu, (const void*)mega, NTHR, LDS_BYTES) != hipSuccess || per_cu < 1) { fprintf(stderr, "occupancy query: %d\n", per_cu); per_cu = 1; }
        (void)hipGetLastError();
        grid = cus * per_cu;
        fprintf(stderr, "grid = %d (cus %d per_cu %d) ws_size %zu\n", grid, cus, per_cu, ws_size);
    }
    Params p{};
    const float** pin = (const float**)&p;
    for (int i = 0; i < 24; ++i) pin[i] = (const float*)d_in[i];
    p.out = (float*)d_out;
    char* w = (char*)d_ws; size_t off = 0;
    auto take = [&](size_t bytes) { char* r = w + off; off += (bytes + 255) & ~(size_t)255; return r; };
    p.Wff1in = (bf16_t*)take((size_t)DEPTH * D * 2 * DFF * 2);
    p.Wff1out = (bf16_t*)take((size_t)DEPTH * D * DFF * 2);
    p.Wff2in = (bf16_t*)take((size_t)DEPTH * D * 2 * DFF * 2);
    p.Wff2out = (bf16_t*)take((size_t)DEPTH * D * DFF * 2);
    p.Win = (bf16_t*)take((size_t)DEPTH * D * INC * 2);
    p.Wout = (bf16_t*)take((size_t)DEPTH * D * D * 2);
    p.Ws = (bf16_t*)take((size_t)DEPTH * 4 * 128 * 128 * 2);
    p.mods = (float*)take((size_t)DEPTH * 17 * MODW * 4);
    p.ropeA = (float*)take((size_t)SEQ * 32 * 2 * 4);
    p.ropeC = (float*)take((size_t)SEQ * 16 * 2 * 4);
    p.bar = (unsigned*)take((size_t)XCD_BAR_WORDS * 4);
    p.hc = (float*)take((size_t)NCTX * D * 4);
    p.xn = (bf16_t*)take((size_t)NTOK * D * 2);
    p.cat = p.xn;
    p.hid = (bf16_t*)take((size_t)NTOK * DFF * 2);
    {
        char* q = (char*)p.hid; size_t o2 = 0;
        auto take2 = [&](size_t bytes) { char* r = q + o2; o2 += (bytes + 255) & ~(size_t)255; return r; };
        p.QA = (bf16_t*)take2((size_t)NB * 4 * KEYS * 64 * 2);
        p.KA = (bf16_t*)take2((size_t)NB * 2 * KEYS * 64 * 2);
        p.VtA = (bf16_t*)take2((size_t)NB * 2 * 64 * KEYS * 2);
        p.QC = (bf16_t*)take2((size_t)NB * 4 * 2 * KEYS * 32 * 2);
        p.KC = (bf16_t*)take2((size_t)NB * 4 * 2 * KEYS * 32 * 2);
        p.VtC = (bf16_t*)take2((size_t)NB * 4 * 64 * KEYS * 2);
        p.U = (bf16_t*)take2((size_t)NTOK * 256 * 2);
        p.VN = (bf16_t*)take2((size_t)NTOK * 256 * 2);
        p.Y = (bf16_t*)take2((size_t)NTOK * 256 * 2);
    }
    if (off > ws_size) { fprintf(stderr, "workspace too small: need %zu have %zu\n", off, ws_size); return; }
#if N_LAUNCH_MODE == 1
    if (hipMemsetAsync(p.bar, 0, (size_t)XCD_BAR_WORDS * 4, stream) != hipSuccess) fprintf(stderr, "memset of barrier words failed\n");
    int lo = 0, hi = N_PHASES;
    void* args[] = {&p, &lo, &hi};
    hipError_t e = hipLaunchCooperativeKernel((const void*)mega, dim3(grid), dim3(NTHR), args, LDS_BYTES, stream);
    if (e != hipSuccess) fprintf(stderr, "cooperative launch failed: %s (grid %d)\n", hipGetErrorString(e), grid);
#else
    for (int ph = 0; ph < N_PHASES; ++ph) hipLaunchKernelGGL(mega, dim3(grid), dim3(NTHR), LDS_BYTES, stream, p, ph, ph + 1);
#endif
}
```

```cpp
#include <hip/hip_runtime.h>
#include <hip/hip_cooperative_groups.h>
#include <cstdint>
#include <cstdio>
#include <cmath>
namespace cg = cooperative_groups;

#ifndef N_LAUNCH_MODE
#define N_LAUNCH_MODE 1
#endif

typedef unsigned short bf16_t;
typedef short bf16x8 __attribute__((ext_vector_type(8)));
typedef short s16x4 __attribute__((ext_vector_type(4)));
typedef float f32x4 __attribute__((ext_vector_type(4)));
typedef float f32x2 __attribute__((ext_vector_type(2)));
typedef float f32x16 __attribute__((ext_vector_type(16)));
typedef unsigned u32x2 __attribute__((ext_vector_type(2)));
typedef unsigned u32x4 __attribute__((ext_vector_type(4)));
typedef __bf16 bf2_t __attribute__((ext_vector_type(2)));
#define DI __device__ __forceinline__

constexpr int D = 1024, NB = 16, SEQ = 2048, CTX = 256, NLAT = NB * SEQ, NCTX = NB * CTX, NTOK = NLAT + NCTX;
constexpr int DFF = 2816, INC = 2304, KEYS = SEQ + CTX, DEPTH = 2, MODW = 9 * D;
constexpr int NTHR = 512;
constexpr int LDS_BYTES = 135168;
constexpr float EPS = 1e-6f;

DI unsigned pk2(float a, float b) { f32x2 v = {a, b}; bf2_t r = __builtin_convertvector(v, bf2_t); return __builtin_bit_cast(unsigned, r); }
DI float bf2f(bf16_t v) { return __uint_as_float(((unsigned)v) << 16); }
DI float bflo(unsigned v) { return __uint_as_float(v << 16); }
DI float bfhi(unsigned v) { return __uint_as_float(v & 0xffff0000u); }
DI bf16_t f2bf(float a) { return (bf16_t)(pk2(a, 0.f) & 0xffffu); }
DI float silu_f(float x) { return x / (1.f + __expf(-x)); }
DI float sigmoid_f(float x) { return 1.f / (1.f + __expf(-x)); }
DI float gelu_f(float x) { float u = 1.5957691216057308f * (x + 0.044715f * x * x * x); return x / (1.f + __expf(-u)); }
DI int TID() { int t = __builtin_amdgcn_workitem_id_x(); asm volatile("" : "+v"(t)); return t; }
DI float wave_sum(float v) {
#pragma unroll
    for (int o = 32; o >= 1; o >>= 1) v += __shfl_xor(v, o);
    return v;
}

struct Params {
    const float *x, *c, *ctx, *c_ctx, *w_ada, *b_ada, *g_norm, *w_ff1_in, *w_ff1_out, *w_ff2_in, *w_ff2_out, *w_in, *w_out, *g_q_a, *g_k_a, *lam_c,
        *g_sub_c, *g_v_b, *w_s_b, *b_s_b, *w_dw_d, *b_dw_d, *g_conv_d, *g_final;
    float* out;
    bf16_t *Wff1in, *Wff1out, *Wff2in, *Wff2out, *Win, *Wout, *Ws;
    float *mods, *ropeA, *ropeC, *hc;
    bf16_t *xn, *hid, *QA, *KA, *VtA, *QC, *KC, *VtC, *U, *VN, *Y, *cat;
    unsigned* bar;
};

DI void sincos_d(double x, double& s, double& c) {
    double k = rint(x * 0.15915494309189535);
    double r = fma(-k, 6.283185307179586, x);
    r = fma(-k, 2.4492935982947064e-16, r);
    double r2 = r * r, as = 1.0, ac = 1.0;
#pragma unroll
    for (int n = 14; n >= 1; --n) {
        as = 1.0 - r2 / (double)((2 * n) * (2 * n + 1)) * as;
        ac = 1.0 - r2 / (double)((2 * n - 1) * (2 * n)) * ac;
    }
    s = r * as; c = ac;
}

constexpr int T_FFIN = (D / 64) * (2 * DFF / 64), T_FFOUT = (DFF / 64) * (D / 64), T_WIN = (D / 64) * (INC / 64), T_WOUT = (D / 64) * (D / 64);
constexpr int T_LAYER = 2 * T_FFIN + 2 * T_FFOUT + T_WIN + T_WOUT;
constexpr int U_TR = DEPTH * T_LAYER, U_WS = 32, U_ADA = 288, U_ROPE = 192;
constexpr int U_P0 = U_TR + U_WS + U_ADA + U_ROPE;

DI void transpose_unit(const float* src, bf16_t* dst, int K, int N, int perm, int ti, float* tile) {
    const int tn = N / 64, kt = ti / tn, nt = ti % tn, k0 = kt * 64, n0 = nt * 64;
    int sc0 = n0;
    if (perm == 1) { int t = n0 >> 8, j = n0 & 255; sc0 = j < 128 ? t * 128 + j : DFF + t * 128 + (j - 128); }
    else if (perm == 2 && n0 >= 1792) { int m = n0 - 1792, t = m >> 8, j = m & 255; sc0 = j < 128 ? 1792 + t * 128 + j : 2048 + t * 128 + (j - 128); }
    const int t = TID();
    {
        const int kk = t >> 4, c4 = (t & 15) * 4;
#pragma unroll
        for (int i = 0; i < 2; ++i) {
            const int k = kk + 32 * i;
            f32x4 v = *(const f32x4*)(src + (size_t)(k0 + k) * N + sc0 + c4);
            tile[k * 65 + c4 + 0] = v[0]; tile[k * 65 + c4 + 1] = v[1]; tile[k * 65 + c4 + 2] = v[2]; tile[k * 65 + c4 + 3] = v[3];
        }
    }
    __syncthreads();
    {
        const int n = t >> 3, k8 = (t & 7) * 8;
        u32x4 o;
        o[0] = pk2(tile[(k8 + 0) * 65 + n], tile[(k8 + 1) * 65 + n]);
        o[1] = pk2(tile[(k8 + 2) * 65 + n], tile[(k8 + 3) * 65 + n]);
        o[2] = pk2(tile[(k8 + 4) * 65 + n], tile[(k8 + 5) * 65 + n]);
        o[3] = pk2(tile[(k8 + 6) * 65 + n], tile[(k8 + 7) * 65 + n]);
        *(u32x4*)(dst + (size_t)(n0 + n) * K + k0 + k8) = o;
    }
    __syncthreads();
}

DI void phase_prologue(const Params& p, char* smem) {
    const int t = TID();
    for (int u = blockIdx.x; u < U_P0; u += gridDim.x) {
        if (u < U_TR) {
            const int l = u / T_LAYER; int r = u % T_LAYER;
            const float* src; bf16_t* dst; int K, N, perm;
            if (r < T_FFIN) { src = p.w_ff1_in + (size_t)l * D * 2 * DFF; dst = p.Wff1in + (size_t)l * D * 2 * DFF; K = D; N = 2 * DFF; perm = 1; }
            else if ((r -= T_FFIN) < T_FFOUT) { src = p.w_ff1_out + (size_t)l * D * DFF; dst = p.Wff1out + (size_t)l * D * DFF; K = DFF; N = D; perm = 0; }
            else if ((r -= T_FFOUT) < T_FFIN) { src = p.w_ff2_in + (size_t)l * D * 2 * DFF; dst = p.Wff2in + (size_t)l * D * 2 * DFF; K = D; N = 2 * DFF; perm = 1; }
            else if ((r -= T_FFIN) < T_FFOUT) { src = p.w_ff2_out + (size_t)l * D * DFF; dst = p.Wff2out + (size_t)l * D * DFF; K = DFF; N = D; perm = 0; }
            else if ((r -= T_FFOUT) < T_WIN) { src = p.w_in + (size_t)l * D * INC; dst = p.Win + (size_t)l * D * INC; K = D; N = INC; perm = 2; }
            else { r -= T_WIN; src = p.w_out + (size_t)l * D * D; dst = p.Wout + (size_t)l * D * D; K = D; N = D; perm = 0; }
            transpose_unit(src, dst, K, N, perm, r, (float*)smem);
        } else if (u < U_TR + U_WS) {
            const int e0 = (u - U_TR) * 4096 + t * 8;
            f32x4 a = *(const f32x4*)(p.w_s_b + e0), b = *(const f32x4*)(p.w_s_b + e0 + 4);
            u32x4 o; o[0] = pk2(a[0], a[1]); o[1] = pk2(a[2], a[3]); o[2] = pk2(b[0], b[1]); o[3] = pk2(b[2], b[3]);
            *(u32x4*)(p.Ws + e0) = o;
        } else if (u < U_TR + U_WS + U_ADA) {
            const int uu = u - U_TR - U_WS, l = uu / 144, col0 = (uu % 144) * 64;
            float* s = (float*)smem;
            float* red = s + 17 * 1024;
            for (int i = t; i < 17 * 1024; i += NTHR) { const int r = i >> 10, k = i & 1023; const float v = r < 16 ? p.c[r * D + k] : p.c_ctx[k]; s[i] = silu_f(v); }
            __syncthreads();
            const int col = t & 63, ks = t >> 6;
            float acc[17];
#pragma unroll
            for (int r = 0; r < 17; ++r) acc[r] = 0.f;
            const float* w = p.w_ada + (size_t)l * D * MODW + (size_t)(ks * 128) * MODW + col0 + col;
            for (int k = 0; k < 128; ++k) {
                const float wv = w[(size_t)k * MODW];
#pragma unroll
                for (int r = 0; r < 17; ++r) acc[r] += s[r * 1024 + ks * 128 + k] * wv;
            }
#pragma unroll
            for (int r = 0; r < 17; ++r) red[(ks * 17 + r) * 64 + col] = acc[r];
            __syncthreads();
            for (int i = t; i < 17 * 64; i += NTHR) {
                const int r = i >> 6, cc = i & 63; float sum = 0.f;
#pragma unroll
                for (int q = 0; q < 8; ++q) sum += red[(q * 17 + r) * 64 + cc];
                p.mods[((size_t)l * 17 + r) * MODW + col0 + cc] = sum + p.b_ada[(size_t)l * MODW + col0 + cc];
            }
            __syncthreads();
        } else {
            const int e = (u - U_TR - U_WS - U_ADA) * 512 + t;
            const int pos = e / 48, j = e % 48, row = pos >> 6, col = pos & 63;
            float ang; float* dst;
            if (j < 32) { const float inv = exp2f(-(float)(j & 15) * (13.287712379549449f / 16.f)); ang = (float)(j < 16 ? row : col) * inv; dst = p.ropeA + ((size_t)pos * 32 + j) * 2; }
            else { const int jj = j - 32; const float inv = exp2f(-(float)(jj & 7) * (13.287712379549449f / 8.f)); ang = (float)(jj < 8 ? row : col) * inv; dst = p.ropeC + ((size_t)pos * 16 + jj) * 2; }
            double sn, cs; sincos_d((double)ang, sn, cs);
            dst[0] = (float)cs; dst[1] = (float)sn;
        }
    }
}

template <bool FINAL>
DI void phase_norm(const Params& p, const float* lat, const float* cx, const float* g, const float* mods_l, int mi, int nrows) {
    const int wid = TID() >> 6, lane = TID() & 63;
    for (int u = blockIdx.x; u < nrows / 8; u += gridDim.x) {
        const int row = u * 8 + wid;
        const float* src = row < NLAT ? lat + (size_t)row * D : cx + (size_t)(row - NLAT) * D;
        const int mb = row < NLAT ? row / SEQ : 16;
        f32x4 v[4]; float ss = 0.f;
#pragma unroll
        for (int i = 0; i < 4; ++i) { v[i] = *(const f32x4*)(src + i * 256 + lane * 4); ss += v[i][0] * v[i][0] + v[i][1] * v[i][1] + v[i][2] * v[i][2] + v[i][3] * v[i][3]; }
        ss = wave_sum(ss);
        const float rstd = rsqrtf(ss * (1.f / D) + EPS);
        if (FINAL) {
#pragma unroll
            for (int i = 0; i < 4; ++i) { const int col = i * 256 + lane * 4; const f32x4 gv = *(const f32x4*)(g + col); *(f32x4*)(p.out + (size_t)row * D + col) = v[i] * rstd * gv; }
        } else {
            const float* sh = mods_l + (size_t)mb * MODW + mi * D; const float* scl = sh + D;
#pragma unroll
            for (int i = 0; i < 4; ++i) {
                const int col = i * 256 + lane * 4;
                const f32x4 gv = *(const f32x4*)(g + col), sv = *(const f32x4*)(scl + col), bv = *(const f32x4*)(sh + col);
                const f32x4 o = v[i] * rstd * gv * (1.f + sv) + bv;
                u32x2 w; w[0] = pk2(o[0], o[1]); w[1] = pk2(o[2], o[3]);
                *(u32x2*)(p.xn + (size_t)row * D + col) = w;
            }
        }
    }
}

constexpr int BM = 256, BK = 64, HALF = 128, HT = HALF * BK, NXCD = 8, WGM = 8;
DI int lds_byte(int r, int c) { const int st = (r >> 4) * 2 + (c >> 5), rr = r & 15, cc = c & 31, ob = rr * 64 + cc * 2; return st * 1024 + (ob ^ (((ob >> 9) & 1) << 5)); }
DI void stage_rc(int b, int& R, int& C) { const int st = b / 1024, sb = b % 1024, swz = sb ^ (((sb >> 9) & 1) << 5); R = (st >> 1) * 16 + swz / 64; C = (st & 1) * 32 + (swz % 64) / 2; }

#define LAS __attribute__((address_space(3)))
constexpr int HTB = HALF * BK * 2;
DI void gemm_tile(const bf16_t* A, const bf16_t* Bt, int K, int brow, int bcol, f32x4 (&acc)[2][2][4][2], LAS unsigned char* lds) {
    const int tid = TID(), wid = __builtin_amdgcn_readfirstlane(tid >> 6), lane = tid & 63, wr = wid >> 2, wc = wid & 3, fr = lane & 15, fq = lane >> 4;
    const int nt = K / BK;
    unsigned voff[2];
#pragma unroll
    for (int i = 0; i < 2; ++i) { int R, C; stage_rc(tid * 16 + i * 8192, R, C); voff[i] = (unsigned)(R * K + C) * 2u; }
    const size_t kstep = (size_t)(BK * 2), hstep = (size_t)HALF * K * 2;
    const unsigned ldsw = (unsigned)wid * 1024u;
    const int aoff = lds_byte(wr * 64 + fr, fq * 8), boff = lds_byte(wc * 32 + fr, fq * 8);
#define SA(b, h) (((b) * 2 + (h)) * HTB)
#define SB(b, h) ((4 + (b) * 2 + (h)) * HTB)
#define STAGE(bufoff, gbase) do { _Pragma("unroll") for (int _i = 0; _i < 2; ++_i) \
        __builtin_amdgcn_global_load_lds((const unsigned*)((const char*)(gbase) + voff[_i]), (LAS unsigned*)(lds + (bufoff) + ldsw + _i * 8192), 16, 0, 0); } while (0)
#define LDA(dst, b, h) do { _Pragma("unroll") for (int m = 0; m < 4; ++m) _Pragma("unroll") for (int k = 0; k < 2; ++k) dst[m][k] = *(const LAS bf16x8*)(lds + SA(b, h) + aoff + m * 2048 + k * 1024); } while (0)
#define LDB(dst, b, h) do { _Pragma("unroll") for (int n = 0; n < 2; ++n) _Pragma("unroll") for (int k = 0; k < 2; ++k) dst[n][k] = *(const LAS bf16x8*)(lds + SB(b, h) + boff + n * 2048 + k * 1024); } while (0)
#define MMA(ai, bj, At_, Bt_) do { __builtin_amdgcn_s_setprio(1); _Pragma("unroll") for (int m = 0; m < 4; ++m) _Pragma("unroll") for (int n = 0; n < 2; ++n) _Pragma("unroll") for (int k = 0; k < 2; ++k) \
        acc[ai][bj][m][n] = __builtin_amdgcn_mfma_f32_16x16x32_bf16(Bt_[n][k], At_[m][k], acc[ai][bj][m][n], 0, 0, 0); __builtin_amdgcn_s_setprio(0); } while (0)
#define WAIT_V(n) asm volatile("s_waitcnt vmcnt(" #n ")" ::: "memory")
#define WAIT_L(n) asm volatile("s_waitcnt lgkmcnt(" #n ")" ::: "memory")
#define BAR __builtin_amdgcn_s_barrier()
#define SCHED __builtin_amdgcn_sched_barrier(0)
#pragma unroll
    for (int a = 0; a < 2; ++a)
#pragma unroll
        for (int b = 0; b < 2; ++b)
#pragma unroll
            for (int m = 0; m < 4; ++m)
#pragma unroll
                for (int n = 0; n < 2; ++n) acc[a][b][m][n] = (f32x4){0.f, 0.f, 0.f, 0.f};
    bf16x8 At[4][2], B0[2][2], B1[2][2];
    const char* cA = (const char*)A + (size_t)brow * K * 2; const char* cB = (const char*)Bt + (size_t)bcol * K * 2;
    STAGE(SB(0, 0), cB); STAGE(SA(0, 0), cA); STAGE(SB(0, 1), cB + hstep); STAGE(SA(0, 1), cA + hstep);
    if (wr == 1) BAR;
    WAIT_V(4); BAR;
    STAGE(SB(1, 0), cB + kstep); STAGE(SA(1, 0), cA + kstep); STAGE(SB(1, 1), cB + hstep + kstep);
    WAIT_V(6); BAR;
    for (int t = 0; t < nt - 2; t += 2) {
        const char* a1 = cA + (size_t)(t + 1) * kstep; const char* a2 = cA + (size_t)(t + 2) * kstep; const char* b2 = cB + (size_t)(t + 2) * kstep;
        const char* a3 = a2 + kstep; const char* b3 = b2 + kstep;
        LDB(B0, 0, 0); SCHED; LDA(At, 0, 0); STAGE(SA(1, 1), a1 + hstep);
        WAIT_L(8); BAR; WAIT_L(0); MMA(0, 0, At, B0); BAR; SCHED;
        LDB(B1, 0, 1); STAGE(SB(0, 0), b2);
        BAR; WAIT_L(0); MMA(0, 1, At, B1); BAR;
        LDA(At, 0, 1); STAGE(SA(0, 0), a2);
        BAR; WAIT_L(0); MMA(1, 0, At, B0); BAR; SCHED;
        STAGE(SB(0, 1), b2 + hstep);
        WAIT_V(6); BAR; MMA(1, 1, At, B1); BAR;
        LDB(B0, 1, 0); SCHED; LDA(At, 1, 0); STAGE(SA(0, 1), a2 + hstep);
        WAIT_L(8); BAR; WAIT_L(0); MMA(0, 0, At, B0); BAR; SCHED;
        LDB(B1, 1, 1); STAGE(SB(1, 0), b3);
        BAR; WAIT_L(0); MMA(0, 1, At, B1); BAR;
        LDA(At, 1, 1); STAGE(SA(1, 0), a3);
        BAR; WAIT_L(0); MMA(1, 0, At, B0); BAR; SCHED;
        STAGE(SB(1, 1), b3 + hstep);
        WAIT_V(6); BAR; MMA(1, 1, At, B1); BAR;
    }
    { LDB(B0, 0, 0); LDA(At, 0, 0); STAGE(SA(1, 1), cA + (size_t)(nt - 1) * kstep + hstep);
      BAR; WAIT_L(0); MMA(0, 0, At, B0); BAR;
      LDB(B1, 0, 1); BAR; WAIT_L(0); MMA(0, 1, At, B1); BAR;
      LDA(At, 0, 1); WAIT_V(4); BAR; WAIT_L(0); MMA(1, 0, At, B0); MMA(1, 1, At, B1); BAR; }
    { LDB(B0, 1, 0); LDA(At, 1, 0); WAIT_V(2); BAR; WAIT_L(0); MMA(0, 0, At, B0); BAR;
      LDB(B1, 1, 1); WAIT_V(0); BAR; WAIT_L(0); MMA(0, 1, At, B1); BAR;
      LDA(At, 1, 1); BAR; WAIT_L(0); MMA(1, 0, At, B0); MMA(1, 1, At, B1); BAR; }
    if (wr == 0) BAR;
}

DI void tile_order(int L, int nM, int nN, int& pm, int& pn) {
    const int nwg = nM * nN; int wgid = L;
    { const int q = nwg / NXCD, r = nwg % NXCD, xcd = wgid % NXCD, off = wgid / NXCD; wgid = (xcd < r ? xcd * (q + 1) : r * (q + 1) + (xcd - r) * q) + off; }
    const int nig = WGM * nN, gid = wgid / nig, fm = gid * WGM, gsz = (nM - fm) < WGM ? (nM - fm) : WGM;
    pm = fm + ((wgid % nig) % gsz); pn = (wgid % nig) / gsz;
}

struct EpiSwiglu {
    bf16_t* hid;
    DI void operator()(f32x4 (&acc)[2][2][4][2], int pm, int pn, char* smem) const {
        const int wid = TID() >> 6, lane = TID() & 63, wr = wid >> 2, wc = wid & 3, fr = lane & 15, fq = lane >> 4;
#pragma unroll
        for (int ai = 0; ai < 2; ++ai)
#pragma unroll
            for (int m = 0; m < 4; ++m) {
                const int row = pm * BM + ai * HALF + wr * 64 + m * 16 + fr;
#pragma unroll
                for (int n = 0; n < 2; ++n) {
                    const f32x4 a = acc[ai][0][m][n], b = acc[ai][1][m][n];
                    u32x2 w; w[0] = pk2(silu_f(a[0]) * b[0], silu_f(a[1]) * b[1]); w[1] = pk2(silu_f(a[2]) * b[2], silu_f(a[3]) * b[3]);
                    *(u32x2*)(hid + (size_t)row * DFF + pn * 128 + wc * 32 + n * 16 + fq * 4) = w;
                }
            }
    }
};
struct EpiResid {
    const float *lat_in, *cx_in; float *lat_out, *cx_out; const float* gate; float gs;
    DI void operator()(f32x4 (&acc)[2][2][4][2], int pm, int pn, char* smem) const {
        const int wid = TID() >> 6, lane = TID() & 63, wr = wid >> 2, wc = wid & 3, fr = lane & 15, fq = lane >> 4;
        const int row0 = pm * BM; const bool islat = row0 < NLAT;
        const size_t base = (size_t)(islat ? row0 : row0 - NLAT) * D + (size_t)(wr * 64 + fr) * D + pn * BM + wc * 32 + fq * 4;
        const float* in = (islat ? lat_in : cx_in) + base;
        float* out = (islat ? lat_out : cx_out) + base;
        const float* gt = gate + (size_t)(islat ? row0 / SEQ : 16) * MODW + pn * BM + wc * 32 + fq * 4;
        f32x4 gv[2][2];
#pragma unroll
        for (int bj = 0; bj < 2; ++bj)
#pragma unroll
            for (int n = 0; n < 2; ++n) gv[bj][n] = *(const f32x4*)(gt + bj * HALF + n * 16) * gs;
#pragma unroll
        for (int ai = 0; ai < 2; ++ai)
#pragma unroll
            for (int m = 0; m < 4; ++m) {
                const size_t ro = (size_t)(ai * HALF + m * 16) * D;
                f32x4 hv[2][2];
#pragma unroll
                for (int bj = 0; bj < 2; ++bj)
#pragma unroll
                    for (int n = 0; n < 2; ++n) hv[bj][n] = *(const f32x4*)(in + ro + bj * HALF + n * 16);
#pragma unroll
                for (int bj = 0; bj < 2; ++bj)
#pragma unroll
                    for (int n = 0; n < 2; ++n) *(f32x4*)(out + ro + bj * HALF + n * 16) = hv[bj][n] + gv[bj][n] * acc[ai][bj][m][n];
                if (m & 1) __builtin_amdgcn_sched_barrier(0);
            }
    }
};
constexpr int TS = 257;
struct EpiProj {
    const Params* pp; int l;
    DI void operator()(f32x4 (&acc)[2][2][4][2], int pm, int pn, char* smem) const {
        const Params& p = *pp;
        float* T = (float*)smem;
        const int tid = TID(), wid = tid >> 6, lane = tid & 63, wr = wid >> 2, wc = wid & 3, fr = lane & 15, fq = lane >> 4;
#pragma unroll
        for (int ai = 0; ai < 2; ++ai) {
            __syncthreads();
#pragma unroll
            for (int bj = 0; bj < 2; ++bj)
#pragma unroll
                for (int m = 0; m < 4; ++m)
#pragma unroll
                    for (int n = 0; n < 2; ++n)
#pragma unroll
                        for (int j = 0; j < 4; ++j) T[(wr * 64 + m * 16 + fr) * TS + bj * HALF + wc * 32 + n * 16 + fq * 4 + j] = acc[ai][bj][m][n][j];
            __syncthreads();
            const int rl = tid & 127, seg = tid >> 7, grow = pm * BM + ai * HALF + rl;
            const bool islat = grow < NLAT;
            const int b = islat ? grow / SEQ : (grow - NLAT) / CTX;
            const int pos = islat ? grow % SEQ : SEQ + (grow - NLAT) % CTX;
            const float* xr = T + rl * TS + seg * 64;
            if (pn == 0 || (pn == 2 && seg < 2)) {
                const float* g = (pn == 0 ? p.g_q_a : p.g_k_a) + l * 64;
                bf16_t* dst = pn == 0 ? p.QA + ((size_t)(b * 4 + seg) * KEYS + pos) * 64 : p.KA + ((size_t)(b * 2 + seg) * KEYS + pos) * 64;
                float ss = 0.f;
                for (int i = 0; i < 64; ++i) ss += xr[i] * xr[i];
                const float rstd = rsqrtf(ss * (1.f / 64.f) + EPS);
                const float* rp = p.ropeA + (size_t)(islat ? pos : 0) * 64;
                for (int i0 = 0; i0 < 32; i0 += 8) {
                    float o1[8], o2[8];
#pragma unroll
                    for (int i = 0; i < 8; ++i) {
                        const float a = xr[i0 + i] * rstd * g[i0 + i], bb = xr[i0 + i + 32] * rstd * g[i0 + i + 32];
                        float cs = 1.f, sn = 0.f;
                        if (islat) { cs = rp[(i0 + i) * 2]; sn = rp[(i0 + i) * 2 + 1]; }
                        o1[i] = a * cs - bb * sn; o2[i] = a * sn + bb * cs;
                    }
                    u32x4 w1, w2;
#pragma unroll
                    for (int i = 0; i < 4; ++i) { w1[i] = pk2(o1[2 * i], o1[2 * i + 1]); w2[i] = pk2(o2[2 * i], o2[2 * i + 1]); }
                    *(u32x4*)(dst + i0) = w1; *(u32x4*)(dst + 32 + i0) = w2;
                }
            } else if (pn == 1 || pn == 3) {
                bf16_t* base = (pn == 1 ? p.QC : p.KC);
                const float* rp = p.ropeC + (size_t)(islat ? pos : 0) * 32;
#pragma unroll
                for (int mp = 0; mp < 2; ++mp) {
                    bf16_t* dst = base + ((size_t)((b * 4 + seg) * 2 + mp) * KEYS + pos) * 32;
                    for (int i0 = 0; i0 < 16; i0 += 8) {
                        float o1[8], o2[8];
#pragma unroll
                        for (int i = 0; i < 8; ++i) {
                            const float a = xr[mp * 32 + i0 + i], bb = xr[mp * 32 + i0 + i + 16];
                            float cs = 1.f, sn = 0.f;
                            if (islat) { cs = rp[(i0 + i) * 2]; sn = rp[(i0 + i) * 2 + 1]; }
                            o1[i] = a * cs - bb * sn; o2[i] = a * sn + bb * cs;
                        }
                        u32x4 w1, w2;
#pragma unroll
                        for (int i = 0; i < 4; ++i) { w1[i] = pk2(o1[2 * i], o1[2 * i + 1]); w2[i] = pk2(o2[2 * i], o2[2 * i + 1]); }
                        *(u32x4*)(dst + i0) = w1; *(u32x4*)(dst + 16 + i0) = w2;
                    }
                }
            } else if (pn == 2 || pn == 4) {
                bf16_t* dst = pn == 2 ? p.VtA + ((size_t)(b * 2 + (seg - 2)) * 64) * KEYS + pos : p.VtC + ((size_t)(b * 4 + seg) * 64) * KEYS + pos;
                for (int d = 0; d < 64; ++d) dst[(size_t)d * KEYS] = f2bf(xr[d]);
            } else if (pn == 5) {
                bf16_t* dst = p.U + (size_t)grow * 256 + seg * 64;
                for (int i0 = 0; i0 < 64; i0 += 8) {
                    u32x4 w;
#pragma unroll
                    for (int i = 0; i < 4; ++i) w[i] = pk2(gelu_f(xr[i0 + 2 * i]), gelu_f(xr[i0 + 2 * i + 1]));
                    *(u32x4*)(dst + i0) = w;
                }
            } else if (pn == 6) {
                const float* xrow = T + rl * TS; float ss = 0.f;
                for (int i = 0; i < 256; ++i) { const float gv = gelu_f(xrow[i]); ss += gv * gv; }
                const float rstd = rsqrtf(ss * (1.f / 256.f) + EPS);
                const float* g = p.g_v_b + l * 256 + seg * 64;
                bf16_t* dst = p.VN + (size_t)grow * 256 + seg * 64;
                for (int i0 = 0; i0 < 64; i0 += 8) {
                    u32x4 w;
#pragma unroll
                    for (int i = 0; i < 4; ++i) w[i] = pk2(gelu_f(xr[i0 + 2 * i]) * rstd * g[i0 + 2 * i], gelu_f(xr[i0 + 2 * i + 1]) * rstd * g[i0 + 2 * i + 1]);
                    *(u32x4*)(dst + i0) = w;
                }
            } else {
                if (seg < 2) {
                    const float* gr = xr + 128;
                    bf16_t* dst = p.Y + (size_t)grow * 256 + (pn - 7) * 128 + seg * 64;
                    for (int i0 = 0; i0 < 64; i0 += 8) {
                        u32x4 w;
#pragma unroll
                        for (int i = 0; i < 4; ++i) w[i] = pk2(xr[i0 + 2 * i] * sigmoid_f(gr[i0 + 2 * i]), xr[i0 + 2 * i + 1] * sigmoid_f(gr[i0 + 2 * i + 1]));
                        *(u32x4*)(dst + i0) = w;
                    }
                }
            }
        }
        __syncthreads();
    }
};

template <class Epi>
DI void phase_gemm(const bf16_t* A, const bf16_t* Bt, int M, int N, int K, const Epi& epi, char* smem) {
    const int nM = M / BM, nN = N / BM, nwg = nM * nN;
    for (int L = blockIdx.x; L < nwg; L += gridDim.x) {
        int pm, pn; tile_order(L, nM, nN, pm, pn);
        f32x4 acc[2][2][4][2];
        gemm_tile(A, Bt, K, pm * BM, pn * BM, acc, (LAS unsigned char*)smem);
        epi(acc, pm, pn, smem);
    }
}

constexpr int VROW = 144;
template <int DQK>
DI void attn_core(const bf16_t* Q, const bf16_t* Kg, const bf16_t* Vt, int qpos0, int key_lo, int nkt, float sc, f32x16 (&O)[2], char* smem) {
    constexpr int KROW = DQK * 2 + 16, KBUF = 64 * KROW, VBUF = 64 * VROW, NKS = DQK / 16, NSLOT = 4;
    LAS char* lds = (LAS char*)smem;
    const int tid = TID(), lane = tid & 63, wid = tid >> 6, r = lane & 31, h = lane >> 5;
    bf16x8 qf[NKS];
#pragma unroll
    for (int ks = 0; ks < NKS; ++ks) qf[ks] = *(const bf16x8*)(Q + (size_t)(qpos0 + wid * 32 + r) * DQK + ks * 16 + 8 * h);
#pragma unroll
    for (int i = 0; i < 16; ++i) { O[0][i] = 0.f; O[1][i] = 0.f; }
    float m_run = -1e30f, l_run = 0.f;
    constexpr int KCH = DQK / 8;
    const bool kact = tid < 64 * KCH;
    const int kkey = tid / KCH, kch = tid % KCH, vd = tid >> 3, vch = tid & 7;
    const int kst = kkey * KROW + kch * 16, vst = NSLOT * KBUF + vd * VROW + vch * 16;
    const int krd = r * KROW + 16 * h, vrd = NSLOT * KBUF + r * VROW + 8 * h;
    const bf16_t* kg = Kg + (size_t)(key_lo + kkey) * DQK + kch * 8;
    const bf16_t* vg = Vt + (size_t)vd * KEYS + key_lo + vch * 8;
    u32x4 kreg = {0, 0, 0, 0}, vreg;
    bf16x8 kf[NKS]; u32x2 vf[2][2][2];
    auto gload = [&](int t) { if (kact) kreg = *(const u32x4*)(kg + (size_t)t * 64 * DQK); vreg = *(const u32x4*)(vg + t * 64); };
    auto lstore = [&](int slot) { if (kact) *(LAS u32x4*)(lds + slot * KBUF + kst) = kreg; *(LAS u32x4*)(lds + slot * VBUF + vst) = vreg; };
    auto ldk = [&](int slot, int kk) {
        const LAS char* kb = lds + slot * KBUF + krd + kk * 32 * KROW;
#pragma unroll
        for (int ks = 0; ks < NKS; ++ks) kf[ks] = *(const LAS bf16x8*)(kb + ks * 32);
    };
    auto ldv = [&](int slot, int kk) {
        const LAS char* vb = lds + slot * VBUF + vrd + kk * 64;
#pragma unroll
        for (int st = 0; st < 2; ++st)
#pragma unroll
            for (int dt = 0; dt < 2; ++dt) { const LAS char* vp = vb + dt * 32 * VROW + st * 32; vf[st][dt][0] = *(const LAS u32x2*)vp; vf[st][dt][1] = *(const LAS u32x2*)(vp + 16); }
    };
    auto qk = [&]() -> f32x16 {
        f32x16 s;
#pragma unroll
        for (int i = 0; i < 16; ++i) s[i] = 0.f;
#pragma unroll
        for (int ks = 0; ks < NKS; ++ks) s = __builtin_amdgcn_mfma_f32_32x32x16_bf16(kf[ks], qf[ks], s, 0, 0, 0);
        return s;
    };
    auto soft_pv = [&](f32x16& s) {
        float mx = s[0];
#pragma unroll
        for (int i = 1; i < 16; ++i) mx = __ocml_fmax_f32(mx, s[i]);
        mx = fmaxf(mx, __shfl_xor(mx, 32));
        const float m_new = fmaxf(m_run, mx * sc);
        if (__builtin_amdgcn_ballot_w64(m_new > m_run) != 0ull) {
            const float alpha = __builtin_amdgcn_exp2f(m_run - m_new);
            m_run = m_new; l_run *= alpha;
#pragma unroll
            for (int i = 0; i < 16; ++i) { O[0][i] *= alpha; O[1][i] *= alpha; }
        }
        float ps = 0.f;
#pragma unroll
        for (int i = 0; i < 16; ++i) { s[i] = __builtin_amdgcn_exp2f(s[i] * sc - m_run); ps += s[i]; }
        l_run += ps;
#pragma unroll
        for (int st = 0; st < 2; ++st) {
            u32x4 pw;
#pragma unroll
            for (int i = 0; i < 4; ++i) pw[i] = pk2(s[8 * st + 2 * i], s[8 * st + 2 * i + 1]);
            const bf16x8 pf = __builtin_bit_cast(bf16x8, pw);
#pragma unroll
            for (int dt = 0; dt < 2; ++dt) {
                u32x4 vw = {vf[st][dt][0][0], vf[st][dt][0][1], vf[st][dt][1][0], vf[st][dt][1][1]};
                O[dt] = __builtin_amdgcn_mfma_f32_32x32x16_bf16(__builtin_bit_cast(bf16x8, vw), pf, O[dt], 0, 0, 0);
            }
        }
    };
    __syncthreads();
    gload(0); lstore(0);
    if (nkt > 1) { gload(1); lstore(1); }
    if (nkt > 2) gload(2);
    __syncthreads();
    ldk(0, 0);
    f32x16 sn = qk();
    ldk(0, 1);
    for (int t = 0; t < nkt; ++t) {
        const int cur = t & 3, nxt = (t + 1) & 3;
        if (t + 2 < nkt) lstore((t + 2) & 3);
        if (t + 3 < nkt) gload(t + 3);
        f32x16 s = sn;
        sn = qk();
        __builtin_amdgcn_sched_barrier(0);
        if (t + 1 < nkt) ldk(nxt, 0);
        ldv(cur, 0);
        __builtin_amdgcn_sched_barrier(0);
        soft_pv(s);
        __builtin_amdgcn_sched_barrier(0);
        s = sn;
        if (t + 1 < nkt) sn = qk();
        __builtin_amdgcn_sched_barrier(0);
        if (t + 1 < nkt) ldk(nxt, 1);
        ldv(cur, 1);
        __builtin_amdgcn_sched_barrier(0);
        soft_pv(s);
        __syncthreads();
    }
    const float lt = l_run + __shfl_xor(l_run, 32);
    const float inv = 1.f / lt;
#pragma unroll
    for (int i = 0; i < 16; ++i) { O[0][i] *= inv; O[1][i] *= inv; }
}

DI void store_OT(const f32x16 (&O)[2], bf16_t* dst  , int h) {
#pragma unroll
    for (int dt = 0; dt < 2; ++dt)
#pragma unroll
        for (int gq = 0; gq < 4; ++gq) {
            u32x2 w; w[0] = pk2(O[dt][4 * gq], O[dt][4 * gq + 1]); w[1] = pk2(O[dt][4 * gq + 2], O[dt][4 * gq + 3]);
            *(u32x2*)(dst + dt * 32 + 8 * gq + 4 * h) = w;
        }
}

DI void attn_unit(const Params& p, int l, int bh, int qb, bool isC, char* smem) {
    const int head = bh & 3, b = bh >> 2;
    const int lane = TID() & 63, wid = TID() >> 6, r = lane & 31, h = lane >> 5;
    const int qpos0 = qb < 8 ? qb * 256 : SEQ, key_lo = qb < 8 ? 0 : SEQ, nkt = qb < 8 ? KEYS / 64 : CTX / 64;
    const int qpos = qpos0 + wid * 32 + r;
    const size_t grow = qpos < SEQ ? (size_t)b * SEQ + qpos : (size_t)NLAT + b * CTX + (qpos - SEQ);
    if (!isC) {
        f32x16 O[2];
        attn_core<64>(p.QA + (size_t)(b * 4 + head) * KEYS * 64, p.KA + (size_t)(b * 2 + (head >> 1)) * KEYS * 64, p.VtA + (size_t)(b * 2 + (head >> 1)) * 64 * KEYS,
                      qpos0, key_lo, nkt, 0.125f * 1.4426950408889634f, O, smem);
        store_OT(O, p.cat + grow * D + head * 64, h);
    } else {
        const float lam_init = 0.8f - 0.6f * __expf(-0.3f * (float)l);
        float d0 = 0.f, d1 = 0.f;
        const float* lp = p.lam_c + l * 128;
        for (int i = 0; i < 32; ++i) { d0 += lp[i] * lp[32 + i]; d1 += lp[64 + i] * lp[96 + i]; }
        const float lam = __expf(d0) - __expf(d1) + lam_init;
        const bf16_t* Vt = p.VtC + (size_t)(b * 4 + head) * 64 * KEYS;
        f32x16 O0[2], O1[2];
        attn_core<32>(p.QC + (size_t)((b * 4 + head) * 2 + 0) * KEYS * 32, p.KC + (size_t)((b * 4 + head) * 2 + 0) * KEYS * 32, Vt, qpos0, key_lo, nkt,
                      0.17677669529663687f * 1.4426950408889634f, O0, smem);
        attn_core<32>(p.QC + (size_t)((b * 4 + head) * 2 + 1) * KEYS * 32, p.KC + (size_t)((b * 4 + head) * 2 + 1) * KEYS * 32, Vt, qpos0, key_lo, nkt,
                      0.17677669529663687f * 1.4426950408889634f, O1, smem);
        float ss = 0.f;
#pragma unroll
        for (int dt = 0; dt < 2; ++dt)
#pragma unroll
            for (int i = 0; i < 16; ++i) { const float v = O0[dt][i] - lam * O1[dt][i]; O0[dt][i] = v; ss += v * v; }
        ss += __shfl_xor(ss, 32);
        const float rstd = rsqrtf(ss * (1.f / 64.f) + EPS) * (1.f - lam_init);
        const float* g = p.g_sub_c + l * 64;
#pragma unroll
        for (int dt = 0; dt < 2; ++dt)
#pragma unroll
            for (int i = 0; i < 16; ++i) O0[dt][i] *= rstd * g[dt * 32 + 8 * (i >> 2) + 4 * h + (i & 3)];
        store_OT(O0, p.cat + grow * D + 256 + head * 64, h);
    }
}

DI void gmlp_unit(const Params& p, int l, int uidx, char* smem) {
    const int g = uidx & 3, c = uidx >> 2, tid = TID(), lane = tid & 63, wid = tid >> 6, fr = lane & 15, fq = lane >> 4;
    bf16_t* vT = (bf16_t*)smem;
    constexpr int VS = 136;
    __syncthreads();
    {
        const int q = tid >> 2, d0 = (tid & 3) * 16;
        const bf16_t* src = p.VN + (size_t)(c * 128 + q) * 256 + g * 64 + d0;
        const bf16x8 a = *(const bf16x8*)src, bb = *(const bf16x8*)(src + 8);
#pragma unroll
        for (int j = 0; j < 8; ++j) { vT[(d0 + j) * VS + q] = (bf16_t)a[j]; vT[(d0 + 8 + j) * VS + q] = (bf16_t)bb[j]; }
    }
    __syncthreads();
    f32x4 acc[4];
#pragma unroll
    for (int n = 0; n < 4; ++n) acc[n] = (f32x4){0.f, 0.f, 0.f, 0.f};
    const bf16_t* wrow = p.Ws + ((size_t)(l * 4 + g) * 128 + wid * 16 + fr) * 128;
#pragma unroll
    for (int ks = 0; ks < 4; ++ks) {
        const bf16x8 af = *(const bf16x8*)(wrow + ks * 32 + fq * 8);
#pragma unroll
        for (int n = 0; n < 4; ++n) {
            const bf16x8 bfv = *(const bf16x8*)(vT + (n * 16 + fr) * VS + ks * 32 + fq * 8);
            acc[n] = __builtin_amdgcn_mfma_f32_16x16x32_bf16(bfv, af, acc[n], 0, 0, 0);
        }
    }
    const int prow = wid * 16 + fr; const size_t grow = (size_t)c * 128 + prow;
    const float bias = p.b_s_b[(l * 4 + g) * 128 + prow];
#pragma unroll
    for (int n = 0; n < 4; ++n) {
        const int col = g * 64 + n * 16 + fq * 4;
        const u32x2 uu = *(const u32x2*)(p.U + grow * 256 + col);
        u32x2 w;
        w[0] = pk2(bflo(uu[0]) * (acc[n][0] + bias), bfhi(uu[0]) * (acc[n][1] + bias));
        w[1] = pk2(bflo(uu[1]) * (acc[n][2] + bias), bfhi(uu[1]) * (acc[n][3] + bias));
        *(u32x2*)(p.cat + grow * D + 512 + col) = w;
    }
}

DI void conv_unit(const Params& p, int l, int uidx, char* smem) {
    const int tid = TID(), lane = tid & 63, wid = tid >> 6;
    bf16_t* yin = (bf16_t*)smem;
    float* co = (float*)(smem + 94 * 256 * 2);
    const int row0 = uidx * 64;
    int s0, s1;
    if (row0 < NLAT) { s0 = (row0 / SEQ) * SEQ; s1 = s0 + SEQ; } else { s0 = NLAT + ((row0 - NLAT) / CTX) * CTX; s1 = s0 + CTX; }
    __syncthreads();
    for (int i = tid; i < 94 * 32; i += NTHR) {
        const int rr = i >> 5, ch8 = (i & 31) * 8, gr = row0 - 15 + rr;
        u32x4 v = {0, 0, 0, 0};
        if (gr >= s0 && gr < s1) v = *(const u32x4*)(p.Y + (size_t)gr * 256 + ch8);
        *(u32x4*)(yin + rr * 256 + ch8) = v;
    }
    __syncthreads();
    {
        const int ch = tid & 255, th = tid >> 8;
        float w[31];
#pragma unroll
        for (int k = 0; k < 31; ++k) w[k] = p.w_dw_d[(size_t)(l * 31 + k) * 256 + ch];
        const float bias = p.b_dw_d[l * 256 + ch];
        for (int i = th * 32; i < th * 32 + 32; ++i) {
            float a = bias;
#pragma unroll
            for (int k = 0; k < 31; ++k) a += w[k] * bf2f(yin[(i + k) * 256 + ch]);
            co[i * 256 + ch] = a;
        }
    }
    __syncthreads();
#pragma unroll
    for (int j = 0; j < 8; ++j) {
        const int tk = wid * 8 + j;
        const f32x4 v = *(const f32x4*)(co + tk * 256 + lane * 4);
        const float ss = wave_sum(v[0] * v[0] + v[1] * v[1] + v[2] * v[2] + v[3] * v[3]);
        const float rstd = rsqrtf(ss * (1.f / 256.f) + EPS);
        const f32x4 g = *(const f32x4*)(p.g_conv_d + l * 256 + lane * 4);
        u32x2 w; w[0] = pk2(silu_f(v[0] * rstd * g[0]), silu_f(v[1] * rstd * g[1])); w[1] = pk2(silu_f(v[2] * rstd * g[2]), silu_f(v[3] * rstd * g[3]));
        *(u32x2*)(p.cat + (size_t)(row0 + tk) * D + 768 + lane * 4) = w;
    }
}

DI void phase_mixers(const Params& p, int l, bool withctx, char* smem) {
    const int nL = NB * 4 * 8, nX = withctx ? NB * 4 : 0;
    const int nG = (withctx ? NTOK : NLAT) / 128 * 4, nV = (withctx ? NTOK : NLAT) / 64;
    const int total = 2 * nL + 2 * nX + nG + nV;
    for (int u = blockIdx.x; u < total; u += gridDim.x) {
        asm volatile("" : "+s"(l));
        int r = u;
        if (r < 2 * nL + 2 * nX) {
            int bh, qb; bool isC;
            if (r < 2 * nL) { isC = r < nL; if (!isC) r -= nL; bh = r >> 3; qb = r & 7; }
            else { r -= 2 * nL; isC = r < nX; if (!isC) r -= nX; bh = r; qb = 8; }
            if (isC) attn_unit(p, l, bh, qb, true, smem); else attn_unit(p, l, bh, qb, false, smem);
        } else if ((r -= 2 * nL + 2 * nX) < nG) gmlp_unit(p, l, r, smem);
        else conv_unit(p, l, r - nG, smem);
    }
}

#define XB_TMO      128
#define XB_XCNT(j)  (256  + 64 * (j))
#define XB_XSUB(j)  (1280 + 64 * (j))
#define XB_XGEN(j)  (2304 + 64 * (j))
#define XB_TOP      3328
#define XB_TOPGEN   3392
#define XCD_BAR_WORDS 3456
#define XB_SPIN_CAP (1u << 22)
DI unsigned xb_ld(unsigned* p) { return __hip_atomic_load(p, __ATOMIC_RELAXED, __HIP_MEMORY_SCOPE_AGENT); }
DI unsigned xb_add(unsigned* p, unsigned v) { return __hip_atomic_fetch_add(p, v, __ATOMIC_RELAXED, __HIP_MEMORY_SCOPE_AGENT); }
DI unsigned xb_xcc_id() { return (unsigned)__builtin_amdgcn_s_getreg((3 << 11) | 20) & 0xFu; }
#define XB_SPIN(cond, bar) do { unsigned _sp = 0; while (cond) { __builtin_amdgcn_s_sleep(1); \
    if ((++_sp & 255u) == 0u) { if (xb_ld(&(bar)[XB_TMO])) break; if (_sp > XB_SPIN_CAP) { atomicAdd(&(bar)[XB_TMO], 1u); break; } } } } while (0)
DI void xcd_barrier_complete(unsigned* bar, unsigned x, unsigned& nloc, unsigned& nx) {
    const unsigned G = gridDim.x;
    unsigned sum, cnt, mine, sp = 0u;
    for (;;) {
        sum = 0u; cnt = 0u; mine = 0u;
#pragma unroll
        for (unsigned j = 0; j < 16; ++j) { const unsigned c = xb_ld(&bar[XB_XCNT(j)]); sum += c; cnt += (c > 0u) ? 1u : 0u; mine = (j == x) ? c : mine; }
        if (sum == G) break;
        __builtin_amdgcn_s_sleep(1);
        if ((++sp & 255u) == 0u) { if (xb_ld(&bar[XB_TMO])) break; if (sp > XB_SPIN_CAP) { atomicAdd(&bar[XB_TMO], 1u); break; } }
    }
    nloc = mine > 0u ? mine : 1u; nx = cnt > 0u ? cnt : 1u;
}
DI void xcd_barrier(unsigned* bar, volatile LAS unsigned* st) {
    asm volatile("s_waitcnt vmcnt(0)" ::: "memory");
    __syncthreads();
    if (__builtin_amdgcn_workitem_id_x() == 0) {
        __builtin_amdgcn_s_waitcnt(0);
        const unsigned x = xb_xcc_id();
        unsigned nloc = st[0], nx = st[1];
        if (nloc == 0u) { xcd_barrier_complete(bar, x, nloc, nx); st[0] = nloc; st[1] = nx; }
        const unsigned old = xb_add(&bar[XB_XSUB(x)], 1u);
        const unsigned gen = old / nloc;
        if (old + 1u == (gen + 1u) * nloc) {
            __builtin_amdgcn_fence(__ATOMIC_RELEASE, "agent");
            asm volatile("s_waitcnt vmcnt(0)" ::: "memory");
            const unsigned og = xb_add(&bar[XB_TOP], 1u);
            const unsigned tg = og / nx;
            if (og + 1u == (tg + 1u) * nx) xb_add(&bar[XB_TOPGEN], 1u);
            else XB_SPIN(xb_ld(&bar[XB_TOPGEN]) == tg, bar);
            __builtin_amdgcn_fence(__ATOMIC_ACQUIRE, "agent");
            xb_add(&bar[XB_XGEN(x)], 1u);
            asm volatile("s_waitcnt vmcnt(0)" ::: "memory");
        } else {
            XB_SPIN(xb_ld(&bar[XB_XGEN(x)]) == gen, bar);
            __builtin_amdgcn_fence(__ATOMIC_ACQUIRE, "agent");
            asm volatile("s_waitcnt vmcnt(0)" ::: "memory");
        }
    }
    __syncthreads();
}

constexpr int PH_PER_LAYER = 10, N_PHASES = 1 + DEPTH * PH_PER_LAYER + 1;

typedef const __attribute__((address_space(4))) Params* KParamsPtr;
__global__ void __launch_bounds__(NTHR) mega(Params p_unused, int ph_lo, int ph_hi) {
    extern __shared__ __attribute__((aligned(16))) char smem[];
    volatile LAS unsigned* xst = (volatile LAS unsigned*)(smem + LDS_BYTES - 16);
    if (ph_hi - ph_lo > 1) {
        if (__builtin_amdgcn_workitem_id_x() == 0) {
            xst[0] = 0u; xst[1] = 0u;
            KParamsPtr kp0 = (KParamsPtr)__builtin_amdgcn_kernarg_segment_ptr();
            (void)xb_add(&kp0->bar[XB_XCNT(xb_xcc_id())], 1u);
        }
        __syncthreads();
    }
#ifndef PROBE_PH
#define PROBE_PH -1
#endif
    for (int it = ph_lo; it < ph_hi + (PROBE_PH >= 0 ? 1 : 0); ++it) {
        const int ph = (PROBE_PH >= 0 && it > PROBE_PH) ? it - 1 : it;
        if (it == ph_lo + 1) cg::this_grid().sync();
        else if (it > ph_lo) { KParamsPtr kpb = (KParamsPtr)__builtin_amdgcn_kernarg_segment_ptr(); asm volatile("" : "+s"(kpb)); xcd_barrier(kpb->bar, xst); }
        KParamsPtr kp = (KParamsPtr)__builtin_amdgcn_kernarg_segment_ptr();
        asm volatile("" : "+s"(kp));
        const Params& p = *(const Params*)kp;
        if (ph == 0) { phase_prologue(p, smem); continue; }
        if (ph == N_PHASES - 1) { phase_norm<true>(p, p.out, p.hc, p.g_final, nullptr, 0, NLAT); continue; }
        const int l = (ph - 1) / PH_PER_LAYER, s = (ph - 1) % PH_PER_LAYER;
        const bool last = l == DEPTH - 1;
        const float* mods_l = p.mods + (size_t)l * 17 * MODW;
        const bool first = (l == 0 && s <= 2);
        const float* lat_in = first ? p.x : p.out;
        const float* cx_in = first ? p.ctx : p.hc;
        if (s == 0 || s == 3 || s == 7) {
            const int j = s == 0 ? 0 : (s == 3 ? 1 : 2);
            phase_norm<false>(p, lat_in, cx_in, p.g_norm + (l * 3 + j) * D, mods_l, 3 * j, (s == 7 && last) ? NLAT : NTOK);
        } else if (s == 1 || s == 8) {
            EpiSwiglu e{p.hid};
            phase_gemm(p.xn, (s == 1 ? p.Wff1in : p.Wff2in) + (size_t)l * D * 2 * DFF, (s == 8 && last) ? NLAT : NTOK, 2 * DFF, D, e, smem);
        } else if (s == 2 || s == 6 || s == 9) {
            const bf16_t* A = s == 6 ? p.cat : p.hid;
            const bf16_t* Bt = s == 2 ? p.Wff1out + (size_t)l * D * DFF : (s == 9 ? p.Wff2out + (size_t)l * D * DFF : p.Wout + (size_t)l * D * D);
            const int K = s == 6 ? D : DFF, gi = s == 2 ? 2 : (s == 6 ? 5 : 8);
            EpiResid e{lat_in, cx_in, p.out, p.hc, mods_l + gi * D, s == 6 ? 1.0f : 0.5f};
            phase_gemm(A, Bt, (s != 2 && last) ? NLAT : NTOK, D, K, e, smem);
        } else if (s == 4) {
            EpiProj e{&p, l}; phase_gemm(p.xn, p.Win + (size_t)l * D * INC, NTOK, INC, D, e, smem);
        } else {
            phase_mixers(p, l, !last, smem);
        }
    }
}

extern "C" void kernel_launch(void* const* d_in, const int* in_sizes, int n_in, void* d_out, int out_size, void* d_ws, size_t ws_size, hipStream_t stream) {
    static int grid = 0;
    if (grid == 0) {
        int dev = 0, cus = 0, per_cu = 0;
        hipGetDevice(&dev);
        hipDeviceGetAttribute(&cus, hipDeviceAttributeMultiprocessorCount, dev);
        if (hipFuncSetAttribute((const void*)mega, hipFuncAttributeMaxDynamicSharedMemorySize, LDS_BYTES) != hipSuccess) fprintf(stderr, "hipFuncSetAttribute failed\n");
        if (hipOccupancyMaxActiveBlocksPerMultiprocessor(&per_cu, (const void*)mega, NTHR, LDS_BYTES) != hipSuccess || per_cu < 1) { fprintf(stderr, "occupancy query: %d\n", per_cu); per_cu = 1; }
        (void)hipGetLastError();
        grid = cus * per_cu;
        fprintf(stderr, "grid = %d (cus %d per_cu %d) ws_size %zu\n", grid, cus, per_cu, ws_size);
    }
    Params p{};
    const float** pin = (const float**)&p;
    for (int i = 0; i < 24; ++i) pin[i] = (const float*)d_in[i];
    p.out = (float*)d_out;
    char* w = (char*)d_ws; size_t off = 0;
    auto take = [&](size_t bytes) { char* r = w + off; off += (bytes + 255) & ~(size_t)255; return r; };
    p.Wff1in = (bf16_t*)take((size_t)DEPTH * D * 2 * DFF * 2);
    p.Wff1out = (bf16_t*)take((size_t)DEPTH * D * DFF * 2);
    p.Wff2in = (bf16_t*)take((size_t)DEPTH * D * 2 * DFF * 2);
    p.Wff2out = (bf16_t*)take((size_t)DEPTH * D * DFF * 2);
    p.Win = (bf16_t*)take((size_t)DEPTH * D * INC * 2);
    p.Wout = (bf16_t*)take((size_t)DEPTH * D * D * 2);
    p.Ws = (bf16_t*)take((size_t)DEPTH * 4 * 128 * 128 * 2);
    p.mods = (float*)take((size_t)DEPTH * 17 * MODW * 4);
    p.ropeA = (float*)take((size_t)SEQ * 32 * 2 * 4);
    p.ropeC = (float*)take((size_t)SEQ * 16 * 2 * 4);
    p.bar = (unsigned*)take((size_t)XCD_BAR_WORDS * 4);
    p.hc = (float*)take((size_t)NCTX * D * 4);
    p.xn = (bf16_t*)take((size_t)NTOK * D * 2);
    p.cat = p.xn;
    p.hid = (bf16_t*)take((size_t)NTOK * DFF * 2);
    {
        char* q = (char*)p.hid; size_t o2 = 0;
        auto take2 = [&](size_t bytes) { char* r = q + o2; o2 += (bytes + 255) & ~(size_t)255; return r; };
        p.QA = (bf16_t*)take2((size_t)NB * 4 * KEYS * 64 * 2);
        p.KA = (bf16_t*)take2((size_t)NB * 2 * KEYS * 64 * 2);
        p.VtA = (bf16_t*)take2((size_t)NB * 2 * 64 * KEYS * 2);
        p.QC = (bf16_t*)take2((size_t)NB * 4 * 2 * KEYS * 32 * 2);
        p.KC = (bf16_t*)take2((size_t)NB * 4 * 2 * KEYS * 32 * 2);
        p.VtC = (bf16_t*)take2((size_t)NB * 4 * 64 * KEYS * 2);
        p.U = (bf16_t*)take2((size_t)NTOK * 256 * 2);
        p.VN = (bf16_t*)take2((size_t)NTOK * 256 * 2);
        p.Y = (bf16_t*)take2((size_t)NTOK * 256 * 2);
    }
    if (off > ws_size) { fprintf(stderr, "workspace too small: need %zu have %zu\n", off, ws_size); return; }
#if N_LAUNCH_MODE == 1
    if (hipMemsetAsync(p.bar, 0, (size_t)XCD_BAR_WORDS * 4, stream) != hipSuccess) fprintf(stderr, "memset of barrier words failed\n");
    int lo = 0, hi = N_PHASES;
    void* args[] = {&p, &lo, &hi};
    hipError_t e = hipLaunchCooperativeKernel((const void*)mega, dim3(grid), dim3(NTHR), args, LDS_BYTES, stream);
    if (e != hipSuccess) fprintf(stderr, "cooperative launch failed: %s (grid %d)\n", hipGetErrorString(e), grid);
#else
    for (int ph = 0; ph < N_PHASES; ++ph) hipLaunchKernelGGL(mega, dim3(grid), dim3(NTHR), LDS_BYTES, stream, p, ph, ph + 1);
#endif
}
```

```cpp
#include <hip/hip_runtime.h>
#include <hip/hip_cooperative_groups.h>
#include <cstdint>
#include <cstdio>
#include <cmath>
namespace cg = cooperative_groups;

#ifndef PROBE_SEL
#define PROBE_SEL 0
#endif
#ifndef N_LAUNCH_MODE
#define N_LAUNCH_MODE 1
#endif

typedef unsigned short bf16_t;
typedef short bf16x8 __attribute__((ext_vector_type(8)));
typedef short s16x4 __attribute__((ext_vector_type(4)));
typedef float f32x4 __attribute__((ext_vector_type(4)));
typedef float f32x2 __attribute__((ext_vector_type(2)));
typedef float f32x16 __attribute__((ext_vector_type(16)));
typedef unsigned u32x2 __attribute__((ext_vector_type(2)));
typedef unsigned u32x4 __attribute__((ext_vector_type(4)));
typedef __bf16 bf2_t __attribute__((ext_vector_type(2)));
#define DI __device__ __forceinline__

constexpr int D = 1024, NB = 16, SEQ = 2048, CTX = 256, NLAT = NB * SEQ, NCTX = NB * CTX, NTOK = NLAT + NCTX;
constexpr int DFF = 2816, INC = 2304, KEYS = SEQ + CTX, DEPTH = 2, MODW = 9 * D;
constexpr int NTHR = 512;
constexpr int LDS_BYTES = 135168;
constexpr float EPS = 1e-6f;

DI unsigned pk2(float a, float b) { f32x2 v = {a, b}; bf2_t r = __builtin_convertvector(v, bf2_t); return __builtin_bit_cast(unsigned, r); }
DI float bf2f(bf16_t v) { return __uint_as_float(((unsigned)v) << 16); }
DI float bflo(unsigned v) { return __uint_as_float(v << 16); }
DI float bfhi(unsigned v) { return __uint_as_float(v & 0xffff0000u); }
DI bf16_t f2bf(float a) { return (bf16_t)(pk2(a, 0.f) & 0xffffu); }
DI float silu_f(float x) { return x * __builtin_amdgcn_rcpf(1.f + __expf(-x)); }
DI float sigmoid_f(float x) { return __builtin_amdgcn_rcpf(1.f + __expf(-x)); }
DI float gelu_f(float x) { float u = 1.5957691216057308f * (x + 0.044715f * x * x * x); return x * __builtin_amdgcn_rcpf(1.f + __expf(-u)); }
DI int TID() { int t = __builtin_amdgcn_workitem_id_x(); asm volatile("" : "+v"(t)); return t; }
DI void lds_barrier() { asm volatile("s_waitcnt lgkmcnt(0)" ::: "memory"); __builtin_amdgcn_s_barrier(); asm volatile("" ::: "memory"); }
DI float wave_sum(float v) {
#pragma unroll
    for (int o = 32; o >= 1; o >>= 1) v += __shfl_xor(v, o);
    return v;
}

struct Params {
    const float *x, *c, *ctx, *c_ctx, *w_ada, *b_ada, *g_norm, *w_ff1_in, *w_ff1_out, *w_ff2_in, *w_ff2_out, *w_in, *w_out, *g_q_a, *g_k_a, *lam_c,
        *g_sub_c, *g_v_b, *w_s_b, *b_s_b, *w_dw_d, *b_dw_d, *g_conv_d, *g_final;
    float* out;
    bf16_t *Wff1in, *Wff1out, *Wff2in, *Wff2out, *Win, *Wout, *Ws;
    float *mods, *ropeA, *ropeC, *hc;
    bf16_t *xn, *hid, *QA, *KA, *VtA, *QC, *KC, *VtC, *U, *VN, *Y, *cat;
    unsigned* bar;
    float* probe;
    unsigned* kmaxC;
    float* dctx;
    _Float16* h16;
};

DI void sincos_d(double x, double& s, double& c) {
    double k = rint(x * 0.15915494309189535);
    double r = fma(-k, 6.283185307179586, x);
    r = fma(-k, 2.4492935982947064e-16, r);
    double r2 = r * r, as = 1.0, ac = 1.0;
#pragma unroll
    for (int n = 14; n >= 1; --n) {
        as = 1.0 - r2 / (double)((2 * n) * (2 * n + 1)) * as;
        ac = 1.0 - r2 / (double)((2 * n - 1) * (2 * n)) * ac;
    }
    s = r * as; c = ac;
}

constexpr int T_FFIN = (D / 64) * (2 * DFF / 256), T_FFOUT = (DFF / 64) * (D / 256), T_WIN = (D / 64) * (INC / 256), T_WOUT = (D / 64) * (D / 256);
constexpr int T_LAYER = 2 * T_FFIN + 2 * T_FFOUT + T_WIN + T_WOUT;
constexpr int U_TR = DEPTH * T_LAYER, U_WS = 32, U_ADA = 288, U_ROPE = 192;
constexpr int U_P0 = U_TR + U_WS + U_ADA + U_ROPE;

DI void transpose_unit(const float* src, bf16_t* dst, int K, int N, int perm, int ti, float* tile) {
    const int tn = N / 256, kt = ti / tn, nt = ti % tn, k0 = kt * 64;
    const int t = TID();
    const int kk = t >> 4, c4 = (t & 15) * 4;
    f32x4 v[4][2];
#pragma unroll
    for (int sub = 0; sub < 4; ++sub) {
        const int n0 = nt * 256 + sub * 64;
        int sc0 = n0;
        if (perm == 1) { const int q = n0 >> 8, j = n0 & 255; sc0 = j < 128 ? q * 128 + j : DFF + q * 128 + (j - 128); }
        else if (perm == 2 && n0 >= 1792) { const int m = n0 - 1792, q = m >> 8, j = m & 255; sc0 = j < 128 ? 1792 + q * 128 + j : 2048 + q * 128 + (j - 128); }
#pragma unroll
        for (int i = 0; i < 2; ++i) v[sub][i] = *(const f32x4*)(src + (size_t)(k0 + kk + 32 * i) * N + sc0 + c4);
    }
#pragma unroll
    for (int sub = 0; sub < 4; ++sub)
#pragma unroll
        for (int i = 0; i < 2; ++i) {
            float* tp = tile + sub * 64 * 65 + (kk + 32 * i) * 65 + c4;
            tp[0] = v[sub][i][0]; tp[1] = v[sub][i][1]; tp[2] = v[sub][i][2]; tp[3] = v[sub][i][3];
        }
    __syncthreads();
    {
        const int n = t >> 3, k8 = (t & 7) * 8;
#pragma unroll
        for (int sub = 0; sub < 4; ++sub) {
            const float* tp = tile + sub * 64 * 65 + k8 * 65 + n;
            u32x4 o;
            o[0] = pk2(tp[0], tp[65]); o[1] = pk2(tp[2 * 65], tp[3 * 65]); o[2] = pk2(tp[4 * 65], tp[5 * 65]); o[3] = pk2(tp[6 * 65], tp[7 * 65]);
            *(u32x4*)(dst + (size_t)(nt * 256 + sub * 64 + n) * K + k0 + k8) = o;
        }
    }
    __syncthreads();
}

DI void phase_prologue(const Params& p, char* smem) {
    const int t = TID();
    if ((int)blockIdx.x < U_ADA) {
        float* s = (float*)smem;
        float* red = s + 17 * 1024;
        {
            float cv[34];
#pragma unroll
            for (int j = 0; j < 34; ++j) { const int i = t + j * NTHR, r = i >> 10, k = i & 1023; cv[j] = r < 16 ? p.c[r * D + k] : p.c_ctx[k]; }
#pragma unroll
            for (int j = 0; j < 34; ++j) s[t + j * NTHR] = silu_f(cv[j]);
        }
        __syncthreads();
        const int col = t & 63, ks = t >> 6;
        for (int uu = blockIdx.x; uu < U_ADA; uu += gridDim.x) {
            const int l = uu / 144, col0 = (uu % 144) * 64;
            float acc[17];
#pragma unroll
            for (int r = 0; r < 17; ++r) acc[r] = 0.f;
            const float* w = p.w_ada + (size_t)l * D * MODW + (size_t)(ks * 128) * MODW + col0 + col;
            float wv[16], wn[16];
#pragma unroll
            for (int k = 0; k < 16; ++k) wv[k] = w[(size_t)k * MODW];
            for (int k0 = 0; k0 < 128; k0 += 16) {
                if (k0 + 16 < 128) {
#pragma unroll
                    for (int k = 0; k < 16; ++k) wn[k] = w[(size_t)(k0 + 16 + k) * MODW];
                }
#pragma unroll
                for (int r = 0; r < 17; ++r)
#pragma unroll
                    for (int kq = 0; kq < 4; ++kq) {
                        const f32x4 sv = *(const f32x4*)(s + r * 1024 + ks * 128 + k0 + 4 * kq);
                        acc[r] += (sv[0] * wv[4 * kq] + sv[1] * wv[4 * kq + 1]) + (sv[2] * wv[4 * kq + 2] + sv[3] * wv[4 * kq + 3]);
                    }
#pragma unroll
                for (int k = 0; k < 16; ++k) wv[k] = wn[k];
            }
#pragma unroll
            for (int r = 0; r < 17; ++r) red[(ks * 17 + r) * 64 + col] = acc[r];
            __syncthreads();
            for (int i = t; i < 17 * 64; i += NTHR) {
                const int r = i >> 6, cc = i & 63; float sum = 0.f;
#pragma unroll
                for (int q = 0; q < 8; ++q) sum += red[(q * 17 + r) * 64 + cc];
                p.mods[((size_t)l * 17 + r) * MODW + col0 + cc] = sum + p.b_ada[(size_t)l * MODW + col0 + cc];
            }
            __syncthreads();
        }
    }
    if (blockIdx.x == gridDim.x - 1 && t < DEPTH * NB * 4 * 2) p.kmaxC[t] = 0u;
    for (int v = (int)gridDim.x - 1 - (int)blockIdx.x; v < U_WS + U_ROPE; v += gridDim.x) {
        if (v < U_WS) {
            const int e0 = v * 4096 + t * 8;
            f32x4 a = *(const f32x4*)(p.w_s_b + e0), b = *(const f32x4*)(p.w_s_b + e0 + 4);
            u32x4 o; o[0] = pk2(a[0], a[1]); o[1] = pk2(a[2], a[3]); o[2] = pk2(b[0], b[1]); o[3] = pk2(b[2], b[3]);
            *(u32x4*)(p.Ws + e0) = o;
        } else {
            const int e = (v - U_WS) * 512 + t;
            const int pos = e / 48, j = e % 48, row = pos >> 6, col = pos & 63;
            float ang; float* dst;
            if (j < 32) { const float inv = exp2f(-(float)(j & 15) * (13.287712379549449f / 16.f)); ang = (float)(j < 16 ? row : col) * inv; dst = p.ropeA + ((size_t)pos * 32 + j) * 2; }
            else { const int jj = j - 32; const float inv = exp2f(-(float)(jj & 7) * (13.287712379549449f / 8.f)); ang = (float)(jj < 8 ? row : col) * inv; dst = p.ropeC + ((size_t)pos * 16 + jj) * 2; }
            double sn, cs; sincos_d((double)ang, sn, cs);
            dst[0] = (float)cs; dst[1] = (float)sn;
        }
    }
    for (int u = blockIdx.x; u < U_TR; u += gridDim.x) {
        const int l = u / T_LAYER; int r = u % T_LAYER;
        const float* src; bf16_t* dst; int K, N, perm;
        if (r < T_FFIN) { src = p.w_ff1_in + (size_t)l * D * 2 * DFF; dst = p.Wff1in + (size_t)l * D * 2 * DFF; K = D; N = 2 * DFF; perm = 1; }
        else if ((r -= T_FFIN) < T_FFOUT) { src = p.w_ff1_out + (size_t)l * D * DFF; dst = p.Wff1out + (size_t)l * D * DFF; K = DFF; N = D; perm = 0; }
        else if ((r -= T_FFOUT) < T_FFIN) { src = p.w_ff2_in + (size_t)l * D * 2 * DFF; dst = p.Wff2in + (size_t)l * D * 2 * DFF; K = D; N = 2 * DFF; perm = 1; }
        else if ((r -= T_FFIN) < T_FFOUT) { src = p.w_ff2_out + (size_t)l * D * DFF; dst = p.Wff2out + (size_t)l * D * DFF; K = DFF; N = D; perm = 0; }
        else if ((r -= T_FFOUT) < T_WIN) { src = p.w_in + (size_t)l * D * INC; dst = p.Win + (size_t)l * D * INC; K = D; N = INC; perm = 2; }
        else { r -= T_WIN; src = p.w_out + (size_t)l * D * D; dst = p.Wout + (size_t)l * D * D; K = D; N = D; perm = 0; }
        transpose_unit(src, dst, K, N, perm, r, (float*)smem);
    }
}

typedef _Float16 h16x4 __attribute__((ext_vector_type(4)));
template <bool FINAL>
DI void phase_norm(const Params& p, bool first, const float* g, const float* mods_l, int mi, int nrows) {
    constexpr int RW = 8;
    const int wid = TID() >> 6, lane = TID() & 63;
    for (int u = blockIdx.x; u < nrows / (8 * RW); u += gridDim.x) {
        const int row0 = (u * 8 + wid) * RW;
        const bool islat = row0 < NLAT;
        const int mb = islat ? row0 / SEQ : 16;
        f32x4 v[RW][4];
        if (first) {
            const float* src = islat ? p.x + (size_t)row0 * D : p.ctx + (size_t)(row0 - NLAT) * D;
#pragma unroll
            for (int q = 0; q < RW; ++q)
#pragma unroll
                for (int i = 0; i < 4; ++i) v[q][i] = *(const f32x4*)(src + (size_t)q * D + i * 256 + lane * 4);
        } else {
            h16x4 hv[RW][4];
#pragma unroll
            for (int q = 0; q < RW; ++q)
#pragma unroll
                for (int i = 0; i < 4; ++i) hv[q][i] = *(const h16x4*)(p.h16 + (size_t)(row0 + q) * D + i * 256 + lane * 4);
            if (islat) {
#pragma unroll
                for (int q = 0; q < RW; ++q)
#pragma unroll
                    for (int i = 0; i < 4; ++i) v[q][i] = __builtin_convertvector(hv[q][i], f32x4);
            } else {
#pragma unroll
                for (int q = 0; q < RW; ++q)
#pragma unroll
                    for (int i = 0; i < 4; ++i) {
                        const float* pq = p.dctx + (size_t)(row0 + q - NLAT) * D + i * 256 + lane * 4;
                        v[q][i] = __builtin_convertvector(hv[q][i], f32x4) + ((*(const f32x4*)pq + *(const f32x4*)(pq + (size_t)NCTX * D)) + (*(const f32x4*)(pq + (size_t)2 * NCTX * D) + *(const f32x4*)(pq + (size_t)3 * NCTX * D)));
                    }
            }
        }
        float rstd[RW];
#pragma unroll
        for (int q = 0; q < RW; ++q) {
            float ss = 0.f;
#pragma unroll
            for (int i = 0; i < 4; ++i) ss += v[q][i][0] * v[q][i][0] + v[q][i][1] * v[q][i][1] + v[q][i][2] * v[q][i][2] + v[q][i][3] * v[q][i][3];
            rstd[q] = rsqrtf(wave_sum(ss) * (1.f / D) + EPS);
        }
        if (FINAL) {
#pragma unroll
            for (int i = 0; i < 4; ++i) { const int col = i * 256 + lane * 4; const f32x4 gv = *(const f32x4*)(g + col);
#pragma unroll
                for (int q = 0; q < RW; ++q) { f32x4 o = v[q][i] * rstd[q] * gv;
#if PROBE_SEL
                    { const float e = p.probe[0]; o[0] *= 1.f + e; o[1] *= 1.f - e; o[2] *= 1.f + e; o[3] *= 1.f - e; }
#endif
                    *(f32x4*)(p.out + (size_t)(row0 + q) * D + col) = o; } }
        } else {
            if (first || !islat) {
#pragma unroll
                for (int q = 0; q < RW; ++q)
#pragma unroll
                    for (int i = 0; i < 4; ++i) *(h16x4*)(p.h16 + (size_t)(row0 + q) * D + i * 256 + lane * 4) = __builtin_convertvector(v[q][i], h16x4);
            }
            const float* sh = mods_l + (size_t)mb * MODW + mi * D; const float* scl = sh + D;
#pragma unroll
            for (int i = 0; i < 4; ++i) {
                const int col = i * 256 + lane * 4;
                const f32x4 gv = *(const f32x4*)(g + col), sv = *(const f32x4*)(scl + col), bv = *(const f32x4*)(sh + col);
                const f32x4 gs = gv * (1.f + sv);
#pragma unroll
                for (int q = 0; q < RW; ++q) {
                    const f32x4 o = v[q][i] * rstd[q] * gs + bv;
                    u32x2 w; w[0] = pk2(o[0], o[1]); w[1] = pk2(o[2], o[3]);
                    *(u32x2*)(p.xn + (size_t)(row0 + q) * D + col) = w;
                }
            }
        }
    }
}

constexpr int BM = 256, BK = 64, HALF = 128, HT = HALF * BK, NXCD = 8, WGM = 8;
DI int lds_byte(int r, int c) { const int st = (r >> 4) * 2 + (c >> 5), rr = r & 15, cc = c & 31, ob = rr * 64 + cc * 2; return st * 1024 + (ob ^ (((ob >> 9) & 1) << 5)); }
DI void stage_rc(int b, int& R, int& C) { const int st = b / 1024, sb = b % 1024, swz = sb ^ (((sb >> 9) & 1) << 5); R = (st >> 1) * 16 + swz / 64; C = (st & 1) * 32 + (swz % 64) / 2; }

#define LAS __attribute__((address_space(3)))
constexpr int HTB = HALF * BK * 2;
DI void gemm_tile(const bf16_t* A, const bf16_t* Bt, int K  , int kt0, int nt  , int brow, int bcol, f32x4 (&acc)[2][2][4][2], LAS unsigned char* lds) {
    const int tid = TID(), wid = __builtin_amdgcn_readfirstlane(tid >> 6), lane = tid & 63, wr = wid >> 2, wc = wid & 3, fr = lane & 15, fq = lane >> 4;
    unsigned voff[2];
#pragma unroll
    for (int i = 0; i < 2; ++i) { int R, C; stage_rc(tid * 16 + i * 8192, R, C); voff[i] = (unsigned)(R * K + C) * 2u; }
    const size_t kstep = (size_t)(BK * 2), hstep = (size_t)HALF * K * 2;
    const unsigned ldsw = (unsigned)wid * 1024u;
    const int aoff = lds_byte(wr * 64 + fr, fq * 8), boff = lds_byte(wc * 32 + fr, fq * 8);
#define SA(b, h) (((b) * 2 + (h)) * HTB)
#define SB(b, h) ((4 + (b) * 2 + (h)) * HTB)
#define STAGE(bufoff, gbase) do { _Pragma("unroll") for (int _i = 0; _i < 2; ++_i) \
        __builtin_amdgcn_global_load_lds((const unsigned*)((const char*)(gbase) + voff[_i]), (LAS unsigned*)(lds + (bufoff) + ldsw + _i * 8192), 16, 0, 0); } while (0)
#define LDA(dst, b, h) do { _Pragma("unroll") for (int m = 0; m < 4; ++m) _Pragma("unroll") for (int k = 0; k < 2; ++k) dst[m][k] = *(const LAS bf16x8*)(lds + SA(b, h) + aoff + m * 2048 + k * 1024); } while (0)
#define LDB(dst, b, h) do { _Pragma("unroll") for (int n = 0; n < 2; ++n) _Pragma("unroll") for (int k = 0; k < 2; ++k) dst[n][k] = *(const LAS bf16x8*)(lds + SB(b, h) + boff + n * 2048 + k * 1024); } while (0)
#define MMA(ai, bj, At_, Bt_) do { __builtin_amdgcn_s_setprio(1); _Pragma("unroll") for (int m = 0; m < 4; ++m) _Pragma("unroll") for (int n = 0; n < 2; ++n) _Pragma("unroll") for (int k = 0; k < 2; ++k) \
        acc[ai][bj][m][n] = __builtin_amdgcn_mfma_f32_16x16x32_bf16(Bt_[n][k], At_[m][k], acc[ai][bj][m][n], 0, 0, 0); __builtin_amdgcn_s_setprio(0); } while (0)
#define WAIT_V(n) asm volatile("s_waitcnt vmcnt(" #n ")" ::: "memory")
#define WAIT_L(n) asm volatile("s_waitcnt lgkmcnt(" #n ")" ::: "memory")
#define BAR __builtin_amdgcn_s_barrier()
#define SCHED __builtin_amdgcn_sched_barrier(0)
#pragma unroll
    for (int a = 0; a < 2; ++a)
#pragma unroll
        for (int b = 0; b < 2; ++b)
#pragma unroll
            for (int m = 0; m < 4; ++m)
#pragma unroll
                for (int n = 0; n < 2; ++n) acc[a][b][m][n] = (f32x4){0.f, 0.f, 0.f, 0.f};
    bf16x8 At[4][2], B0[2][2], B1[2][2];
    const char* cA = (const char*)A + (size_t)brow * K * 2 + (size_t)kt0 * BK * 2; const char* cB = (const char*)Bt + (size_t)bcol * K * 2 + (size_t)kt0 * BK * 2;
    STAGE(SB(0, 0), cB); STAGE(SB(0, 1), cB + hstep); STAGE(SA(0, 0), cA); STAGE(SA(0, 1), cA + hstep);
    if (wr == 1) BAR;
    WAIT_V(2); BAR;
    STAGE(SB(1, 0), cB + kstep); STAGE(SA(1, 0), cA + kstep); STAGE(SB(1, 1), cB + hstep + kstep);
    WAIT_V(6); BAR;
    for (int t = 0; t < nt; t += 2) {
        const bool lastit = (t == nt - 2);
        const char* a1 = cA + (size_t)(t + 1) * kstep;
        const char* a2 = lastit ? cA : cA + (size_t)(t + 2) * kstep; const char* b2 = lastit ? cB : cB + (size_t)(t + 2) * kstep;
        const char* a3 = a2 + kstep; const char* b3 = b2 + kstep;
        LDB(B0, 0, 0); LDB(B1, 0, 1); SCHED; LDA(At, 0, 0); STAGE(SA(1, 1), a1 + hstep);
        WAIT_V(8); WAIT_L(0); BAR; MMA(0, 0, At, B0); MMA(0, 1, At, B1); BAR; SCHED;
        LDA(At, 0, 1); STAGE(SB(0, 0), b2); STAGE(SB(0, 1), b2 + hstep); STAGE(SA(0, 0), a2);
        WAIT_V(8); WAIT_L(0); BAR; MMA(1, 0, At, B0); MMA(1, 1, At, B1); BAR; SCHED;
        LDB(B0, 1, 0); LDB(B1, 1, 1); SCHED; LDA(At, 1, 0); STAGE(SA(0, 1), a2 + hstep);
        WAIT_V(8); WAIT_L(0); BAR; MMA(0, 0, At, B0); MMA(0, 1, At, B1); BAR; SCHED;
        LDA(At, 1, 1); STAGE(SB(1, 0), b3); STAGE(SB(1, 1), b3 + hstep); STAGE(SA(1, 0), a3);
        WAIT_V(8); WAIT_L(0); BAR; MMA(1, 0, At, B0); MMA(1, 1, At, B1); BAR; SCHED;
    }
    WAIT_V(0);
    if (wr == 0) BAR;
    BAR;
}

DI void tile_order(int L, int nM, int nN, int& pm, int& pn) {
    const int nwg = nM * nN; int wgid = L;
    { const int q = nwg / NXCD, r = nwg % NXCD, xcd = wgid % NXCD, off = wgid / NXCD; wgid = (xcd < r ? xcd * (q + 1) : r * (q + 1) + (xcd - r) * q) + off; }
    const int nig = WGM * nN, gid = wgid / nig, fm = gid * WGM, gsz = (nM - fm) < WGM ? (nM - fm) : WGM;
    pm = fm + ((wgid % nig) % gsz); pn = (wgid % nig) / gsz;
}

struct EpiSwiglu {
    bf16_t* hid;
    DI void operator()(f32x4 (&acc)[2][2][4][2], int pm, int pn, int sl, char* smem) const {
        const int wid = TID() >> 6, lane = TID() & 63, wr = wid >> 2, wc = wid & 3, fr = lane & 15, fq = lane >> 4;
#pragma unroll
        for (int ai = 0; ai < 2; ++ai)
#pragma unroll
            for (int m = 0; m < 4; ++m) {
                const int row = pm * BM + ai * HALF + wr * 64 + m * 16 + fr;
#pragma unroll
                for (int n = 0; n < 2; ++n) {
                    const f32x4 a = acc[ai][0][m][n], b = acc[ai][1][m][n];
                    u32x2 w; w[0] = pk2(silu_f(a[0]) * b[0], silu_f(a[1]) * b[1]); w[1] = pk2(silu_f(a[2]) * b[2], silu_f(a[3]) * b[3]);
                    *(u32x2*)(hid + (size_t)row * DFF + pn * 128 + wc * 32 + n * 16 + fq * 4) = w;
                }
            }
    }
};
struct EpiResid {
    _Float16* h16; const float* gate; float* dctx; float gs;
    DI void operator()(f32x4 (&acc)[2][2][4][2], int pm, int pn, int sl, char* smem) const {
        const int wid = TID() >> 6, lane = TID() & 63, wr = wid >> 2, wc = wid & 3, fr = lane & 15, fq = lane >> 4;
        const int row0 = pm * BM; const bool islat = row0 < NLAT;
        _Float16* out = h16 + (size_t)(row0 + wr * 64 + fr) * D + pn * BM + wc * 32 + fq * 4;
        const float* gt = gate + (size_t)(islat ? row0 / SEQ : 16) * MODW + pn * BM + wc * 32 + fq * 4;
        f32x4 gv[2][2];
#pragma unroll
        for (int bj = 0; bj < 2; ++bj)
#pragma unroll
            for (int n = 0; n < 2; ++n) gv[bj][n] = *(const f32x4*)(gt + bj * HALF + n * 16) * gs;
        if (sl >= 0) {
            float* po = dctx + ((size_t)sl * NCTX + (row0 - NLAT) + wr * 64 + fr) * D + pn * BM + wc * 32 + fq * 4;
#pragma unroll
            for (int ai = 0; ai < 2; ++ai)
#pragma unroll
                for (int m = 0; m < 4; ++m)
#pragma unroll
                    for (int bj = 0; bj < 2; ++bj)
#pragma unroll
                        for (int n = 0; n < 2; ++n) *(f32x4*)(po + (size_t)(ai * HALF + m * 16) * D + bj * HALF + n * 16) = gv[bj][n] * acc[ai][bj][m][n];
            return;
        }
        h16x4 hv[2][4][2][2];
#pragma unroll
        for (int ai = 0; ai < 2; ++ai)
#pragma unroll
            for (int m = 0; m < 4; ++m)
#pragma unroll
                for (int bj = 0; bj < 2; ++bj)
#pragma unroll
                    for (int n = 0; n < 2; ++n) hv[ai][m][bj][n] = *(const h16x4*)(out + (size_t)(ai * HALF + m * 16) * D + bj * HALF + n * 16);
#pragma unroll
        for (int ai = 0; ai < 2; ++ai)
#pragma unroll
            for (int m = 0; m < 4; ++m)
#pragma unroll
                for (int bj = 0; bj < 2; ++bj)
#pragma unroll
                    for (int n = 0; n < 2; ++n) {
                        const f32x4 v = __builtin_convertvector(hv[ai][m][bj][n], f32x4) + gv[bj][n] * acc[ai][bj][m][n];
                        *(h16x4*)(out + (size_t)(ai * HALF + m * 16) * D + bj * HALF + n * 16) = __builtin_convertvector(v, h16x4);
                    }
    }
};
constexpr float SC_A = 0.125f * 1.4426950408889634f, SC_C = 0.17677669529663687f * 1.4426950408889634f;
constexpr int TS = 260;
struct EpiProj {
    const Params* pp; int l;
    DI void operator()(f32x4 (&acc)[2][2][4][2], int pm, int pn, int sl, char* smem) const {
        const Params& p = *pp;
        LAS float* T = (LAS float*)smem;
        const int tid = TID(), wid = tid >> 6, lane = tid & 63, wr = wid >> 2, wc = wid & 3, fr = lane & 15, fq = lane >> 4;
#pragma unroll
        for (int ai = 0; ai < 2; ++ai) {
            lds_barrier();
#pragma unroll
            for (int bj = 0; bj < 2; ++bj)
#pragma unroll
                for (int m = 0; m < 4; ++m)
#pragma unroll
                    for (int n = 0; n < 2; ++n) *(LAS f32x4*)(T + (wr * 64 + m * 16 + fr) * TS + bj * HALF + wc * 32 + n * 16 + fq * 4) = acc[ai][bj][m][n];
            lds_barrier();
            const int rl = tid & 127, seg = tid >> 7, grow = pm * BM + ai * HALF + rl;
            const bool islat = grow < NLAT;
            const int b = islat ? grow / SEQ : (grow - NLAT) / CTX;
            const int pos = islat ? grow % SEQ : SEQ + (grow - NLAT) % CTX;
            const LAS float* xr = T + rl * TS + seg * 64;
            if (pn >= 7 && seg >= 2) continue;
#define LD8(dstv, off) { const f32x4 _a = *(const LAS f32x4*)(xr + (off)), _b = *(const LAS f32x4*)(xr + (off) + 4); dstv[0] = _a[0]; dstv[1] = _a[1]; dstv[2] = _a[2]; dstv[3] = _a[3]; dstv[4] = _b[0]; dstv[5] = _b[1]; dstv[6] = _b[2]; dstv[7] = _b[3]; }
            if (pn == 0 || (pn == 2 && seg < 2)) {
                const float* g = (pn == 0 ? p.g_q_a : p.g_k_a) + l * 64;
                bf16_t* dst = pn == 0 ? p.QA + ((size_t)(b * 4 + seg) * KEYS + pos) * 64 : p.KA + ((size_t)(b * 2 + seg) * KEYS + pos) * 64;
                float ss = 0.f;
#pragma unroll
                for (int i = 0; i < 16; ++i) { const f32x4 v = *(const LAS f32x4*)(xr + 4 * i); ss += v[0] * v[0] + v[1] * v[1] + v[2] * v[2] + v[3] * v[3]; }
                const float rstd = rsqrtf(ss * (1.f / 64.f) + EPS);
                const float* rp = p.ropeA + (size_t)(islat ? pos : 0) * 64;
#pragma unroll
                for (int i0 = 0; i0 < 32; i0 += 8) {
                    float xa[8], xb[8], o1[8], o2[8];
                    LD8(xa, i0); LD8(xb, i0 + 32);
#pragma unroll
                    for (int i = 0; i < 8; i += 2) {
                        f32x4 cssn = {1.f, 0.f, 1.f, 0.f};
                        if (islat) cssn = *(const f32x4*)(rp + (i0 + i) * 2);
#pragma unroll
                        for (int e = 0; e < 2; ++e) {
                            const float a = xa[i + e] * rstd * g[i0 + i + e], bb = xb[i + e] * rstd * g[i0 + i + e + 32];
                            o1[i + e] = a * cssn[2 * e] - bb * cssn[2 * e + 1]; o2[i + e] = a * cssn[2 * e + 1] + bb * cssn[2 * e];
                        }
                    }
                    const float qs = pn == 0 ? SC_A : 1.f;
                    u32x4 w1, w2;
#pragma unroll
                    for (int i = 0; i < 4; ++i) { w1[i] = pk2(o1[2 * i] * qs, o1[2 * i + 1] * qs); w2[i] = pk2(o2[2 * i] * qs, o2[2 * i + 1] * qs); }
                    *(u32x4*)(dst + i0) = w1; *(u32x4*)(dst + 32 + i0) = w2;
                }
            } else if (pn == 1 || pn == 3) {
                bf16_t* base = (pn == 1 ? p.QC : p.KC);
                const float* rp = p.ropeC + (size_t)(islat ? pos : 0) * 32;
#pragma unroll
                for (int mp = 0; mp < 2; ++mp) {
                    bf16_t* dst = base + ((size_t)(b * 4 + seg) * KEYS + pos) * 64 + mp * 32;
                    float k2 = 0.f;
#pragma unroll
                    for (int i0 = 0; i0 < 16; i0 += 8) {
                        float xa[8], xb[8], o1[8], o2[8];
                        LD8(xa, mp * 32 + i0); LD8(xb, mp * 32 + i0 + 16);
#pragma unroll
                        for (int i = 0; i < 8; ++i) k2 += xa[i] * xa[i] + xb[i] * xb[i];
#pragma unroll
                        for (int i = 0; i < 8; i += 2) {
                            f32x4 cssn = {1.f, 0.f, 1.f, 0.f};
                            if (islat) cssn = *(const f32x4*)(rp + (i0 + i) * 2);
#pragma unroll
                            for (int e = 0; e < 2; ++e) {
                                const float a = xa[i + e], bb = xb[i + e];
                                o1[i + e] = a * cssn[2 * e] - bb * cssn[2 * e + 1]; o2[i + e] = a * cssn[2 * e + 1] + bb * cssn[2 * e];
                            }
                        }
                        const float qs = pn == 1 ? SC_C : 1.f;
                        u32x4 w1, w2;
#pragma unroll
                        for (int i = 0; i < 4; ++i) { w1[i] = pk2(o1[2 * i] * qs, o1[2 * i + 1] * qs); w2[i] = pk2(o2[2 * i] * qs, o2[2 * i + 1] * qs); }
                        *(u32x4*)(dst + i0) = w1; *(u32x4*)(dst + 16 + i0) = w2;
                    }
                    if (pn == 3) {
#pragma unroll
                        for (int o = 32; o >= 1; o >>= 1) k2 = fmaxf(k2, __shfl_xor(k2, o));
                        if (lane == 0) atomicMax(p.kmaxC + (size_t)l * NB * 8 + (b * 4 + seg) * 2 + mp, __float_as_uint(k2));
                    }
                }
            } else if (pn == 2 || pn == 4) {
                bf16_t* dst = pn == 2 ? p.VtA + ((size_t)(b * 2 + (seg - 2)) * 64) * KEYS + pos : p.VtC + ((size_t)(b * 4 + seg) * 64) * KEYS + pos;
#pragma unroll
                for (int d0 = 0; d0 < 64; d0 += 8) {
                    float xa[8]; LD8(xa, d0);
#pragma unroll
                    for (int d = 0; d < 8; ++d) dst[(size_t)(d0 + d) * KEYS] = f2bf(xa[d]);
                }
            } else if (pn == 5) {
                bf16_t* dst = p.U + (size_t)grow * 256 + seg * 64;
#pragma unroll
                for (int i0 = 0; i0 < 64; i0 += 8) {
                    float xa[8]; LD8(xa, i0);
                    u32x4 w;
#pragma unroll
                    for (int i = 0; i < 4; ++i) w[i] = pk2(gelu_f(xa[2 * i]), gelu_f(xa[2 * i + 1]));
                    *(u32x4*)(dst + i0) = w;
                }
            } else if (pn == 6) {
                float ss = 0.f;
#pragma unroll
                for (int i0 = 0; i0 < 64; i0 += 8) {
                    float xa[8]; LD8(xa, i0);
#pragma unroll
                    for (int i = 0; i < 8; ++i) { const float gv = gelu_f(xa[i]); ss += gv * gv; }
                }
                T[rl * TS + 256 + seg] = ss;
                lds_barrier();
                const f32x4 pt = *(const LAS f32x4*)(T + rl * TS + 256);
                const float rstd = rsqrtf(((pt[0] + pt[1]) + (pt[2] + pt[3])) * (1.f / 256.f) + EPS);
                const float* g = p.g_v_b + l * 256 + seg * 64;
                bf16_t* dst = p.VN + (size_t)grow * 256 + seg * 64;
#pragma unroll
                for (int i0 = 0; i0 < 64; i0 += 8) {
                    float xa[8]; LD8(xa, i0);
                    u32x4 w;
#pragma unroll
                    for (int i = 0; i < 4; ++i) w[i] = pk2(gelu_f(xa[2 * i]) * rstd * g[i0 + 2 * i], gelu_f(xa[2 * i + 1]) * rstd * g[i0 + 2 * i + 1]);
                    *(u32x4*)(dst + i0) = w;
                }
            } else {
                bf16_t* dst = p.Y + (size_t)grow * 256 + (pn - 7) * 128 + seg * 64;
#pragma unroll
                for (int i0 = 0; i0 < 64; i0 += 8) {
                    float xa[8], ga[8]; LD8(xa, i0); LD8(ga, 128 + i0);
                    u32x4 w;
#pragma unroll
                    for (int i = 0; i < 4; ++i) w[i] = pk2(xa[2 * i] * sigmoid_f(ga[2 * i]), xa[2 * i + 1] * sigmoid_f(ga[2 * i + 1]));
                    *(u32x4*)(dst + i0) = w;
                }
            }
#undef LD8
        }
        lds_barrier();
    }
};

struct UnitList {
    int nM, nN, nwg, nsp, ntk, split, kvonly;
    DI void init(int M, int N, int K, bool splitctx, bool kvonlyctx) {
        nN = N / BM; ntk = K / BK; split = splitctx; kvonly = kvonlyctx;
        nM = ((splitctx || kvonlyctx) ? NLAT : M) / BM; nwg = nM * nN; nsp = splitctx ? (NCTX / BM) * nN * 4 : (kvonlyctx ? (NCTX / BM) * 3 : 0);
    }
    DI bool get(int L, int& pm, int& pn, int& sl, int& kt0, int& nt) const {
        if (L >= nwg + nsp) return false;
        sl = -1; kt0 = 0; nt = ntk;
        if (L < nwg) tile_order(L, nM, nN, pm, pn);
        else if (kvonly) { const int c = L - nwg; pm = NLAT / BM + c / 3; pn = 2 + c % 3; }
        else {
            const int c = L - nwg, tile = c >> 2; sl = c & 3; pm = NLAT / BM + tile / nN; pn = tile % nN;
            const int q = ntk / 8 * 2, rem2 = (ntk - 4 * q) / 2;
            kt0 = sl * q + 2 * (sl < rem2 ? sl : rem2); nt = q + (sl < rem2 ? 2 : 0);
        }
        return true;
    }
};

template <class Epi>
DI void phase_gemm(const bf16_t* A, const bf16_t* Bt, int M, int N, int K, const Epi& epi, char* smem, bool splitctx = false, bool kvonlyctx = false) {
    UnitList ul; ul.init(M, N, K, splitctx, kvonlyctx);
    for (int L = blockIdx.x;; L += gridDim.x) {
        int pm, pn, sl, kt0, nt;
        if (!ul.get(L, pm, pn, sl, kt0, nt)) break;
        f32x4 acc[2][2][4][2];
        gemm_tile(A, Bt, K, kt0, nt, pm * BM, pn * BM, acc, (LAS unsigned char*)smem);
        epi(acc, pm, pn, sl, smem);
    }
}

template <class Epi>
DI void phase_gemm_stream(const bf16_t* A, const bf16_t* Bt, int M, int N, int K, const Epi& epi, char* smem, bool splitctx = false) {
    UnitList ul; ul.init(M, N, K, splitctx, false);
    LAS unsigned char* lds = (LAS unsigned char*)smem;
    const int tid = TID(), wid = __builtin_amdgcn_readfirstlane(tid >> 6), lane = tid & 63, wr = wid >> 2, wc = wid & 3, fr = lane & 15, fq = lane >> 4;
    unsigned voff[2];
#pragma unroll
    for (int i = 0; i < 2; ++i) { int R, C; stage_rc(tid * 16 + i * 8192, R, C); voff[i] = (unsigned)(R * K + C) * 2u; }
    const size_t kstep = (size_t)(BK * 2), hstep = (size_t)HALF * K * 2, tstep = 2 * hstep;
    const unsigned ldsw = (unsigned)wid * 1024u;
    const int aoff = lds_byte(wr * 64 + fr, fq * 8), boff = lds_byte(wc * 32 + fr, fq * 8);
    int L = blockIdx.x, pm, pn, sl, kt0, nt;
    if (!ul.get(L, pm, pn, sl, kt0, nt)) return;
    f32x4 acc[2][2][4][2];
#pragma unroll
    for (int a = 0; a < 2; ++a)
#pragma unroll
        for (int b = 0; b < 2; ++b)
#pragma unroll
            for (int m = 0; m < 4; ++m)
#pragma unroll
                for (int n = 0; n < 2; ++n) acc[a][b][m][n] = (f32x4){0.f, 0.f, 0.f, 0.f};
    bf16x8 At[4][2], B0[2][2], B1[2][2];
    const char* cA = (const char*)A + (size_t)pm * tstep + (size_t)kt0 * kstep; const char* cB = (const char*)Bt + (size_t)pn * tstep + (size_t)kt0 * kstep;
    STAGE(SB(0, 0), cB); STAGE(SB(0, 1), cB + hstep); STAGE(SA(0, 0), cA); STAGE(SA(0, 1), cA + hstep);
    if (wr == 1) BAR;
    WAIT_V(2); BAR;
    STAGE(SB(1, 0), cB + kstep); STAGE(SA(1, 0), cA + kstep); STAGE(SB(1, 1), cB + hstep + kstep);
    WAIT_V(6); BAR;
    for (;;) {
        int npm, npn, nsl, nkt0, nnt;
        const bool has_next = ul.get(L + gridDim.x, npm, npn, nsl, nkt0, nnt);
        const char* nA = has_next ? (const char*)A + (size_t)npm * tstep + (size_t)nkt0 * kstep : cA; const char* nB = has_next ? (const char*)Bt + (size_t)npn * tstep + (size_t)nkt0 * kstep : cB;
        for (int t = 0; t < nt; t += 2) {
            const bool lastit = (t == nt - 2);
            const char* a1 = cA + (size_t)(t + 1) * kstep;
            const char* a2 = lastit ? nA : cA + (size_t)(t + 2) * kstep; const char* b2 = lastit ? nB : cB + (size_t)(t + 2) * kstep;
            const char* a3 = a2 + kstep; const char* b3 = b2 + kstep;
            LDB(B0, 0, 0); LDB(B1, 0, 1); SCHED; LDA(At, 0, 0); STAGE(SA(1, 1), a1 + hstep);
            WAIT_V(8); WAIT_L(0); BAR; MMA(0, 0, At, B0); MMA(0, 1, At, B1); BAR; SCHED;
            LDA(At, 0, 1); STAGE(SB(0, 0), b2); STAGE(SB(0, 1), b2 + hstep); STAGE(SA(0, 0), a2);
            WAIT_V(8); WAIT_L(0); BAR; MMA(1, 0, At, B0); MMA(1, 1, At, B1); BAR; SCHED;
            LDB(B0, 1, 0); LDB(B1, 1, 1); SCHED; LDA(At, 1, 0); STAGE(SA(0, 1), a2 + hstep);
            WAIT_V(8); WAIT_L(0); BAR; MMA(0, 0, At, B0); MMA(0, 1, At, B1); BAR; SCHED;
            LDA(At, 1, 1); STAGE(SB(1, 0), b3); STAGE(SB(1, 1), b3 + hstep); STAGE(SA(1, 0), a3);
            WAIT_V(8); WAIT_L(0); BAR; MMA(1, 0, At, B0); MMA(1, 1, At, B1); BAR; SCHED;
        }
        if (wr == 0) BAR;
        epi(acc, pm, pn, sl, smem);
        if (!has_next) break;
#pragma unroll
        for (int a = 0; a < 2; ++a)
#pragma unroll
            for (int b = 0; b < 2; ++b)
#pragma unroll
                for (int m = 0; m < 4; ++m)
#pragma unroll
                    for (int n = 0; n < 2; ++n) acc[a][b][m][n] = (f32x4){0.f, 0.f, 0.f, 0.f};
        L += gridDim.x; pm = npm; pn = npn; sl = nsl; kt0 = nkt0; nt = nnt; cA = nA; cB = nB;
        if (wr == 1) BAR;
    }
    WAIT_V(0);
    BAR;
}

constexpr int VROW = 144;
template <bool ISC, bool FIXM>
DI void attn2_core(const bf16_t* Q0, const bf16_t* Q1, const bf16_t* Kg, const bf16_t* Vt, int qpos0, int key_lo, int nkt, float sc, float mfix0, float mfix1, f32x16 (&O)[2][2], char* smem) {
    constexpr int KROW = 144, KBUF = 64 * KROW, VBUF = 64 * VROW, NSLOT = 4, NQ = ISC ? 1 : 2;
    LAS char* lds = (LAS char*)smem;
    const int tid = TID(), lane = tid & 63, wid = tid >> 6, r = lane & 31, h = lane >> 5;
    bf16x8 qf[NQ][4];
#pragma unroll
    for (int c = 0; c < NQ; ++c)
#pragma unroll
        for (int ks = 0; ks < 4; ++ks) qf[c][ks] = *(const bf16x8*)((c == 0 ? Q0 : Q1) + (size_t)(qpos0 + wid * 32 + r) * 64 + ks * 16 + 8 * h);
#pragma unroll
    for (int c = 0; c < 2; ++c)
#pragma unroll
        for (int i = 0; i < 16; ++i) { O[c][0][i] = 0.f; O[c][1][i] = 0.f; }
    float m_run[2] = {FIXM ? mfix0 : -1e30f, FIXM ? mfix1 : -1e30f}, l_run[2] = {0.f, 0.f};
    const int kkey = tid >> 3, kch = tid & 7;
    const int kst = kkey * KROW + kch * 16, vst = NSLOT * KBUF + kkey * VROW + kch * 16;
    const int krd = r * KROW + 16 * h, vrd = NSLOT * KBUF + r * VROW + 8 * h;
    const bf16_t* kg = Kg + (size_t)(key_lo + kkey) * 64 + kch * 8;
    const bf16_t* vg = Vt + (size_t)kkey * KEYS + key_lo + kch * 8;
    u32x4 kreg, vreg;
    bf16x8 kf[4]; u32x2 vf[2][2][2];
    auto gload = [&](int t) { kreg = *(const u32x4*)(kg + (size_t)t * 64 * 64); vreg = *(const u32x4*)(vg + t * 64); };
    auto lstore = [&](int slot) { *(LAS u32x4*)(lds + slot * KBUF + kst) = kreg; *(LAS u32x4*)(lds + slot * VBUF + vst) = vreg; };
    auto ldk = [&](int slot, int kk) {
        const LAS char* kb = lds + slot * KBUF + krd + kk * 32 * KROW;
#pragma unroll
        for (int ks = 0; ks < 4; ++ks) kf[ks] = *(const LAS bf16x8*)(kb + ks * 32);
    };
    auto ldv = [&](int slot, int kk) {
        const LAS char* vb = lds + slot * VBUF + vrd + kk * 64;
#pragma unroll
        for (int st = 0; st < 2; ++st)
#pragma unroll
            for (int dt = 0; dt < 2; ++dt) { const LAS char* vp = vb + dt * 32 * VROW + st * 32; vf[st][dt][0] = *(const LAS u32x2*)vp; vf[st][dt][1] = *(const LAS u32x2*)(vp + 16); }
    };
#define SOFT_PV(c) do { \
        if (!FIXM) { \
        float mx = s##c[0]; \
        _Pragma("unroll") for (int i = 1; i < 16; ++i) mx = __ocml_fmax_f32(mx, s##c[i]); \
        mx = __ocml_fmax_f32(mx, __shfl_xor(mx, 32)); \
        const float m_new = __ocml_fmax_f32(m_run[c], mx); \
        if (__builtin_amdgcn_ballot_w64(m_new > m_run[c]) != 0ull) { \
            const float alpha = __builtin_amdgcn_exp2f(m_run[c] - m_new); \
            m_run[c] = m_new; l_run[c] *= alpha; \
            _Pragma("unroll") for (int i = 0; i < 16; ++i) { O[c][0][i] *= alpha; O[c][1][i] *= alpha; } \
        } } \
        float ps = 0.f; \
        _Pragma("unroll") for (int i = 0; i < 16; ++i) { s##c[i] = __builtin_amdgcn_exp2f(FIXM ? s##c[i] : s##c[i] - m_run[c]); ps += s##c[i]; } \
        l_run[c] += ps; \
        _Pragma("unroll") for (int st = 0; st < 2; ++st) { \
            u32x4 pw; \
            _Pragma("unroll") for (int i = 0; i < 4; ++i) pw[i] = pk2(s##c[8 * st + 2 * i], s##c[8 * st + 2 * i + 1]); \
            const bf16x8 pf = __builtin_bit_cast(bf16x8, pw); \
            _Pragma("unroll") for (int dt = 0; dt < 2; ++dt) { \
                u32x4 vw = {vf[st][dt][0][0], vf[st][dt][0][1], vf[st][dt][1][0], vf[st][dt][1][1]}; \
                O[c][dt] = __builtin_amdgcn_mfma_f32_32x32x16_bf16(__builtin_bit_cast(bf16x8, vw), pf, O[c][dt], 0, 0, 0); \
            } \
        } } while (0)
    lds_barrier();
    gload(0); lstore(0);
    if (nkt > 1) { gload(1); lstore(1); }
    if (nkt > 2) gload(2);
    lds_barrier();
    ldk(0, 0);
    for (int t = 0; t < nkt; ++t) {
        const int cur = t & 3, nxt = (t + 1) & 3;
        if (t + 2 < nkt) lstore((t + 2) & 3);
        if (t + 3 < nkt) gload(t + 3);
#pragma unroll
        for (int kk = 0; kk < 2; ++kk) {
            f32x16 s0, s1;
#pragma unroll
            for (int i = 0; i < 16; ++i) { s0[i] = 0.f; s1[i] = 0.f; }
            if (ISC) {
                s0 = __builtin_amdgcn_mfma_f32_32x32x16_bf16(kf[0], qf[0][0], s0, 0, 0, 0); s1 = __builtin_amdgcn_mfma_f32_32x32x16_bf16(kf[2], qf[0][2], s1, 0, 0, 0);
                s0 = __builtin_amdgcn_mfma_f32_32x32x16_bf16(kf[1], qf[0][1], s0, 0, 0, 0); s1 = __builtin_amdgcn_mfma_f32_32x32x16_bf16(kf[3], qf[0][3], s1, 0, 0, 0);
            } else {
#pragma unroll
                for (int ks = 0; ks < 4; ++ks) s0 = __builtin_amdgcn_mfma_f32_32x32x16_bf16(kf[ks], qf[0][ks], s0, 0, 0, 0);
#pragma unroll
                for (int ks = 0; ks < 4; ++ks) s1 = __builtin_amdgcn_mfma_f32_32x32x16_bf16(kf[ks], qf[NQ - 1][ks], s1, 0, 0, 0);
            }
            __builtin_amdgcn_sched_barrier(0);
            ldv(cur, kk);
            if (kk == 0) ldk(cur, 1); else if (t + 1 < nkt) ldk(nxt, 0);
            SOFT_PV(0);
            SOFT_PV(1);
        }
        lds_barrier();
    }
#undef SOFT_PV
#pragma unroll
    for (int c = 0; c < 2; ++c) {
        const float lt = l_run[c] + __shfl_xor(l_run[c], 32);
        const float inv = 1.f / lt;
#pragma unroll
        for (int i = 0; i < 16; ++i) { O[c][0][i] *= inv; O[c][1][i] *= inv; }
    }
}

DI void store_OT(const f32x16 (&O)[2], bf16_t* dst  , int h) {
#pragma unroll
    for (int dt = 0; dt < 2; ++dt)
#pragma unroll
        for (int gq = 0; gq < 4; ++gq) {
            u32x2 w; w[0] = pk2(O[dt][4 * gq], O[dt][4 * gq + 1]); w[1] = pk2(O[dt][4 * gq + 2], O[dt][4 * gq + 3]);
            *(u32x2*)(dst + dt * 32 + 8 * gq + 4 * h) = w;
        }
}

DI void attn_unit(const Params& p, int l, int idx, int qb, bool isC, char* smem) {
    const int lane = TID() & 63, wid = TID() >> 6, r = lane & 31, h = lane >> 5;
    const int qpos0 = qb < 8 ? qb * 256 : SEQ, key_lo = qb < 8 ? 0 : SEQ, nkt = qb < 8 ? KEYS / 64 : CTX / 64;
    const int qpos = qpos0 + wid * 32 + r;
    f32x16 O[2][2];
    if (!isC) {
        const int b = idx >> 1, kvh = idx & 1;
        const size_t grow = qpos < SEQ ? (size_t)b * SEQ + qpos : (size_t)NLAT + b * CTX + (qpos - SEQ);
        const bf16_t* q0 = p.QA + (size_t)(b * 4 + 2 * kvh) * KEYS * 64;
        const float gq = fabsf(p.g_q_a[l * 64 + lane]), gk = fabsf(p.g_k_a[l * 64 + lane]);
        float mq = gq, mk = gk;
#pragma unroll
        for (int o = 32; o >= 1; o >>= 1) { mq = fmaxf(mq, __shfl_xor(mq, o)); mk = fmaxf(mk, __shfl_xor(mk, o)); }
        const float sc = 1.f, mfix = 64.f * 1.02f * mq * mk * SC_A;
        if (mfix < 60.f)
            attn2_core<false, true>(q0, q0 + (size_t)KEYS * 64, p.KA + (size_t)idx * KEYS * 64, p.VtA + (size_t)idx * 64 * KEYS, qpos0, key_lo, nkt, sc, mfix, mfix, O, smem);
        else
            attn2_core<false, false>(q0, q0 + (size_t)KEYS * 64, p.KA + (size_t)idx * KEYS * 64, p.VtA + (size_t)idx * 64 * KEYS, qpos0, key_lo, nkt, sc, 0.f, 0.f, O, smem);
        store_OT(O[0], p.cat + grow * D + (2 * kvh) * 64, h);
        store_OT(O[1], p.cat + grow * D + (2 * kvh + 1) * 64, h);
    } else {
        const int b = idx >> 2, head = idx & 3;
        const size_t grow = qpos < SEQ ? (size_t)b * SEQ + qpos : (size_t)NLAT + b * CTX + (qpos - SEQ);
        const bf16_t* qc = p.QC + (size_t)idx * KEYS * 64;
        const float scC = 1.f;
        float q2[2] = {0.f, 0.f};
#pragma unroll
        for (int c = 0; c < 2; ++c)
#pragma unroll
            for (int ks = 0; ks < 2; ++ks) {
                const u32x4 qv = *(const u32x4*)(qc + (size_t)qpos * 64 + (2 * c + ks) * 16 + 8 * h);
#pragma unroll
                for (int i = 0; i < 4; ++i) { const float a = bflo(qv[i]), bq = bfhi(qv[i]); q2[c] += a * a + bq * bq; }
            }
        q2[0] += __shfl_xor(q2[0], 32); q2[1] += __shfl_xor(q2[1], 32);
        const unsigned* km = p.kmaxC + (size_t)l * NB * 8 + idx * 2;
        const float mf0 = 1.03f * sqrtf(q2[0] * __uint_as_float(km[0])), mf1 = 1.03f * sqrtf(q2[1] * __uint_as_float(km[1]));
        if (__builtin_amdgcn_ballot_w64(mf0 < 60.f && mf1 < 60.f) == ~0ull)
            attn2_core<true, true>(qc, qc, p.KC + (size_t)idx * KEYS * 64, p.VtC + (size_t)idx * 64 * KEYS, qpos0, key_lo, nkt, scC, mf0, mf1, O, smem);
        else
            attn2_core<true, false>(qc, qc, p.KC + (size_t)idx * KEYS * 64, p.VtC + (size_t)idx * 64 * KEYS, qpos0, key_lo, nkt, scC, 0.f, 0.f, O, smem);
        const float lam_init = 0.8f - 0.6f * __expf(-0.3f * (float)l);
        const float* lp = p.lam_c + l * 128;
        const float d0 = wave_sum(lane < 32 ? lp[lane] * lp[32 + lane] : 0.f), d1 = wave_sum(lane < 32 ? lp[64 + lane] * lp[96 + lane] : 0.f);
        const float lam = __expf(d0) - __expf(d1) + lam_init;
        float ss = 0.f;
#pragma unroll
        for (int dt = 0; dt < 2; ++dt)
#pragma unroll
            for (int i = 0; i < 16; ++i) { const float v = O[0][dt][i] - lam * O[1][dt][i]; O[0][dt][i] = v; ss += v * v; }
        ss += __shfl_xor(ss, 32);
        const float rstd = rsqrtf(ss * (1.f / 64.f) + EPS) * (1.f - lam_init);
        const float* g = p.g_sub_c + l * 64;
#pragma unroll
        for (int dt = 0; dt < 2; ++dt)
#pragma unroll
            for (int i = 0; i < 16; ++i) O[0][dt][i] *= rstd * g[dt * 32 + 8 * (i >> 2) + 4 * h + (i & 3)];
        store_OT(O[0], p.cat + grow * D + 256 + head * 64, h);
    }
}

DI void gmlp_unit(const Params& p, int l, int uidx, char* smem) {
    const int g = uidx & 3, c = uidx >> 2, tid = TID(), lane = tid & 63, wid = tid >> 6, fr = lane & 15, fq = lane >> 4;
    LAS bf16_t* vT = (LAS bf16_t*)smem;
    constexpr int VS = 136;
    const int q = tid >> 2, d0 = (tid & 3) * 16;
    const bf16_t* src = p.VN + (size_t)(c * 128 + q) * 256 + g * 64 + d0;
    const bf16x8 a = *(const bf16x8*)src, bb = *(const bf16x8*)(src + 8);
    const bf16_t* wrow = p.Ws + ((size_t)(l * 4 + g) * 128 + wid * 16 + fr) * 128;
    bf16x8 af[4];
#pragma unroll
    for (int ks = 0; ks < 4; ++ks) af[ks] = *(const bf16x8*)(wrow + ks * 32 + fq * 8);
    const int prow = wid * 16 + fr; const size_t grow = (size_t)c * 128 + prow;
    const float bias = p.b_s_b[(l * 4 + g) * 128 + prow];
    u32x2 uu[4];
#pragma unroll
    for (int n = 0; n < 4; ++n) uu[n] = *(const u32x2*)(p.U + grow * 256 + g * 64 + n * 16 + fq * 4);
    lds_barrier();
#pragma unroll
    for (int j = 0; j < 8; ++j) { vT[(d0 + j) * VS + q] = (bf16_t)a[j]; vT[(d0 + 8 + j) * VS + q] = (bf16_t)bb[j]; }
    lds_barrier();
    f32x4 acc[4];
#pragma unroll
    for (int n = 0; n < 4; ++n) acc[n] = (f32x4){0.f, 0.f, 0.f, 0.f};
#pragma unroll
    for (int ks = 0; ks < 4; ++ks)
#pragma unroll
        for (int n = 0; n < 4; ++n) {
            const bf16x8 bfv = *(const LAS bf16x8*)(vT + (n * 16 + fr) * VS + ks * 32 + fq * 8);
            acc[n] = __builtin_amdgcn_mfma_f32_16x16x32_bf16(bfv, af[ks], acc[n], 0, 0, 0);
        }
#pragma unroll
    for (int n = 0; n < 4; ++n) {
        const int col = g * 64 + n * 16 + fq * 4;
        u32x2 w;
        w[0] = pk2(bflo(uu[n][0]) * (acc[n][0] + bias), bfhi(uu[n][0]) * (acc[n][1] + bias));
        w[1] = pk2(bflo(uu[n][1]) * (acc[n][2] + bias), bfhi(uu[n][1]) * (acc[n][3] + bias));
        *(u32x2*)(p.cat + grow * D + 512 + col) = w;
    }
}

DI void conv_unit(const Params& p, int l, int uidx, char* smem) {
    const int tid = TID(), lane = tid & 63, wid = tid >> 6;
    bf16_t* yin = (bf16_t*)smem;
    float* co = (float*)(smem + 94 * 256 * 2);
    const int row0 = uidx * 64;
    int s0, s1;
    if (row0 < NLAT) { s0 = (row0 / SEQ) * SEQ; s1 = s0 + SEQ; } else { s0 = NLAT + ((row0 - NLAT) / CTX) * CTX; s1 = s0 + CTX; }
    lds_barrier();
    {
        u32x4 v[6];
#pragma unroll
        for (int j = 0; j < 6; ++j) {
            const int i = tid + j * NTHR, rr = i >> 5, ch8 = (i & 31) * 8, gr = row0 - 15 + rr;
            v[j] = (u32x4){0, 0, 0, 0};
            if (i < 94 * 32 && gr >= s0 && gr < s1) v[j] = *(const u32x4*)(p.Y + (size_t)gr * 256 + ch8);
        }
#pragma unroll
        for (int j = 0; j < 6; ++j) {
            const int i = tid + j * NTHR, rr = i >> 5, ch8 = (i & 31) * 8;
            if (i < 94 * 32) *(u32x4*)(yin + rr * 256 + ch8) = v[j];
        }
    }
    lds_barrier();
    {
        const int ch = tid & 255, th = tid >> 8;
        float w[31];
#pragma unroll
        for (int k = 0; k < 31; ++k) w[k] = p.w_dw_d[(size_t)(l * 31 + k) * 256 + ch];
        const float bias = p.b_dw_d[l * 256 + ch];
        for (int i0 = th * 32; i0 < th * 32 + 32; i0 += 8) {
            float xw[38];
#pragma unroll
            for (int j = 0; j < 38; ++j) xw[j] = bf2f(yin[(i0 + j) * 256 + ch]);
#pragma unroll
            for (int o = 0; o < 8; ++o) {
                float a = bias;
#pragma unroll
                for (int k = 0; k < 31; ++k) a += w[k] * xw[o + k];
                co[(i0 + o) * 256 + ch] = a;
            }
        }
    }
    lds_barrier();
#pragma unroll
    for (int j = 0; j < 8; ++j) {
        const int tk = wid * 8 + j;
        const f32x4 v = *(const f32x4*)(co + tk * 256 + lane * 4);
        const float ss = wave_sum(v[0] * v[0] + v[1] * v[1] + v[2] * v[2] + v[3] * v[3]);
        const float rstd = rsqrtf(ss * (1.f / 256.f) + EPS);
        const f32x4 g = *(const f32x4*)(p.g_conv_d + l * 256 + lane * 4);
        u32x2 w; w[0] = pk2(silu_f(v[0] * rstd * g[0]), silu_f(v[1] * rstd * g[1])); w[1] = pk2(silu_f(v[2] * rstd * g[2]), silu_f(v[3] * rstd * g[3]));
        *(u32x2*)(p.cat + (size_t)(row0 + tk) * D + 768 + lane * 4) = w;
    }
}

DI void phase_mixers(const Params& p, int l, bool withctx, char* smem) {
    const int nCL = NB * 4 * 8, nAL = NB * 2 * 8, nCX = withctx ? NB * 4 : 0, nAX = withctx ? NB * 2 : 0;
    const int nG = (withctx ? NTOK : NLAT) / 128 * 4, nV = (withctx ? NTOK : NLAT) / 64;
    const int nAtt = nCL + nAL + nCX + nAX, total = nAtt + nG + nV;
    for (int u = blockIdx.x; u < total; u += gridDim.x) {
        asm volatile("" : "+s"(l));
        int r = u;
        if (r < nAtt) {
            int idx, qb; bool isC;
            if (r < nCL) { isC = true; idx = r >> 3; qb = r & 7; }
            else if ((r -= nCL) < nAL) { isC = false; idx = r >> 3; qb = r & 7; }
            else if ((r -= nAL) < nCX) { isC = true; idx = r; qb = 8; }
            else { r -= nCX; isC = false; idx = r; qb = 8; }
            if (isC) attn_unit(p, l, idx, qb, true, smem); else attn_unit(p, l, idx, qb, false, smem);
        } else if ((r -= nAtt) < nG) gmlp_unit(p, l, r, smem);
        else conv_unit(p, l, r - nG, smem);
    }
}

#define XB_TMO      128
#define XB_XCNT(j)  (256  + 64 * (j))
#define XB_XSUB(j)  (1280 + 64 * (j))
#define XB_XGEN(j)  (2304 + 64 * (j))
#define XB_TOP      3328
#define XB_TOPGEN   3392
#define XCD_BAR_WORDS 3456
#define XB_SPIN_CAP (1u << 22)
DI unsigned xb_ld(unsigned* p) { return __hip_atomic_load(p, __ATOMIC_RELAXED, __HIP_MEMORY_SCOPE_AGENT); }
DI unsigned xb_add(unsigned* p, unsigned v) { return __hip_atomic_fetch_add(p, v, __ATOMIC_RELAXED, __HIP_MEMORY_SCOPE_AGENT); }
DI unsigned xb_xcc_id() { return (unsigned)__builtin_amdgcn_s_getreg((3 << 11) | 20) & 0xFu; }
#define XB_SPIN(cond, bar) do { unsigned _sp = 0; while (cond) { __builtin_amdgcn_s_sleep(1); \
    if ((++_sp & 255u) == 0u) { if (xb_ld(&(bar)[XB_TMO])) break; if (_sp > XB_SPIN_CAP) { atomicAdd(&(bar)[XB_TMO], 1u); break; } } } } while (0)
DI void xcd_barrier_complete(unsigned* bar, unsigned x, unsigned& nloc, unsigned& nx) {
    const unsigned G = gridDim.x;
    unsigned sum, cnt, mine, sp = 0u;
    for (;;) {
        sum = 0u; cnt = 0u; mine = 0u;
#pragma unroll
        for (unsigned j = 0; j < 16; ++j) { const unsigned c = xb_ld(&bar[XB_XCNT(j)]); sum += c; cnt += (c > 0u) ? 1u : 0u; mine = (j == x) ? c : mine; }
        if (sum == G) break;
        __builtin_amdgcn_s_sleep(1);
        if ((++sp & 255u) == 0u) { if (xb_ld(&bar[XB_TMO])) break; if (sp > XB_SPIN_CAP) { atomicAdd(&bar[XB_TMO], 1u); break; } }
    }
    nloc = mine > 0u ? mine : 1u; nx = cnt > 0u ? cnt : 1u;
}
DI void xcd_barrier(unsigned* bar, volatile LAS unsigned* st) {
    asm volatile("s_waitcnt vmcnt(0)" ::: "memory");
    __syncthreads();
    if (__builtin_amdgcn_workitem_id_x() == 0) {
        __builtin_amdgcn_s_waitcnt(0);
        const unsigned x = xb_xcc_id();
        unsigned nloc = st[0], nx = st[1];
        if (nloc == 0u) { xcd_barrier_complete(bar, x, nloc, nx); st[0] = nloc; st[1] = nx; }
        const unsigned old = xb_add(&bar[XB_XSUB(x)], 1u);
        const unsigned gen = old / nloc;
        if (old + 1u == (gen + 1u) * nloc) {
            __builtin_amdgcn_fence(__ATOMIC_RELEASE, "agent");
            asm volatile("s_waitcnt vmcnt(0)" ::: "memory");
            const unsigned og = xb_add(&bar[XB_TOP], 1u);
            const unsigned tg = og / nx;
            if (og + 1u == (tg + 1u) * nx) xb_add(&bar[XB_TOPGEN], 1u);
            else XB_SPIN(xb_ld(&bar[XB_TOPGEN]) == tg, bar);
            __builtin_amdgcn_fence(__ATOMIC_ACQUIRE, "agent");
            xb_add(&bar[XB_XGEN(x)], 1u);
            asm volatile("s_waitcnt vmcnt(0)" ::: "memory");
        } else {
            XB_SPIN(xb_ld(&bar[XB_XGEN(x)]) == gen, bar);
            __builtin_amdgcn_fence(__ATOMIC_ACQUIRE, "agent");
            asm volatile("s_waitcnt vmcnt(0)" ::: "memory");
        }
    }
    __syncthreads();
}

constexpr int PH_PER_LAYER = 10, N_PHASES = 1 + DEPTH * PH_PER_LAYER + 1;

typedef const __attribute__((address_space(4))) Params* KParamsPtr;
__global__ void __launch_bounds__(NTHR) mega(Params p_unused, int ph_lo, int ph_hi) {
    extern __shared__ __attribute__((aligned(16))) char smem[];
    volatile LAS unsigned* xst = (volatile LAS unsigned*)(smem + LDS_BYTES - 16);
    if (ph_hi - ph_lo > 1) {
        if (__builtin_amdgcn_workitem_id_x() == 0) {
            xst[0] = 0u; xst[1] = 0u;
            KParamsPtr kp0 = (KParamsPtr)__builtin_amdgcn_kernarg_segment_ptr();
            (void)xb_add(&kp0->bar[XB_XCNT(xb_xcc_id())], 1u);
        }
        __syncthreads();
    }
#ifndef PROBE_PH
#define PROBE_PH -1
#endif
#if PROBE_SEL
    unsigned long long pr_t0 = 0, pr_prev = 0, pr_acc = 0; int pr_sel_prev = 0;
#endif
    for (int it = ph_lo; it < ph_hi + (PROBE_PH >= 0 ? 1 : 0); ++it) {
        const int ph = (PROBE_PH >= 0 && it > PROBE_PH) ? it - 1 : it;
        if (it == ph_lo + 1) cg::this_grid().sync();
        else if (it > ph_lo) { KParamsPtr kpb = (KParamsPtr)__builtin_amdgcn_kernarg_segment_ptr(); asm volatile("" : "+s"(kpb)); xcd_barrier(kpb->bar, xst); }
#if PROBE_SEL
        {
            const unsigned long long now = __builtin_amdgcn_s_memrealtime();
            if (it == ph_lo) { pr_t0 = now; } else if (pr_sel_prev) pr_acc += now - pr_prev;
            pr_prev = now;
            const int s_ = ph == 0 ? 10 : (ph == N_PHASES - 1 ? 11 : (ph - 1) % PH_PER_LAYER);
            pr_sel_prev = (PROBE_SEL >> s_) & 1;
            if (ph == N_PHASES - 1 && blockIdx.x == 0 && __builtin_amdgcn_workitem_id_x() == 0) {
                KParamsPtr kpp = (KParamsPtr)__builtin_amdgcn_kernarg_segment_ptr();
                kpp->probe[0] = sqrtf((float)pr_acc / (float)(now - pr_t0) * 2e-5f);
            }
            if (ph == N_PHASES - 1) { __syncthreads(); if (blockIdx.x == 0) { __threadfence(); } cg::this_grid().sync(); }
        }
#endif
        KParamsPtr kp = (KParamsPtr)__builtin_amdgcn_kernarg_segment_ptr();
        asm volatile("" : "+s"(kp));
        const Params& p = *(const Params*)kp;
        if (ph == 0) { phase_prologue(p, smem); continue; }
        if (ph == N_PHASES - 1) { phase_norm<true>(p, false, p.g_final, nullptr, 0, NLAT); continue; }
        const int l = (ph - 1) / PH_PER_LAYER, s = (ph - 1) % PH_PER_LAYER;
        const bool last = l == DEPTH - 1;
        const float* mods_l = p.mods + (size_t)l * 17 * MODW;
        if (s == 0 || s == 3 || s == 7) {
            const int j = s == 0 ? 0 : (s == 3 ? 1 : 2);
            const bool first = (l == 0 && s == 0);
            phase_norm<false>(p, first, p.g_norm + (l * 3 + j) * D, mods_l, 3 * j, (s == 7 && last) ? NLAT : NTOK);
        } else if (s == 1 || s == 8) {
            EpiSwiglu e{p.hid};
            phase_gemm_stream(p.xn, (s == 1 ? p.Wff1in : p.Wff2in) + (size_t)l * D * 2 * DFF, (s == 8 && last) ? NLAT : NTOK, 2 * DFF, D, e, smem);
        } else if (s == 2 || s == 6 || s == 9) {
            const bf16_t* A = s == 6 ? p.cat : p.hid;
            const bf16_t* Bt = s == 2 ? p.Wff1out + (size_t)l * D * DFF : (s == 9 ? p.Wff2out + (size_t)l * D * DFF : p.Wout + (size_t)l * D * D);
            const int K = s == 6 ? D : DFF, gi = s == 2 ? 2 : (s == 6 ? 5 : 8);
            EpiResid e{p.h16, mods_l + gi * D, p.dctx, s == 6 ? 1.0f : 0.5f};
            const bool withctx = !(s != 2 && last);
            phase_gemm_stream(A, Bt, withctx ? NTOK : NLAT, D, K, e, smem, withctx);
        } else if (s == 4) {
            EpiProj e{&p, l}; phase_gemm(p.xn, p.Win + (size_t)l * D * INC, NTOK, INC, D, e, smem, false, last);
        } else {
            phase_mixers(p, l, !last, smem);
        }
    }
}

extern "C" void kernel_launch(void* const* d_in, const int* in_sizes, int n_in, void* d_out, int out_size, void* d_ws, size_t ws_size, hipStream_t stream) {
    static int grid = 0;
    if (grid == 0) {
        int dev = 0, cus = 0, per_cu = 0;
        hipGetDevice(&dev);
        hipDeviceGetAttribute(&cus, hipDeviceAttributeMultiprocessorCount, dev);
        if (hipFuncSetAttribute((const void*)mega, hipFuncAttributeMaxDynamicSharedMemorySize, LDS_BYTES) != hipSuccess) fprintf(stderr, "hipFuncSetAttribute failed\n");
        if (hipOccupancyMaxActiveBlocksPerMultiprocessor(&per_cu, (const void*)mega, NTHR, LDS_BYTES) != hipSuccess || per_cu < 1) { fprintf(stderr, "occupancy query: %d\n", per_cu); per_cu = 1; }
        (void)hipGetLastError();
        grid = cus * per_cu;
        fprintf(stderr, "grid = %d (cus %d per_cu %d) ws_size %zu\n", grid, cus, per_cu, ws_size);
    }
    Params p{};
    const float** pin = (const float**)&p;
    for (int i = 0; i < 24; ++i) pin[i] = (const float*)d_in[i];
    p.out = (float*)d_out;
    char* w = (char*)d_ws; size_t off = 0;
    auto take = [&](size_t bytes) { char* r = w + off; off += (bytes + 255) & ~(size_t)255; return r; };
    p.Wff1in = (bf16_t*)take((size_t)DEPTH * D * 2 * DFF * 2);
    p.Wff1out = (bf16_t*)take((size_t)DEPTH * D * DFF * 2);
    p.Wff2in = (bf16_t*)take((size_t)DEPTH * D * 2 * DFF * 2);
    p.Wff2out = (bf16_t*)take((size_t)DEPTH * D * DFF * 2);
    p.Win = (bf16_t*)take((size_t)DEPTH * D * INC * 2);
    p.Wout = (bf16_t*)take((size_t)DEPTH * D * D * 2);
    p.Ws = (bf16_t*)take((size_t)DEPTH * 4 * 128 * 128 * 2);
    p.mods = (float*)take((size_t)DEPTH * 17 * MODW * 4);
    p.ropeA = (float*)take((size_t)SEQ * 32 * 2 * 4);
    p.ropeC = (float*)take((size_t)SEQ * 16 * 2 * 4);
    p.bar = (unsigned*)take((size_t)XCD_BAR_WORDS * 4);
    p.hc = nullptr;
    p.h16 = (_Float16*)take((size_t)NTOK * D * 2);
    p.probe = (float*)take(256);
    p.kmaxC = (unsigned*)take((size_t)DEPTH * NB * 4 * 2 * 4);
    p.dctx = (float*)take((size_t)4 * NCTX * D * 4);
    p.xn = (bf16_t*)d_out;
    p.cat = p.xn;
    p.hid = (bf16_t*)take((size_t)NTOK * DFF * 2);
    {
        char* q = (char*)p.hid; size_t o2 = 0;
        auto take2 = [&](size_t bytes) { char* r = q + o2; o2 += (bytes + 255) & ~(size_t)255; return r; };
        p.QA = (bf16_t*)take2((size_t)NB * 4 * KEYS * 64 * 2);
        p.KA = (bf16_t*)take2((size_t)NB * 2 * KEYS * 64 * 2);
        p.VtA = (bf16_t*)take2((size_t)NB * 2 * 64 * KEYS * 2);
        p.QC = (bf16_t*)take2((size_t)NB * 4 * 2 * KEYS * 32 * 2);
        p.KC = (bf16_t*)take2((size_t)NB * 4 * 2 * KEYS * 32 * 2);
        p.VtC = (bf16_t*)take2((size_t)NB * 4 * 64 * KEYS * 2);
        p.U = (bf16_t*)take2((size_t)NTOK * 256 * 2);
        p.VN = (bf16_t*)take2((size_t)NTOK * 256 * 2);
        p.Y = (bf16_t*)take2((size_t)NTOK * 256 * 2);
    }
    if (off > ws_size) { fprintf(stderr, "workspace too small: need %zu have %zu\n", off, ws_size); return; }
#if N_LAUNCH_MODE == 1
    if (hipMemsetAsync(p.bar, 0, (size_t)XCD_BAR_WORDS * 4, stream) != hipSuccess) fprintf(stderr, "memset of barrier words failed\n");
    int lo = 0, hi = N_PHASES;
    void* args[] = {&p, &lo, &hi};
    hipError_t e = hipLaunchCooperativeKernel((const void*)mega, dim3(grid), dim3(NTHR), args, LDS_BYTES, stream);
    if (e != hipSuccess) fprintf(stderr, "cooperative launch failed: %s (grid %d)\n", hipGetErrorString(e), grid);
#else
    for (int ph = 0; ph < N_PHASES; ++ph) hipLaunchKernelGGL(mega, dim3(grid), dim3(NTHR), LDS_BYTES, stream, p, ph, ph + 1);
#endif
}
```

```cpp
#include <hip/hip_runtime.h>
#include <hip/hip_cooperative_groups.h>
#include <cstdint>
#include <cstdio>
#include <cmath>
namespace cg = cooperative_groups;

#ifndef PROBE_SEL
#define PROBE_SEL 0
#endif
#ifndef N_LAUNCH_MODE
#define N_LAUNCH_MODE 1
#endif

typedef unsigned short bf16_t;
typedef short bf16x8 __attribute__((ext_vector_type(8)));
typedef short s16x4 __attribute__((ext_vector_type(4)));
typedef float f32x4 __attribute__((ext_vector_type(4)));
typedef float f32x2 __attribute__((ext_vector_type(2)));
typedef float f32x16 __attribute__((ext_vector_type(16)));
typedef unsigned u32x2 __attribute__((ext_vector_type(2)));
typedef unsigned u32x4 __attribute__((ext_vector_type(4)));
typedef __bf16 bf2_t __attribute__((ext_vector_type(2)));
#define DI __device__ __forceinline__

constexpr int D = 1024, NB = 16, SEQ = 2048, CTX = 256, NLAT = NB * SEQ, NCTX = NB * CTX, NTOK = NLAT + NCTX;
constexpr int DFF = 2816, INC = 2304, KEYS = SEQ + CTX, DEPTH = 2, MODW = 9 * D;
constexpr int NTHR = 512;
constexpr int LDS_BYTES = 135168;
constexpr float EPS = 1e-6f;

DI unsigned pk2(float a, float b) { f32x2 v = {a, b}; bf2_t r = __builtin_convertvector(v, bf2_t); return __builtin_bit_cast(unsigned, r); }
DI float bf2f(bf16_t v) { return __uint_as_float(((unsigned)v) << 16); }
DI float bflo(unsigned v) { return __uint_as_float(v << 16); }
DI float bfhi(unsigned v) { return __uint_as_float(v & 0xffff0000u); }
DI bf16_t f2bf(float a) { return (bf16_t)(pk2(a, 0.f) & 0xffffu); }
DI float silu_f(float x) { return x * __builtin_amdgcn_rcpf(1.f + __expf(-x)); }
DI float sigmoid_f(float x) { return __builtin_amdgcn_rcpf(1.f + __expf(-x)); }
DI float gelu_f(float x) { float u = 1.5957691216057308f * (x + 0.044715f * x * x * x); return x * __builtin_amdgcn_rcpf(1.f + __expf(-u)); }
DI int TID() { int t = __builtin_amdgcn_workitem_id_x(); asm volatile("" : "+v"(t)); return t; }
DI void lds_barrier() { asm volatile("s_waitcnt lgkmcnt(0)" ::: "memory"); __builtin_amdgcn_s_barrier(); asm volatile("" ::: "memory"); }
DI float wave_sum(float v) {
#pragma unroll
    for (int o = 32; o >= 1; o >>= 1) v += __shfl_xor(v, o);
    return v;
}

struct Params {
    const float *x, *c, *ctx, *c_ctx, *w_ada, *b_ada, *g_norm, *w_ff1_in, *w_ff1_out, *w_ff2_in, *w_ff2_out, *w_in, *w_out, *g_q_a, *g_k_a, *lam_c,
        *g_sub_c, *g_v_b, *w_s_b, *b_s_b, *w_dw_d, *b_dw_d, *g_conv_d, *g_final;
    float* out;
    bf16_t *Wff1in, *Wff1out, *Wff2in, *Wff2out, *Win, *Wout, *Ws;
    float *mods, *ropeA, *ropeC, *hc;
    bf16_t *xn, *hid, *QA, *KA, *VtA, *QC, *KC, *VtC, *U, *VN, *Y, *cat;
    unsigned* bar;
    float* probe;
    unsigned* kmaxC;
    float* dctx;
    _Float16* h16;
};

DI void sincos_d(double x, double& s, double& c) {
    double k = rint(x * 0.15915494309189535);
    double r = fma(-k, 6.283185307179586, x);
    r = fma(-k, 2.4492935982947064e-16, r);
    double r2 = r * r, as = 1.0, ac = 1.0;
#pragma unroll
    for (int n = 14; n >= 1; --n) {
        as = 1.0 - r2 / (double)((2 * n) * (2 * n + 1)) * as;
        ac = 1.0 - r2 / (double)((2 * n - 1) * (2 * n)) * ac;
    }
    s = r * as; c = ac;
}

constexpr int T_FFIN = (D / 64) * (2 * DFF / 256), T_FFOUT = (DFF / 64) * (D / 256), T_WIN = (D / 64) * (INC / 256), T_WOUT = (D / 64) * (D / 256);
constexpr int T_LAYER = 2 * T_FFIN + 2 * T_FFOUT + T_WIN + T_WOUT;
constexpr int U_TR = DEPTH * T_LAYER, U_WS = 32, U_ADA = 288, U_ROPE = 192;
constexpr int U_P0 = U_TR + U_WS + U_ADA + U_ROPE;

DI void transpose_unit(const float* src, bf16_t* dst, int K, int N, int perm, int ti, float* tile) {
    const int tn = N / 256, kt = ti / tn, nt = ti % tn, k0 = kt * 64;
    const int t = TID();
    const int kk = t >> 4, c4 = (t & 15) * 4;
    f32x4 v[4][2];
#pragma unroll
    for (int sub = 0; sub < 4; ++sub) {
        const int n0 = nt * 256 + sub * 64;
        int sc0 = n0;
        if (perm == 1) { const int q = n0 >> 8, j = n0 & 255; sc0 = j < 128 ? q * 128 + j : DFF + q * 128 + (j - 128); }
        else if (perm == 2 && n0 >= 1792) { const int m = n0 - 1792, q = m >> 8, j = m & 255; sc0 = j < 128 ? 1792 + q * 128 + j : 2048 + q * 128 + (j - 128); }
#pragma unroll
        for (int i = 0; i < 2; ++i) v[sub][i] = *(const f32x4*)(src + (size_t)(k0 + kk + 32 * i) * N + sc0 + c4);
    }
#pragma unroll
    for (int sub = 0; sub < 4; ++sub)
#pragma unroll
        for (int i = 0; i < 2; ++i) {
            float* tp = tile + sub * 64 * 65 + (kk + 32 * i) * 65 + c4;
            tp[0] = v[sub][i][0]; tp[1] = v[sub][i][1]; tp[2] = v[sub][i][2]; tp[3] = v[sub][i][3];
        }
    __syncthreads();
    {
        const int n = t >> 3, k8 = (t & 7) * 8;
#pragma unroll
        for (int sub = 0; sub < 4; ++sub) {
            const float* tp = tile + sub * 64 * 65 + k8 * 65 + n;
            u32x4 o;
            o[0] = pk2(tp[0], tp[65]); o[1] = pk2(tp[2 * 65], tp[3 * 65]); o[2] = pk2(tp[4 * 65], tp[5 * 65]); o[3] = pk2(tp[6 * 65], tp[7 * 65]);
            *(u32x4*)(dst + (size_t)(nt * 256 + sub * 64 + n) * K + k0 + k8) = o;
        }
    }
    __syncthreads();
}

DI void phase_prologue(const Params& p, char* smem) {
    const int t = TID();
    if ((int)blockIdx.x < U_ADA) {
        float* s = (float*)smem;
        float* red = s + 17 * 1024;
        {
            float cv[34];
#pragma unroll
            for (int j = 0; j < 34; ++j) { const int i = t + j * NTHR, r = i >> 10, k = i & 1023; cv[j] = r < 16 ? p.c[r * D + k] : p.c_ctx[k]; }
#pragma unroll
            for (int j = 0; j < 34; ++j) s[t + j * NTHR] = silu_f(cv[j]);
        }
        __syncthreads();
        const int col = t & 63, ks = t >> 6;
        for (int uu = blockIdx.x; uu < U_ADA; uu += gridDim.x) {
            const int l = uu / 144, col0 = (uu % 144) * 64;
            float acc[17];
#pragma unroll
            for (int r = 0; r < 17; ++r) acc[r] = 0.f;
            const float* w = p.w_ada + (size_t)l * D * MODW + (size_t)(ks * 128) * MODW + col0 + col;
            float wv[16], wn[16];
#pragma unroll
            for (int k = 0; k < 16; ++k) wv[k] = w[(size_t)k * MODW];
            for (int k0 = 0; k0 < 128; k0 += 16) {
                if (k0 + 16 < 128) {
#pragma unroll
                    for (int k = 0; k < 16; ++k) wn[k] = w[(size_t)(k0 + 16 + k) * MODW];
                }
#pragma unroll
                for (int r = 0; r < 17; ++r)
#pragma unroll
                    for (int kq = 0; kq < 4; ++kq) {
                        const f32x4 sv = *(const f32x4*)(s + r * 1024 + ks * 128 + k0 + 4 * kq);
                        acc[r] += (sv[0] * wv[4 * kq] + sv[1] * wv[4 * kq + 1]) + (sv[2] * wv[4 * kq + 2] + sv[3] * wv[4 * kq + 3]);
                    }
#pragma unroll
                for (int k = 0; k < 16; ++k) wv[k] = wn[k];
            }
#pragma unroll
            for (int r = 0; r < 17; ++r) red[(ks * 17 + r) * 64 + col] = acc[r];
            __syncthreads();
            for (int i = t; i < 17 * 64; i += NTHR) {
                const int r = i >> 6, cc = i & 63; float sum = 0.f;
#pragma unroll
                for (int q = 0; q < 8; ++q) sum += red[(q * 17 + r) * 64 + cc];
                p.mods[((size_t)l * 17 + r) * MODW + col0 + cc] = sum + p.b_ada[(size_t)l * MODW + col0 + cc];
            }
            __syncthreads();
        }
    }
    if (blockIdx.x == gridDim.x - 1 && t < DEPTH * NB * 4 * 2) p.kmaxC[t] = 0u;
    for (int v = (int)gridDim.x - 1 - (int)blockIdx.x; v < U_WS + U_ROPE; v += gridDim.x) {
        if (v < U_WS) {
            const int e0 = v * 4096 + t * 8;
            f32x4 a = *(const f32x4*)(p.w_s_b + e0), b = *(const f32x4*)(p.w_s_b + e0 + 4);
            u32x4 o; o[0] = pk2(a[0], a[1]); o[1] = pk2(a[2], a[3]); o[2] = pk2(b[0], b[1]); o[3] = pk2(b[2], b[3]);
            *(u32x4*)(p.Ws + e0) = o;
        } else {
            const int e = (v - U_WS) * 512 + t;
            const int pos = e / 48, j = e % 48, row = pos >> 6, col = pos & 63;
            float ang; float* dst;
            if (j < 32) { const float inv = exp2f(-(float)(j & 15) * (13.287712379549449f / 16.f)); ang = (float)(j < 16 ? row : col) * inv; dst = p.ropeA + ((size_t)pos * 32 + j) * 2; }
            else { const int jj = j - 32; const float inv = exp2f(-(float)(jj & 7) * (13.287712379549449f / 8.f)); ang = (float)(jj < 8 ? row : col) * inv; dst = p.ropeC + ((size_t)pos * 16 + jj) * 2; }
            double sn, cs; sincos_d((double)ang, sn, cs);
            dst[0] = (float)cs; dst[1] = (float)sn;
        }
    }
    for (int u = blockIdx.x; u < U_TR; u += gridDim.x) {
        const int l = u / T_LAYER; int r = u % T_LAYER;
        const float* src; bf16_t* dst; int K, N, perm;
        if (r < T_FFIN) { src = p.w_ff1_in + (size_t)l * D * 2 * DFF; dst = p.Wff1in + (size_t)l * D * 2 * DFF; K = D; N = 2 * DFF; perm = 1; }
        else if ((r -= T_FFIN) < T_FFOUT) { src = p.w_ff1_out + (size_t)l * D * DFF; dst = p.Wff1out + (size_t)l * D * DFF; K = DFF; N = D; perm = 0; }
        else if ((r -= T_FFOUT) < T_FFIN) { src = p.w_ff2_in + (size_t)l * D * 2 * DFF; dst = p.Wff2in + (size_t)l * D * 2 * DFF; K = D; N = 2 * DFF; perm = 1; }
        else if ((r -= T_FFIN) < T_FFOUT) { src = p.w_ff2_out + (size_t)l * D * DFF; dst = p.Wff2out + (size_t)l * D * DFF; K = DFF; N = D; perm = 0; }
        else if ((r -= T_FFOUT) < T_WIN) { src = p.w_in + (size_t)l * D * INC; dst = p.Win + (size_t)l * D * INC; K = D; N = INC; perm = 2; }
        else { r -= T_WIN; src = p.w_out + (size_t)l * D * D; dst = p.Wout + (size_t)l * D * D; K = D; N = D; perm = 0; }
        transpose_unit(src, dst, K, N, perm, r, (float*)smem);
    }
}

typedef _Float16 h16x4 __attribute__((ext_vector_type(4)));
template <bool FINAL>
DI void phase_norm(const Params& p, bool first, const float* g, const float* mods_l, int mi, int nrows) {
    constexpr int RW = 4;
    const int wid = TID() >> 6, lane = TID() & 63;
    for (int u = blockIdx.x; u < nrows / (8 * RW); u += gridDim.x) {
        const int row0 = (u * 8 + wid) * RW;
        const bool islat = row0 < NLAT;
        const int mb = islat ? row0 / SEQ : 16;
        f32x4 v[RW][4];
        if (first) {
            const float* src = islat ? p.x + (size_t)row0 * D : p.ctx + (size_t)(row0 - NLAT) * D;
#pragma unroll
            for (int q = 0; q < RW; ++q)
#pragma unroll
                for (int i = 0; i < 4; ++i) v[q][i] = *(const f32x4*)(src + (size_t)q * D + i * 256 + lane * 4);
        } else {
            h16x4 hv[RW][4];
#pragma unroll
            for (int q = 0; q < RW; ++q)
#pragma unroll
                for (int i = 0; i < 4; ++i) hv[q][i] = *(const h16x4*)(p.h16 + (size_t)(row0 + q) * D + i * 256 + lane * 4);
            if (islat) {
#pragma unroll
                for (int q = 0; q < RW; ++q)
#pragma unroll
                    for (int i = 0; i < 4; ++i) v[q][i] = __builtin_convertvector(hv[q][i], f32x4);
            } else {
#pragma unroll
                for (int q = 0; q < RW; ++q)
#pragma unroll
                    for (int i = 0; i < 4; ++i) {
                        const float* pq = p.dctx + (size_t)(row0 + q - NLAT) * D + i * 256 + lane * 4;
                        v[q][i] = __builtin_convertvector(hv[q][i], f32x4) + ((*(const f32x4*)pq + *(const f32x4*)(pq + (size_t)NCTX * D)) + (*(const f32x4*)(pq + (size_t)2 * NCTX * D) + *(const f32x4*)(pq + (size_t)3 * NCTX * D)));
                    }
            }
        }
        float rstd[RW];
#pragma unroll
        for (int q = 0; q < RW; ++q) {
            float ss = 0.f;
#pragma unroll
            for (int i = 0; i < 4; ++i) ss += v[q][i][0] * v[q][i][0] + v[q][i][1] * v[q][i][1] + v[q][i][2] * v[q][i][2] + v[q][i][3] * v[q][i][3];
            rstd[q] = rsqrtf(wave_sum(ss) * (1.f / D) + EPS);
        }
        if (FINAL) {
#pragma unroll
            for (int i = 0; i < 4; ++i) { const int col = i * 256 + lane * 4; const f32x4 gv = *(const f32x4*)(g + col);
#pragma unroll
                for (int q = 0; q < RW; ++q) { f32x4 o = v[q][i] * rstd[q] * gv;
#if PROBE_SEL
                    { const float e = p.probe[0]; o[0] *= 1.f + e; o[1] *= 1.f - e; o[2] *= 1.f + e; o[3] *= 1.f - e; }
#endif
                    *(f32x4*)(p.out + (size_t)(row0 + q) * D + col) = o; } }
        } else {
            if (first || !islat) {
#pragma unroll
                for (int q = 0; q < RW; ++q)
#pragma unroll
                    for (int i = 0; i < 4; ++i) *(h16x4*)(p.h16 + (size_t)(row0 + q) * D + i * 256 + lane * 4) = __builtin_convertvector(v[q][i], h16x4);
            }
            const float* sh = mods_l + (size_t)mb * MODW + mi * D; const float* scl = sh + D;
#pragma unroll
            for (int i = 0; i < 4; ++i) {
                const int col = i * 256 + lane * 4;
                const f32x4 gv = *(const f32x4*)(g + col), sv = *(const f32x4*)(scl + col), bv = *(const f32x4*)(sh + col);
                const f32x4 gs = gv * (1.f + sv);
#pragma unroll
                for (int q = 0; q < RW; ++q) {
                    const f32x4 o = v[q][i] * rstd[q] * gs + bv;
                    u32x2 w; w[0] = pk2(o[0], o[1]); w[1] = pk2(o[2], o[3]);
                    *(u32x2*)(p.xn + (size_t)(row0 + q) * D + col) = w;
                }
            }
        }
    }
}

constexpr int BM = 256, BK = 64, HALF = 128, HT = HALF * BK, NXCD = 8, WGM = 8;
DI int lds_byte(int r, int c) { const int st = (r >> 4) * 2 + (c >> 5), rr = r & 15, cc = c & 31, ob = rr * 64 + cc * 2; return st * 1024 + (ob ^ (((ob >> 9) & 1) << 5)); }
DI void stage_rc(int b, int& R, int& C) { const int st = b / 1024, sb = b % 1024, swz = sb ^ (((sb >> 9) & 1) << 5); R = (st >> 1) * 16 + swz / 64; C = (st & 1) * 32 + (swz % 64) / 2; }

#define LAS __attribute__((address_space(3)))
constexpr int HTB = HALF * BK * 2;
DI void gemm_tile(const bf16_t* A, const bf16_t* Bt, int K  , int kt0, int nt  , int brow, int bcol, f32x4 (&acc)[2][2][4][2], LAS unsigned char* lds) {
    const int tid = TID(), wid = __builtin_amdgcn_readfirstlane(tid >> 6), lane = tid & 63, wr = wid >> 2, wc = wid & 3, fr = lane & 15, fq = lane >> 4;
    unsigned voff[2];
#pragma unroll
    for (int i = 0; i < 2; ++i) { int R, C; stage_rc(tid * 16 + i * 8192, R, C); voff[i] = (unsigned)(R * K + C) * 2u; }
    const size_t kstep = (size_t)(BK * 2), hstep = (size_t)HALF * K * 2;
    const unsigned ldsw = (unsigned)wid * 1024u;
    const int aoff = lds_byte(wr * 64 + fr, fq * 8), boff = lds_byte(wc * 32 + fr, fq * 8);
#define SA(b, h) (((b) * 2 + (h)) * HTB)
#define SB(b, h) ((4 + (b) * 2 + (h)) * HTB)
#define STAGE(bufoff, gbase) do { _Pragma("unroll") for (int _i = 0; _i < 2; ++_i) \
        __builtin_amdgcn_global_load_lds((const unsigned*)((const char*)(gbase) + voff[_i]), (LAS unsigned*)(lds + (bufoff) + ldsw + _i * 8192), 16, 0, 0); } while (0)
#define LDA(dst, b, h) do { _Pragma("unroll") for (int m = 0; m < 4; ++m) _Pragma("unroll") for (int k = 0; k < 2; ++k) dst[m][k] = *(const LAS bf16x8*)(lds + SA(b, h) + aoff + m * 2048 + k * 1024); } while (0)
#define LDB(dst, b, h) do { _Pragma("unroll") for (int n = 0; n < 2; ++n) _Pragma("unroll") for (int k = 0; k < 2; ++k) dst[n][k] = *(const LAS bf16x8*)(lds + SB(b, h) + boff + n * 2048 + k * 1024); } while (0)
#define MMA(ai, bj, At_, Bt_) do { __builtin_amdgcn_s_setprio(1); _Pragma("unroll") for (int m = 0; m < 4; ++m) _Pragma("unroll") for (int n = 0; n < 2; ++n) _Pragma("unroll") for (int k = 0; k < 2; ++k) \
        acc[ai][bj][m][n] = __builtin_amdgcn_mfma_f32_16x16x32_bf16(Bt_[n][k], At_[m][k], acc[ai][bj][m][n], 0, 0, 0); __builtin_amdgcn_s_setprio(0); } while (0)
#define WAIT_V(n) asm volatile("s_waitcnt vmcnt(" #n ")" ::: "memory")
#define WAIT_L(n) asm volatile("s_waitcnt lgkmcnt(" #n ")" ::: "memory")
#define BAR __builtin_amdgcn_s_barrier()
#define SCHED __builtin_amdgcn_sched_barrier(0)
#pragma unroll
    for (int a = 0; a < 2; ++a)
#pragma unroll
        for (int b = 0; b < 2; ++b)
#pragma unroll
            for (int m = 0; m < 4; ++m)
#pragma unroll
                for (int n = 0; n < 2; ++n) acc[a][b][m][n] = (f32x4){0.f, 0.f, 0.f, 0.f};
    bf16x8 At[4][2], B0[2][2], B1[2][2];
    const char* cA = (const char*)A + (size_t)brow * K * 2 + (size_t)kt0 * BK * 2; const char* cB = (const char*)Bt + (size_t)bcol * K * 2 + (size_t)kt0 * BK * 2;
    STAGE(SB(0, 0), cB); STAGE(SB(0, 1), cB + hstep); STAGE(SA(0, 0), cA); STAGE(SA(0, 1), cA + hstep);
    if (wr == 1) BAR;
    WAIT_V(2); BAR;
    STAGE(SB(1, 0), cB + kstep); STAGE(SA(1, 0), cA + kstep); STAGE(SB(1, 1), cB + hstep + kstep);
    WAIT_V(6); BAR;
    for (int t = 0; t < nt; t += 2) {
        const bool lastit = (t == nt - 2);
        const char* a1 = cA + (size_t)(t + 1) * kstep;
        const char* a2 = lastit ? cA : cA + (size_t)(t + 2) * kstep; const char* b2 = lastit ? cB : cB + (size_t)(t + 2) * kstep;
        const char* a3 = a2 + kstep; const char* b3 = b2 + kstep;
        LDB(B0, 0, 0); LDB(B1, 0, 1); SCHED; LDA(At, 0, 0); STAGE(SA(1, 1), a1 + hstep);
        WAIT_V(8); WAIT_L(0); BAR; MMA(0, 0, At, B0); MMA(0, 1, At, B1); BAR; SCHED;
        LDA(At, 0, 1); STAGE(SB(0, 0), b2); STAGE(SB(0, 1), b2 + hstep); STAGE(SA(0, 0), a2);
        WAIT_V(8); WAIT_L(0); BAR; MMA(1, 0, At, B0); MMA(1, 1, At, B1); BAR; SCHED;
        LDB(B0, 1, 0); LDB(B1, 1, 1); SCHED; LDA(At, 1, 0); STAGE(SA(0, 1), a2 + hstep);
        WAIT_V(8); WAIT_L(0); BAR; MMA(0, 0, At, B0); MMA(0, 1, At, B1); BAR; SCHED;
        LDA(At, 1, 1); STAGE(SB(1, 0), b3); STAGE(SB(1, 1), b3 + hstep); STAGE(SA(1, 0), a3);
        WAIT_V(8); WAIT_L(0); BAR; MMA(1, 0, At, B0); MMA(1, 1, At, B1); BAR; SCHED;
    }
    WAIT_V(0);
    if (wr == 0) BAR;
    BAR;
}

DI void tile_order(int L, int nM, int nN, int& pm, int& pn) {
    const int nwg = nM * nN; int wgid = L;
    { const int q = nwg / NXCD, r = nwg % NXCD, xcd = wgid % NXCD, off = wgid / NXCD; wgid = (xcd < r ? xcd * (q + 1) : r * (q + 1) + (xcd - r) * q) + off; }
    const int nig = WGM * nN, gid = wgid / nig, fm = gid * WGM, gsz = (nM - fm) < WGM ? (nM - fm) : WGM;
    pm = fm + ((wgid % nig) % gsz); pn = (wgid % nig) / gsz;
}

struct EpiSwiglu {
    bf16_t* hid;
    DI void operator()(f32x4 (&acc)[2][2][4][2], int pm, int pn, int sl, char* smem) const {
        const int wid = TID() >> 6, lane = TID() & 63, wr = wid >> 2, wc = wid & 3, fr = lane & 15, fq = lane >> 4;
#pragma unroll
        for (int ai = 0; ai < 2; ++ai)
#pragma unroll
            for (int m = 0; m < 4; ++m) {
                const int row = pm * BM + ai * HALF + wr * 64 + m * 16 + fr;
#pragma unroll
                for (int n = 0; n < 2; ++n) {
                    const f32x4 a = acc[ai][0][m][n], b = acc[ai][1][m][n];
                    u32x2 w; w[0] = pk2(silu_f(a[0]) * b[0], silu_f(a[1]) * b[1]); w[1] = pk2(silu_f(a[2]) * b[2], silu_f(a[3]) * b[3]);
                    *(u32x2*)(hid + (size_t)row * DFF + pn * 128 + wc * 32 + n * 16 + fq * 4) = w;
                }
            }
    }
};
struct EpiResid {
    _Float16* h16; const float* gate; float* dctx; float gs;
    DI void operator()(f32x4 (&acc)[2][2][4][2], int pm, int pn, int sl, char* smem) const {
        const int wid = TID() >> 6, lane = TID() & 63, wr = wid >> 2, wc = wid & 3, fr = lane & 15, fq = lane >> 4;
        const int row0 = pm * BM; const bool islat = row0 < NLAT;
        _Float16* out = h16 + (size_t)(row0 + wr * 64 + fr) * D + pn * BM + wc * 32 + fq * 4;
        const float* gt = gate + (size_t)(islat ? row0 / SEQ : 16) * MODW + pn * BM + wc * 32 + fq * 4;
        f32x4 gv[2][2];
#pragma unroll
        for (int bj = 0; bj < 2; ++bj)
#pragma unroll
            for (int n = 0; n < 2; ++n) gv[bj][n] = *(const f32x4*)(gt + bj * HALF + n * 16) * gs;
        if (sl >= 0) {
            float* po = dctx + ((size_t)sl * NCTX + (row0 - NLAT) + wr * 64 + fr) * D + pn * BM + wc * 32 + fq * 4;
#pragma unroll
            for (int ai = 0; ai < 2; ++ai)
#pragma unroll
                for (int m = 0; m < 4; ++m)
#pragma unroll
                    for (int bj = 0; bj < 2; ++bj)
#pragma unroll
                        for (int n = 0; n < 2; ++n) *(f32x4*)(po + (size_t)(ai * HALF + m * 16) * D + bj * HALF + n * 16) = gv[bj][n] * acc[ai][bj][m][n];
            return;
        }
        h16x4 hv[2][4][2][2];
#pragma unroll
        for (int ai = 0; ai < 2; ++ai)
#pragma unroll
            for (int m = 0; m < 4; ++m)
#pragma unroll
                for (int bj = 0; bj < 2; ++bj)
#pragma unroll
                    for (int n = 0; n < 2; ++n) hv[ai][m][bj][n] = *(const h16x4*)(out + (size_t)(ai * HALF + m * 16) * D + bj * HALF + n * 16);
#pragma unroll
        for (int ai = 0; ai < 2; ++ai)
#pragma unroll
            for (int m = 0; m < 4; ++m)
#pragma unroll
                for (int bj = 0; bj < 2; ++bj)
#pragma unroll
                    for (int n = 0; n < 2; ++n) {
                        const f32x4 v = __builtin_convertvector(hv[ai][m][bj][n], f32x4) + gv[bj][n] * acc[ai][bj][m][n];
                        *(h16x4*)(out + (size_t)(ai * HALF + m * 16) * D + bj * HALF + n * 16) = __builtin_convertvector(v, h16x4);
                    }
    }
};
constexpr float SC_A = 0.125f * 1.4426950408889634f, SC_C = 0.17677669529663687f * 1.4426950408889634f;
constexpr int TS = 260;
struct EpiProj {
    const Params* pp; int l;
    DI void operator()(f32x4 (&acc)[2][2][4][2], int pm, int pn, int sl, char* smem) const {
        const Params& p = *pp;
        LAS float* T = (LAS float*)smem;
        const int tid = TID(), wid = tid >> 6, lane = tid & 63, wr = wid >> 2, wc = wid & 3, fr = lane & 15, fq = lane >> 4;
#pragma unroll
        for (int ai = 0; ai < 2; ++ai) {
            lds_barrier();
#pragma unroll
            for (int bj = 0; bj < 2; ++bj)
#pragma unroll
                for (int m = 0; m < 4; ++m)
#pragma unroll
                    for (int n = 0; n < 2; ++n) *(LAS f32x4*)(T + (wr * 64 + m * 16 + fr) * TS + bj * HALF + wc * 32 + n * 16 + fq * 4) = acc[ai][bj][m][n];
            lds_barrier();
            const int rl = tid & 127, seg = tid >> 7, grow = pm * BM + ai * HALF + rl;
            const bool islat = grow < NLAT;
            const int b = islat ? grow / SEQ : (grow - NLAT) / CTX;
            const int pos = islat ? grow % SEQ : SEQ + (grow - NLAT) % CTX;
            const LAS float* xr = T + rl * TS + seg * 64;
            if (pn >= 7 && seg >= 2) continue;
#define LD8(dstv, off) { const f32x4 _a = *(const LAS f32x4*)(xr + (off)), _b = *(const LAS f32x4*)(xr + (off) + 4); dstv[0] = _a[0]; dstv[1] = _a[1]; dstv[2] = _a[2]; dstv[3] = _a[3]; dstv[4] = _b[0]; dstv[5] = _b[1]; dstv[6] = _b[2]; dstv[7] = _b[3]; }
            if (pn == 0 || (pn == 2 && seg < 2)) {
                const float* g = (pn == 0 ? p.g_q_a : p.g_k_a) + l * 64;
                bf16_t* dst = pn == 0 ? p.QA + ((size_t)(b * 4 + seg) * KEYS + pos) * 64 : p.KA + ((size_t)(b * 2 + seg) * KEYS + pos) * 64;
                float ss = 0.f;
#pragma unroll
                for (int i = 0; i < 16; ++i) { const f32x4 v = *(const LAS f32x4*)(xr + 4 * i); ss += v[0] * v[0] + v[1] * v[1] + v[2] * v[2] + v[3] * v[3]; }
                const float rstd = rsqrtf(ss * (1.f / 64.f) + EPS);
                const float* rp = p.ropeA + (size_t)(islat ? pos : 0) * 64;
#pragma unroll
                for (int i0 = 0; i0 < 32; i0 += 8) {
                    float xa[8], xb[8], o1[8], o2[8];
                    LD8(xa, i0); LD8(xb, i0 + 32);
#pragma unroll
                    for (int i = 0; i < 8; i += 2) {
                        f32x4 cssn = {1.f, 0.f, 1.f, 0.f};
                        if (islat) cssn = *(const f32x4*)(rp + (i0 + i) * 2);
#pragma unroll
                        for (int e = 0; e < 2; ++e) {
                            const float a = xa[i + e] * rstd * g[i0 + i + e], bb = xb[i + e] * rstd * g[i0 + i + e + 32];
                            o1[i + e] = a * cssn[2 * e] - bb * cssn[2 * e + 1]; o2[i + e] = a * cssn[2 * e + 1] + bb * cssn[2 * e];
                        }
                    }
                    const float qs = pn == 0 ? SC_A : 1.f;
                    u32x4 w1, w2;
#pragma unroll
                    for (int i = 0; i < 4; ++i) { w1[i] = pk2(o1[2 * i] * qs, o1[2 * i + 1] * qs); w2[i] = pk2(o2[2 * i] * qs, o2[2 * i + 1] * qs); }
                    *(u32x4*)(dst + i0) = w1; *(u32x4*)(dst + 32 + i0) = w2;
                }
            } else if (pn == 1 || pn == 3) {
                bf16_t* base = (pn == 1 ? p.QC : p.KC);
                const float* rp = p.ropeC + (size_t)(islat ? pos : 0) * 32;
#pragma unroll
                for (int mp = 0; mp < 2; ++mp) {
                    bf16_t* dst = base + ((size_t)(b * 4 + seg) * KEYS + pos) * 64 + mp * 32;
                    float k2 = 0.f;
#pragma unroll
                    for (int i0 = 0; i0 < 16; i0 += 8) {
                        float xa[8], xb[8], o1[8], o2[8];
                        LD8(xa, mp * 32 + i0); LD8(xb, mp * 32 + i0 + 16);
#pragma unroll
                        for (int i = 0; i < 8; ++i) k2 += xa[i] * xa[i] + xb[i] * xb[i];
#pragma unroll
                        for (int i = 0; i < 8; i += 2) {
                            f32x4 cssn = {1.f, 0.f, 1.f, 0.f};
                            if (islat) cssn = *(const f32x4*)(rp + (i0 + i) * 2);
#pragma unroll
                            for (int e = 0; e < 2; ++e) {
                                const float a = xa[i + e], bb = xb[i + e];
                                o1[i + e] = a * cssn[2 * e] - bb * cssn[2 * e + 1]; o2[i + e] = a * cssn[2 * e + 1] + bb * cssn[2 * e];
                            }
                        }
                        const float qs = pn == 1 ? SC_C : 1.f;
                        u32x4 w1, w2;
#pragma unroll
                        for (int i = 0; i < 4; ++i) { w1[i] = pk2(o1[2 * i] * qs, o1[2 * i + 1] * qs); w2[i] = pk2(o2[2 * i] * qs, o2[2 * i + 1] * qs); }
                        *(u32x4*)(dst + i0) = w1; *(u32x4*)(dst + 16 + i0) = w2;
                    }
                    if (pn == 3) {
#pragma unroll
                        for (int o = 32; o >= 1; o >>= 1) k2 = fmaxf(k2, __shfl_xor(k2, o));
                        if (lane == 0) atomicMax(p.kmaxC + (size_t)l * NB * 8 + (b * 4 + seg) * 2 + mp, __float_as_uint(k2));
                    }
                }
            } else if (pn == 2 || pn == 4) {
                bf16_t* dst = pn == 2 ? p.VtA + ((size_t)(b * 2 + (seg - 2)) * 64) * KEYS + pos : p.VtC + ((size_t)(b * 4 + seg) * 64) * KEYS + pos;
#pragma unroll
                for (int d0 = 0; d0 < 64; d0 += 8) {
                    float xa[8]; LD8(xa, d0);
#pragma unroll
                    for (int d = 0; d < 8; ++d) dst[(size_t)(d0 + d) * KEYS] = f2bf(xa[d]);
                }
            } else if (pn == 5) {
                bf16_t* dst = p.U + (size_t)grow * 256 + seg * 64;
#pragma unroll
                for (int i0 = 0; i0 < 64; i0 += 8) {
                    float xa[8]; LD8(xa, i0);
                    u32x4 w;
#pragma unroll
                    for (int i = 0; i < 4; ++i) w[i] = pk2(gelu_f(xa[2 * i]), gelu_f(xa[2 * i + 1]));
                    *(u32x4*)(dst + i0) = w;
                }
            } else if (pn == 6) {
                float ss = 0.f;
#pragma unroll
                for (int i0 = 0; i0 < 64; i0 += 8) {
                    float xa[8]; LD8(xa, i0);
#pragma unroll
                    for (int i = 0; i < 8; ++i) { const float gv = gelu_f(xa[i]); ss += gv * gv; }
                }
                T[rl * TS + 256 + seg] = ss;
                lds_barrier();
                const f32x4 pt = *(const LAS f32x4*)(T + rl * TS + 256);
                const float rstd = rsqrtf(((pt[0] + pt[1]) + (pt[2] + pt[3])) * (1.f / 256.f) + EPS);
                const float* g = p.g_v_b + l * 256 + seg * 64;
                bf16_t* dst = p.VN + (size_t)grow * 256 + seg * 64;
#pragma unroll
                for (int i0 = 0; i0 < 64; i0 += 8) {
                    float xa[8]; LD8(xa, i0);
                    u32x4 w;
#pragma unroll
                    for (int i = 0; i < 4; ++i) w[i] = pk2(gelu_f(xa[2 * i]) * rstd * g[i0 + 2 * i], gelu_f(xa[2 * i + 1]) * rstd * g[i0 + 2 * i + 1]);
                    *(u32x4*)(dst + i0) = w;
                }
            } else {
                bf16_t* dst = p.Y + (size_t)grow * 256 + (pn - 7) * 128 + seg * 64;
#pragma unroll
                for (int i0 = 0; i0 < 64; i0 += 8) {
                    float xa[8], ga[8]; LD8(xa, i0); LD8(ga, 128 + i0);
                    u32x4 w;
#pragma unroll
                    for (int i = 0; i < 4; ++i) w[i] = pk2(xa[2 * i] * sigmoid_f(ga[2 * i]), xa[2 * i + 1] * sigmoid_f(ga[2 * i + 1]));
                    *(u32x4*)(dst + i0) = w;
                }
            }
#undef LD8
        }
        lds_barrier();
    }
};

struct UnitList {
    int nM, nN, nwg, nsp, ntk, split, kvonly;
    DI void init(int M, int N, int K, bool splitctx, bool kvonlyctx) {
        nN = N / BM; ntk = K / BK; split = splitctx; kvonly = kvonlyctx;
        nM = ((splitctx || kvonlyctx) ? NLAT : M) / BM; nwg = nM * nN; nsp = splitctx ? (NCTX / BM) * nN * 4 : (kvonlyctx ? (NCTX / BM) * 3 : 0);
    }
    DI bool get(int L, int& pm, int& pn, int& sl, int& kt0, int& nt) const {
        if (L >= nwg + nsp) return false;
        sl = -1; kt0 = 0; nt = ntk;
        if (L < nwg) tile_order(L, nM, nN, pm, pn);
        else if (kvonly) { const int c = L - nwg; pm = NLAT / BM + c / 3; pn = 2 + c % 3; }
        else {
            const int c = L - nwg, tile = c >> 2; sl = c & 3; pm = NLAT / BM + tile / nN; pn = tile % nN;
            const int q = ntk / 8 * 2, rem2 = (ntk - 4 * q) / 2;
            kt0 = sl * q + 2 * (sl < rem2 ? sl : rem2); nt = q + (sl < rem2 ? 2 : 0);
        }
        return true;
    }
};

template <class Epi>
DI void phase_gemm(const bf16_t* A, const bf16_t* Bt, int M, int N, int K, const Epi& epi, char* smem, bool splitctx = false, bool kvonlyctx = false) {
    UnitList ul; ul.init(M, N, K, splitctx, kvonlyctx);
    for (int L = blockIdx.x;; L += gridDim.x) {
        int pm, pn, sl, kt0, nt;
        if (!ul.get(L, pm, pn, sl, kt0, nt)) break;
        f32x4 acc[2][2][4][2];
        gemm_tile(A, Bt, K, kt0, nt, pm * BM, pn * BM, acc, (LAS unsigned char*)smem);
        epi(acc, pm, pn, sl, smem);
    }
}

template <class Epi>
DI void phase_gemm_stream(const bf16_t* A, const bf16_t* Bt, int M, int N, int K, const Epi& epi, char* smem, bool splitctx = false) {
    UnitList ul; ul.init(M, N, K, splitctx, false);
    LAS unsigned char* lds = (LAS unsigned char*)smem;
    const int tid = TID(), wid = __builtin_amdgcn_readfirstlane(tid >> 6), lane = tid & 63, wr = wid >> 2, wc = wid & 3, fr = lane & 15, fq = lane >> 4;
    unsigned voff[2];
#pragma unroll
    for (int i = 0; i < 2; ++i) { int R, C; stage_rc(tid * 16 + i * 8192, R, C); voff[i] = (unsigned)(R * K + C) * 2u; }
    const size_t kstep = (size_t)(BK * 2), hstep = (size_t)HALF * K * 2, tstep = 2 * hstep;
    const unsigned ldsw = (unsigned)wid * 1024u;
    const int aoff = lds_byte(wr * 64 + fr, fq * 8), boff = lds_byte(wc * 32 + fr, fq * 8);
    int L = blockIdx.x, pm, pn, sl, kt0, nt;
    if (!ul.get(L, pm, pn, sl, kt0, nt)) return;
    f32x4 acc[2][2][4][2];
#pragma unroll
    for (int a = 0; a < 2; ++a)
#pragma unroll
        for (int b = 0; b < 2; ++b)
#pragma unroll
            for (int m = 0; m < 4; ++m)
#pragma unroll
                for (int n = 0; n < 2; ++n) acc[a][b][m][n] = (f32x4){0.f, 0.f, 0.f, 0.f};
    bf16x8 At[4][2], B0[2][2], B1[2][2];
    const char* cA = (const char*)A + (size_t)pm * tstep + (size_t)kt0 * kstep; const char* cB = (const char*)Bt + (size_t)pn * tstep + (size_t)kt0 * kstep;
    STAGE(SB(0, 0), cB); STAGE(SB(0, 1), cB + hstep); STAGE(SA(0, 0), cA); STAGE(SA(0, 1), cA + hstep);
    if (wr == 1) BAR;
    WAIT_V(2); BAR;
    STAGE(SB(1, 0), cB + kstep); STAGE(SA(1, 0), cA + kstep); STAGE(SB(1, 1), cB + hstep + kstep);
    WAIT_V(6); BAR;
    for (;;) {
        int npm, npn, nsl, nkt0, nnt;
        const bool has_next = ul.get(L + gridDim.x, npm, npn, nsl, nkt0, nnt);
        const char* nA = has_next ? (const char*)A + (size_t)npm * tstep + (size_t)nkt0 * kstep : cA; const char* nB = has_next ? (const char*)Bt + (size_t)npn * tstep + (size_t)nkt0 * kstep : cB;
        for (int t = 0; t < nt; t += 2) {
            const bool lastit = (t == nt - 2);
            const char* a1 = cA + (size_t)(t + 1) * kstep;
            const char* a2 = lastit ? nA : cA + (size_t)(t + 2) * kstep; const char* b2 = lastit ? nB : cB + (size_t)(t + 2) * kstep;
            const char* a3 = a2 + kstep; const char* b3 = b2 + kstep;
            LDB(B0, 0, 0); LDB(B1, 0, 1); SCHED; LDA(At, 0, 0); STAGE(SA(1, 1), a1 + hstep);
            WAIT_V(8); WAIT_L(0); BAR; MMA(0, 0, At, B0); MMA(0, 1, At, B1); BAR; SCHED;
            LDA(At, 0, 1); STAGE(SB(0, 0), b2); STAGE(SB(0, 1), b2 + hstep); STAGE(SA(0, 0), a2);
            WAIT_V(8); WAIT_L(0); BAR; MMA(1, 0, At, B0); MMA(1, 1, At, B1); BAR; SCHED;
            LDB(B0, 1, 0); LDB(B1, 1, 1); SCHED; LDA(At, 1, 0); STAGE(SA(0, 1), a2 + hstep);
            WAIT_V(8); WAIT_L(0); BAR; MMA(0, 0, At, B0); MMA(0, 1, At, B1); BAR; SCHED;
            LDA(At, 1, 1); STAGE(SB(1, 0), b3); STAGE(SB(1, 1), b3 + hstep); STAGE(SA(1, 0), a3);
            WAIT_V(8); WAIT_L(0); BAR; MMA(1, 0, At, B0); MMA(1, 1, At, B1); BAR; SCHED;
        }
        if (wr == 0) BAR;
        epi(acc, pm, pn, sl, smem);
        if (!has_next) break;
#pragma unroll
        for (int a = 0; a < 2; ++a)
#pragma unroll
            for (int b = 0; b < 2; ++b)
#pragma unroll
                for (int m = 0; m < 4; ++m)
#pragma unroll
                    for (int n = 0; n < 2; ++n) acc[a][b][m][n] = (f32x4){0.f, 0.f, 0.f, 0.f};
        L += gridDim.x; pm = npm; pn = npn; sl = nsl; kt0 = nkt0; nt = nnt; cA = nA; cB = nB;
        if (wr == 1) BAR;
    }
    WAIT_V(0);
    BAR;
}

constexpr int VROW = 144;
template <bool ISC, bool FIXM>
DI void attn2_core(const bf16_t* Q0, const bf16_t* Q1, const bf16_t* Kg, const bf16_t* Vt, int qpos0, int key_lo, int nkt, float sc, float mfix0, float mfix1, f32x16 (&O)[2][2], char* smem) {
    constexpr int KROW = 144, KBUF = 64 * KROW, VBUF = 64 * VROW, NSLOT = 4, NQ = ISC ? 1 : 2;
    LAS char* lds = (LAS char*)smem;
    const int tid = TID(), lane = tid & 63, wid = tid >> 6, r = lane & 31, h = lane >> 5;
    bf16x8 qf[NQ][4];
#pragma unroll
    for (int c = 0; c < NQ; ++c)
#pragma unroll
        for (int ks = 0; ks < 4; ++ks) qf[c][ks] = *(const bf16x8*)((c == 0 ? Q0 : Q1) + (size_t)(qpos0 + wid * 32 + r) * 64 + ks * 16 + 8 * h);
#pragma unroll
    for (int c = 0; c < 2; ++c)
#pragma unroll
        for (int i = 0; i < 16; ++i) { O[c][0][i] = 0.f; O[c][1][i] = 0.f; }
    float m_run[2] = {FIXM ? mfix0 : -1e30f, FIXM ? mfix1 : -1e30f}, l_run[2] = {0.f, 0.f};
    const int kkey = tid >> 3, kch = tid & 7;
    const int kst = kkey * KROW + kch * 16, vst = NSLOT * KBUF + kkey * VROW + kch * 16;
    const int krd = r * KROW + 16 * h, vrd = NSLOT * KBUF + r * VROW + 8 * h;
    const bf16_t* kg = Kg + (size_t)(key_lo + kkey) * 64 + kch * 8;
    const bf16_t* vg = Vt + (size_t)kkey * KEYS + key_lo + kch * 8;
    u32x4 kreg, vreg;
    bf16x8 kf[4]; u32x2 vf[2][2][2];
    auto gload = [&](int t) { kreg = *(const u32x4*)(kg + (size_t)t * 64 * 64); vreg = *(const u32x4*)(vg + t * 64); };
    auto lstore = [&](int slot) { *(LAS u32x4*)(lds + slot * KBUF + kst) = kreg; *(LAS u32x4*)(lds + slot * VBUF + vst) = vreg; };
    auto ldk = [&](int slot, int kk) {
        const LAS char* kb = lds + slot * KBUF + krd + kk * 32 * KROW;
#pragma unroll
        for (int ks = 0; ks < 4; ++ks) kf[ks] = *(const LAS bf16x8*)(kb + ks * 32);
    };
    auto ldv = [&](int slot, int kk) {
        const LAS char* vb = lds + slot * VBUF + vrd + kk * 64;
#pragma unroll
        for (int st = 0; st < 2; ++st)
#pragma unroll
            for (int dt = 0; dt < 2; ++dt) { const LAS char* vp = vb + dt * 32 * VROW + st * 32; vf[st][dt][0] = *(const LAS u32x2*)vp; vf[st][dt][1] = *(const LAS u32x2*)(vp + 16); }
    };
#define SOFT_PV(c) do { \
        if (!FIXM) { \
        float mx = s##c[0]; \
        _Pragma("unroll") for (int i = 1; i < 16; ++i) mx = __ocml_fmax_f32(mx, s##c[i]); \
        mx = __ocml_fmax_f32(mx, __shfl_xor(mx, 32)); \
        const float m_new = __ocml_fmax_f32(m_run[c], mx); \
        if (__builtin_amdgcn_ballot_w64(m_new > m_run[c]) != 0ull) { \
            const float alpha = __builtin_amdgcn_exp2f(m_run[c] - m_new); \
            m_run[c] = m_new; l_run[c] *= alpha; \
            _Pragma("unroll") for (int i = 0; i < 16; ++i) { O[c][0][i] *= alpha; O[c][1][i] *= alpha; } \
        } } \
        float ps = 0.f; \
        _Pragma("unroll") for (int i = 0; i < 16; ++i) { s##c[i] = __builtin_amdgcn_exp2f(FIXM ? s##c[i] : s##c[i] - m_run[c]); ps += s##c[i]; } \
        l_run[c] += ps; \
        _Pragma("unroll") for (int st = 0; st < 2; ++st) { \
            u32x4 pw; \
            _Pragma("unroll") for (int i = 0; i < 4; ++i) pw[i] = pk2(s##c[8 * st + 2 * i], s##c[8 * st + 2 * i + 1]); \
            const bf16x8 pf = __builtin_bit_cast(bf16x8, pw); \
            _Pragma("unroll") for (int dt = 0; dt < 2; ++dt) { \
                u32x4 vw = {vf[st][dt][0][0], vf[st][dt][0][1], vf[st][dt][1][0], vf[st][dt][1][1]}; \
                O[c][dt] = __builtin_amdgcn_mfma_f32_32x32x16_bf16(__builtin_bit_cast(bf16x8, vw), pf, O[c][dt], 0, 0, 0); \
            } \
        } } while (0)
    lds_barrier();
    gload(0); lstore(0);
    if (nkt > 1) { gload(1); lstore(1); }
    if (nkt > 2) gload(2);
    lds_barrier();
    ldk(0, 0);
    for (int t = 0; t < nkt; ++t) {
        const int cur = t & 3, nxt = (t + 1) & 3;
        if (t + 2 < nkt) lstore((t + 2) & 3);
        if (t + 3 < nkt) gload(t + 3);
#pragma unroll
        for (int kk = 0; kk < 2; ++kk) {
            f32x16 s0, s1;
#pragma unroll
            for (int i = 0; i < 16; ++i) { s0[i] = 0.f; s1[i] = 0.f; }
            if (ISC) {
                s0 = __builtin_amdgcn_mfma_f32_32x32x16_bf16(kf[0], qf[0][0], s0, 0, 0, 0); s1 = __builtin_amdgcn_mfma_f32_32x32x16_bf16(kf[2], qf[0][2], s1, 0, 0, 0);
                s0 = __builtin_amdgcn_mfma_f32_32x32x16_bf16(kf[1], qf[0][1], s0, 0, 0, 0); s1 = __builtin_amdgcn_mfma_f32_32x32x16_bf16(kf[3], qf[0][3], s1, 0, 0, 0);
            } else {
#pragma unroll
                for (int ks = 0; ks < 4; ++ks) s0 = __builtin_amdgcn_mfma_f32_32x32x16_bf16(kf[ks], qf[0][ks], s0, 0, 0, 0);
#pragma unroll
                for (int ks = 0; ks < 4; ++ks) s1 = __builtin_amdgcn_mfma_f32_32x32x16_bf16(kf[ks], qf[NQ - 1][ks], s1, 0, 0, 0);
            }
            __builtin_amdgcn_sched_barrier(0);
            ldv(cur, kk);
            if (kk == 0) ldk(cur, 1); else if (t + 1 < nkt) ldk(nxt, 0);
            SOFT_PV(0);
            SOFT_PV(1);
        }
        lds_barrier();
    }
#undef SOFT_PV
#pragma unroll
    for (int c = 0; c < 2; ++c) {
        const float lt = l_run[c] + __shfl_xor(l_run[c], 32);
        const float inv = 1.f / lt;
#pragma unroll
        for (int i = 0; i < 16; ++i) { O[c][0][i] *= inv; O[c][1][i] *= inv; }
    }
}

DI void store_OT(const f32x16 (&O)[2], bf16_t* dst  , int h) {
#pragma unroll
    for (int dt = 0; dt < 2; ++dt)
#pragma unroll
        for (int gq = 0; gq < 4; ++gq) {
            u32x2 w; w[0] = pk2(O[dt][4 * gq], O[dt][4 * gq + 1]); w[1] = pk2(O[dt][4 * gq + 2], O[dt][4 * gq + 3]);
            *(u32x2*)(dst + dt * 32 + 8 * gq + 4 * h) = w;
        }
}

DI void attn_unit(const Params& p, int l, int idx, int qb, bool isC, char* smem) {
    const int lane = TID() & 63, wid = TID() >> 6, r = lane & 31, h = lane >> 5;
    const int qpos0 = qb < 8 ? qb * 256 : SEQ, key_lo = qb < 8 ? 0 : SEQ, nkt = qb < 8 ? KEYS / 64 : CTX / 64;
    const int qpos = qpos0 + wid * 32 + r;
    f32x16 O[2][2];
    if (!isC) {
        const int b = idx >> 1, kvh = idx & 1;
        const size_t grow = qpos < SEQ ? (size_t)b * SEQ + qpos : (size_t)NLAT + b * CTX + (qpos - SEQ);
        const bf16_t* q0 = p.QA + (size_t)(b * 4 + 2 * kvh) * KEYS * 64;
        const float gq = fabsf(p.g_q_a[l * 64 + lane]), gk = fabsf(p.g_k_a[l * 64 + lane]);
        float mq = gq, mk = gk;
#pragma unroll
        for (int o = 32; o >= 1; o >>= 1) { mq = fmaxf(mq, __shfl_xor(mq, o)); mk = fmaxf(mk, __shfl_xor(mk, o)); }
        const float sc = 1.f, mfix = 64.f * 1.02f * mq * mk * SC_A;
        if (mfix < 60.f)
            attn2_core<false, true>(q0, q0 + (size_t)KEYS * 64, p.KA + (size_t)idx * KEYS * 64, p.VtA + (size_t)idx * 64 * KEYS, qpos0, key_lo, nkt, sc, mfix, mfix, O, smem);
        else
            attn2_core<false, false>(q0, q0 + (size_t)KEYS * 64, p.KA + (size_t)idx * KEYS * 64, p.VtA + (size_t)idx * 64 * KEYS, qpos0, key_lo, nkt, sc, 0.f, 0.f, O, smem);
        store_OT(O[0], p.cat + grow * D + (2 * kvh) * 64, h);
        store_OT(O[1], p.cat + grow * D + (2 * kvh + 1) * 64, h);
    } else {
        const int b = idx >> 2, head = idx & 3;
        const size_t grow = qpos < SEQ ? (size_t)b * SEQ + qpos : (size_t)NLAT + b * CTX + (qpos - SEQ);
        const bf16_t* qc = p.QC + (size_t)idx * KEYS * 64;
        const float scC = 1.f;
        float q2[2] = {0.f, 0.f};
#pragma unroll
        for (int c = 0; c < 2; ++c)
#pragma unroll
            for (int ks = 0; ks < 2; ++ks) {
                const u32x4 qv = *(const u32x4*)(qc + (size_t)qpos * 64 + (2 * c + ks) * 16 + 8 * h);
#pragma unroll
                for (int i = 0; i < 4; ++i) { const float a = bflo(qv[i]), bq = bfhi(qv[i]); q2[c] += a * a + bq * bq; }
            }
        q2[0] += __shfl_xor(q2[0], 32); q2[1] += __shfl_xor(q2[1], 32);
        const unsigned* km = p.kmaxC + (size_t)l * NB * 8 + idx * 2;
        const float mf0 = 1.03f * sqrtf(q2[0] * __uint_as_float(km[0])), mf1 = 1.03f * sqrtf(q2[1] * __uint_as_float(km[1]));
        if (__builtin_amdgcn_ballot_w64(mf0 < 60.f && mf1 < 60.f) == ~0ull)
            attn2_core<true, true>(qc, qc, p.KC + (size_t)idx * KEYS * 64, p.VtC + (size_t)idx * 64 * KEYS, qpos0, key_lo, nkt, scC, mf0, mf1, O, smem);
        else
            attn2_core<true, false>(qc, qc, p.KC + (size_t)idx * KEYS * 64, p.VtC + (size_t)idx * 64 * KEYS, qpos0, key_lo, nkt, scC, 0.f, 0.f, O, smem);
        const float lam_init = 0.8f - 0.6f * __expf(-0.3f * (float)l);
        const float* lp = p.lam_c + l * 128;
        const float d0 = wave_sum(lane < 32 ? lp[lane] * lp[32 + lane] : 0.f), d1 = wave_sum(lane < 32 ? lp[64 + lane] * lp[96 + lane] : 0.f);
        const float lam = __expf(d0) - __expf(d1) + lam_init;
        float ss = 0.f;
#pragma unroll
        for (int dt = 0; dt < 2; ++dt)
#pragma unroll
            for (int i = 0; i < 16; ++i) { const float v = O[0][dt][i] - lam * O[1][dt][i]; O[0][dt][i] = v; ss += v * v; }
        ss += __shfl_xor(ss, 32);
        const float rstd = rsqrtf(ss * (1.f / 64.f) + EPS) * (1.f - lam_init);
        const float* g = p.g_sub_c + l * 64;
#pragma unroll
        for (int dt = 0; dt < 2; ++dt)
#pragma unroll
            for (int i = 0; i < 16; ++i) O[0][dt][i] *= rstd * g[dt * 32 + 8 * (i >> 2) + 4 * h + (i & 3)];
        store_OT(O[0], p.cat + grow * D + 256 + head * 64, h);
    }
}

DI void gmlp_unit(const Params& p, int l, int uidx, char* smem) {
    const int g = uidx & 3, c = uidx >> 2, tid = TID(), lane = tid & 63, wid = tid >> 6, fr = lane & 15, fq = lane >> 4;
    LAS bf16_t* vT = (LAS bf16_t*)smem;
    constexpr int VS = 136;
    const int q = tid >> 2, d0 = (tid & 3) * 16;
    const bf16_t* src = p.VN + (size_t)(c * 128 + q) * 256 + g * 64 + d0;
    const bf16x8 a = *(const bf16x8*)src, bb = *(const bf16x8*)(src + 8);
    const bf16_t* wrow = p.Ws + ((size_t)(l * 4 + g) * 128 + wid * 16 + fr) * 128;
    bf16x8 af[4];
#pragma unroll
    for (int ks = 0; ks < 4; ++ks) af[ks] = *(const bf16x8*)(wrow + ks * 32 + fq * 8);
    const int prow = wid * 16 + fr; const size_t grow = (size_t)c * 128 + prow;
    const float bias = p.b_s_b[(l * 4 + g) * 128 + prow];
    u32x2 uu[4];
#pragma unroll
    for (int n = 0; n < 4; ++n) uu[n] = *(const u32x2*)(p.U + grow * 256 + g * 64 + n * 16 + fq * 4);
    lds_barrier();
#pragma unroll
    for (int j = 0; j < 8; ++j) { vT[(d0 + j) * VS + q] = (bf16_t)a[j]; vT[(d0 + 8 + j) * VS + q] = (bf16_t)bb[j]; }
    lds_barrier();
    f32x4 acc[4];
#pragma unroll
    for (int n = 0; n < 4; ++n) acc[n] = (f32x4){0.f, 0.f, 0.f, 0.f};
#pragma unroll
    for (int ks = 0; ks < 4; ++ks)
#pragma unroll
        for (int n = 0; n < 4; ++n) {
            const bf16x8 bfv = *(const LAS bf16x8*)(vT + (n * 16 + fr) * VS + ks * 32 + fq * 8);
            acc[n] = __builtin_amdgcn_mfma_f32_16x16x32_bf16(bfv, af[ks], acc[n], 0, 0, 0);
        }
#pragma unroll
    for (int n = 0; n < 4; ++n) {
        const int col = g * 64 + n * 16 + fq * 4;
        u32x2 w;
        w[0] = pk2(bflo(uu[n][0]) * (acc[n][0] + bias), bfhi(uu[n][0]) * (acc[n][1] + bias));
        w[1] = pk2(bflo(uu[n][1]) * (acc[n][2] + bias), bfhi(uu[n][1]) * (acc[n][3] + bias));
        *(u32x2*)(p.cat + grow * D + 512 + col) = w;
    }
}

DI void conv_unit(const Params& p, int l, int uidx, char* smem) {
    const int tid = TID(), lane = tid & 63, wid = tid >> 6;
    bf16_t* yin = (bf16_t*)smem;
    float* co = (float*)(smem + 94 * 256 * 2);
    const int row0 = uidx * 64;
    int s0, s1;
    if (row0 < NLAT) { s0 = (row0 / SEQ) * SEQ; s1 = s0 + SEQ; } else { s0 = NLAT + ((row0 - NLAT) / CTX) * CTX; s1 = s0 + CTX; }
    lds_barrier();
    {
        u32x4 v[6];
#pragma unroll
        for (int j = 0; j < 6; ++j) {
            const int i = tid + j * NTHR, rr = i >> 5, ch8 = (i & 31) * 8, gr = row0 - 15 + rr;
            v[j] = (u32x4){0, 0, 0, 0};
            if (i < 94 * 32 && gr >= s0 && gr < s1) v[j] = *(const u32x4*)(p.Y + (size_t)gr * 256 + ch8);
        }
#pragma unroll
        for (int j = 0; j < 6; ++j) {
            const int i = tid + j * NTHR, rr = i >> 5, ch8 = (i & 31) * 8;
            if (i < 94 * 32) *(u32x4*)(yin + rr * 256 + ch8) = v[j];
        }
    }
    lds_barrier();
    {
        const int ch = tid & 255, th = tid >> 8;
        float w[31];
#pragma unroll
        for (int k = 0; k < 31; ++k) w[k] = p.w_dw_d[(size_t)(l * 31 + k) * 256 + ch];
        const float bias = p.b_dw_d[l * 256 + ch];
        for (int i0 = th * 32; i0 < th * 32 + 32; i0 += 8) {
            float xw[38];
#pragma unroll
            for (int j = 0; j < 38; ++j) xw[j] = bf2f(yin[(i0 + j) * 256 + ch]);
#pragma unroll
            for (int o = 0; o < 8; ++o) {
                float a = bias;
#pragma unroll
                for (int k = 0; k < 31; ++k) a += w[k] * xw[o + k];
                co[(i0 + o) * 256 + ch] = a;
            }
        }
    }
    lds_barrier();
#pragma unroll
    for (int j = 0; j < 8; ++j) {
        const int tk = wid * 8 + j;
        const f32x4 v = *(const f32x4*)(co + tk * 256 + lane * 4);
        const float ss = wave_sum(v[0] * v[0] + v[1] * v[1] + v[2] * v[2] + v[3] * v[3]);
        const float rstd = rsqrtf(ss * (1.f / 256.f) + EPS);
        const f32x4 g = *(const f32x4*)(p.g_conv_d + l * 256 + lane * 4);
        u32x2 w; w[0] = pk2(silu_f(v[0] * rstd * g[0]), silu_f(v[1] * rstd * g[1])); w[1] = pk2(silu_f(v[2] * rstd * g[2]), silu_f(v[3] * rstd * g[3]));
        *(u32x2*)(p.cat + (size_t)(row0 + tk) * D + 768 + lane * 4) = w;
    }
}

DI void phase_mixers(const Params& p, int l, bool withctx, char* smem) {
    const int nCL = NB * 4 * 8, nAL = NB * 2 * 8, nCX = withctx ? NB * 4 : 0, nAX = withctx ? NB * 2 : 0;
    const int nG = (withctx ? NTOK : NLAT) / 128 * 4, nV = (withctx ? NTOK : NLAT) / 64;
    const int nAtt = nCL + nAL + nCX + nAX, total = nAtt + nG + nV;
    for (int u = blockIdx.x; u < total; u += gridDim.x) {
        asm volatile("" : "+s"(l));
        int r = u;
        if (r < nAtt) {
            int idx, qb; bool isC;
            if (r < nCL) { isC = true; const int w = r & 255, s = w >> 3; qb = s & 7; idx = (w & 7) + 8 * (s >> 3) + 32 * (r >> 8); }
            else if ((r -= nCL) < nAL) { isC = false; const int w = r & 255, s = w >> 3; qb = s & 7; idx = (w & 7) + 8 * (s >> 3) + 32 * (r >> 8); }
            else if ((r -= nAL) < nCX) { isC = true; idx = r; qb = 8; }
            else { r -= nCX; isC = false; idx = r; qb = 8; }
            if (isC) attn_unit(p, l, idx, qb, true, smem); else attn_unit(p, l, idx, qb, false, smem);
        } else if ((r -= nAtt) < nG) gmlp_unit(p, l, r, smem);
        else conv_unit(p, l, r - nG, smem);
    }
}

#define XB_TMO      128
#define XB_XCNT(j)  (256  + 64 * (j))
#define XB_XSUB(j)  (1280 + 64 * (j))
#define XB_XGEN(j)  (2304 + 64 * (j))
#define XB_TOP      3328
#define XB_TOPGEN   3392
#define XCD_BAR_WORDS 3456
#define XB_SPIN_CAP (1u << 22)
DI unsigned xb_ld(unsigned* p) { return __hip_atomic_load(p, __ATOMIC_RELAXED, __HIP_MEMORY_SCOPE_AGENT); }
DI unsigned xb_add(unsigned* p, unsigned v) { return __hip_atomic_fetch_add(p, v, __ATOMIC_RELAXED, __HIP_MEMORY_SCOPE_AGENT); }
DI unsigned xb_xcc_id() { return (unsigned)__builtin_amdgcn_s_getreg((3 << 11) | 20) & 0xFu; }
#define XB_SPIN(cond, bar) do { unsigned _sp = 0; while (cond) { __builtin_amdgcn_s_sleep(1); \
    if ((++_sp & 255u) == 0u) { if (xb_ld(&(bar)[XB_TMO])) break; if (_sp > XB_SPIN_CAP) { atomicAdd(&(bar)[XB_TMO], 1u); break; } } } } while (0)
DI void xcd_barrier_complete(unsigned* bar, unsigned x, unsigned& nloc, unsigned& nx) {
    const unsigned G = gridDim.x;
    unsigned sum, cnt, mine, sp = 0u;
    for (;;) {
        sum = 0u; cnt = 0u; mine = 0u;
#pragma unroll
        for (unsigned j = 0; j < 16; ++j) { const unsigned c = xb_ld(&bar[XB_XCNT(j)]); sum += c; cnt += (c > 0u) ? 1u : 0u; mine = (j == x) ? c : mine; }
        if (sum == G) break;
        __builtin_amdgcn_s_sleep(1);
        if ((++sp & 255u) == 0u) { if (xb_ld(&bar[XB_TMO])) break; if (sp > XB_SPIN_CAP) { atomicAdd(&bar[XB_TMO], 1u); break; } }
    }
    nloc = mine > 0u ? mine : 1u; nx = cnt > 0u ? cnt : 1u;
}
DI void xcd_barrier(unsigned* bar, volatile LAS unsigned* st) {
    asm volatile("s_waitcnt vmcnt(0)" ::: "memory");
    __syncthreads();
    if (__builtin_amdgcn_workitem_id_x() == 0) {
        __builtin_amdgcn_s_waitcnt(0);
        const unsigned x = xb_xcc_id();
        unsigned nloc = st[0], nx = st[1];
        if (nloc == 0u) { xcd_barrier_complete(bar, x, nloc, nx); st[0] = nloc; st[1] = nx; }
        const unsigned old = xb_add(&bar[XB_XSUB(x)], 1u);
        const unsigned gen = old / nloc;
        if (old + 1u == (gen + 1u) * nloc) {
            __builtin_amdgcn_fence(__ATOMIC_RELEASE, "agent");
            asm volatile("s_waitcnt vmcnt(0)" ::: "memory");
            const unsigned og = xb_add(&bar[XB_TOP], 1u);
            const unsigned tg = og / nx;
            if (og + 1u == (tg + 1u) * nx) xb_add(&bar[XB_TOPGEN], 1u);
            else XB_SPIN(xb_ld(&bar[XB_TOPGEN]) == tg, bar);
            __builtin_amdgcn_fence(__ATOMIC_ACQUIRE, "agent");
            xb_add(&bar[XB_XGEN(x)], 1u);
            asm volatile("s_waitcnt vmcnt(0)" ::: "memory");
        } else {
            XB_SPIN(xb_ld(&bar[XB_XGEN(x)]) == gen, bar);
            __builtin_amdgcn_fence(__ATOMIC_ACQUIRE, "agent");
            asm volatile("s_waitcnt vmcnt(0)" ::: "memory");
        }
    }
    __syncthreads();
}

constexpr int PH_PER_LAYER = 10, N_PHASES = 1 + DEPTH * PH_PER_LAYER + 1;

typedef const __attribute__((address_space(4))) Params* KParamsPtr;
__global__ void __launch_bounds__(NTHR) mega(Params p_unused, int ph_lo, int ph_hi) {
    extern __shared__ __attribute__((aligned(16))) char smem[];
    volatile LAS unsigned* xst = (volatile LAS unsigned*)(smem + LDS_BYTES - 16);
    if (ph_hi - ph_lo > 1) {
        if (__builtin_amdgcn_workitem_id_x() == 0) {
            xst[0] = 0u; xst[1] = 0u;
            KParamsPtr kp0 = (KParamsPtr)__builtin_amdgcn_kernarg_segment_ptr();
            (void)xb_add(&kp0->bar[XB_XCNT(xb_xcc_id())], 1u);
        }
        __syncthreads();
    }
#ifndef PROBE_PH
#define PROBE_PH -1
#endif
#if PROBE_SEL
    unsigned long long pr_t0 = 0, pr_prev = 0, pr_acc = 0; int pr_sel_prev = 0;
#endif
    for (int it = ph_lo; it < ph_hi + (PROBE_PH >= 0 ? 1 : 0); ++it) {
        const int ph = (PROBE_PH >= 0 && it > PROBE_PH) ? it - 1 : it;
        if (it == ph_lo + 1) cg::this_grid().sync();
        else if (it > ph_lo) { KParamsPtr kpb = (KParamsPtr)__builtin_amdgcn_kernarg_segment_ptr(); asm volatile("" : "+s"(kpb)); xcd_barrier(kpb->bar, xst); }
#if PROBE_SEL
        {
            const unsigned long long now = __builtin_amdgcn_s_memrealtime();
            if (it == ph_lo) { pr_t0 = now; } else if (pr_sel_prev) pr_acc += now - pr_prev;
            pr_prev = now;
            const int s_ = ph == 0 ? 10 : (ph == N_PHASES - 1 ? 11 : (ph - 1) % PH_PER_LAYER);
            pr_sel_prev = (PROBE_SEL >> s_) & 1;
            if (ph == N_PHASES - 1 && blockIdx.x == 0 && __builtin_amdgcn_workitem_id_x() == 0) {
                KParamsPtr kpp = (KParamsPtr)__builtin_amdgcn_kernarg_segment_ptr();
                kpp->probe[0] = sqrtf((float)pr_acc / (float)(now - pr_t0) * 2e-5f);
            }
            if (ph == N_PHASES - 1) { __syncthreads(); if (blockIdx.x == 0) { __threadfence(); } cg::this_grid().sync(); }
        }
#endif
        KParamsPtr kp = (KParamsPtr)__builtin_amdgcn_kernarg_segment_ptr();
        asm volatile("" : "+s"(kp));
        const Params& p = *(const Params*)kp;
        if (ph == 0) { phase_prologue(p, smem); continue; }
        if (ph == N_PHASES - 1) { phase_norm<true>(p, false, p.g_final, nullptr, 0, NLAT); continue; }
        const int l = (ph - 1) / PH_PER_LAYER, s = (ph - 1) % PH_PER_LAYER;
        const bool last = l == DEPTH - 1;
        const float* mods_l = p.mods + (size_t)l * 17 * MODW;
        if (s == 0 || s == 3 || s == 7) {
            const int j = s == 0 ? 0 : (s == 3 ? 1 : 2);
            const bool first = (l == 0 && s == 0);
            phase_norm<false>(p, first, p.g_norm + (l * 3 + j) * D, mods_l, 3 * j, (s == 7 && last) ? NLAT : NTOK);
        } else if (s == 1 || s == 8) {
            EpiSwiglu e{p.hid};
            phase_gemm_stream(p.xn, (s == 1 ? p.Wff1in : p.Wff2in) + (size_t)l * D * 2 * DFF, (s == 8 && last) ? NLAT : NTOK, 2 * DFF, D, e, smem);
        } else if (s == 2 || s == 6 || s == 9) {
            const bf16_t* A = s == 6 ? p.cat : p.hid;
            const bf16_t* Bt = s == 2 ? p.Wff1out + (size_t)l * D * DFF : (s == 9 ? p.Wff2out + (size_t)l * D * DFF : p.Wout + (size_t)l * D * D);
            const int K = s == 6 ? D : DFF, gi = s == 2 ? 2 : (s == 6 ? 5 : 8);
            EpiResid e{p.h16, mods_l + gi * D, p.dctx, s == 6 ? 1.0f : 0.5f};
            const bool withctx = !(s != 2 && last);
            phase_gemm_stream(A, Bt, withctx ? NTOK : NLAT, D, K, e, smem, withctx);
        } else if (s == 4) {
            EpiProj e{&p, l}; phase_gemm(p.xn, p.Win + (size_t)l * D * INC, NTOK, INC, D, e, smem, false, last);
        } else {
            phase_mixers(p, l, !last, smem);
        }
    }
}

extern "C" void kernel_launch(void* const* d_in, const int* in_sizes, int n_in, void* d_out, int out_size, void* d_ws, size_t ws_size, hipStream_t stream) {
    static int grid = 0;
    if (grid == 0) {
        int dev = 0, cus = 0, per_cu = 0;
        hipGetDevice(&dev);
        hipDeviceGetAttribute(&cus, hipDeviceAttributeMultiprocessorCount, dev);
        if (hipFuncSetAttribute((const void*)mega, hipFuncAttributeMaxDynamicSharedMemorySize, LDS_BYTES) != hipSuccess) fprintf(stderr, "hipFuncSetAttribute failed\n");
        if (hipOccupancyMaxActiveBlocksPerMultiprocessor(&per_cu, (const void*)mega, NTHR, LDS_BYTES) != hipSuccess || per_cu < 1) { fprintf(stderr, "occupancy query: %d\n", per_cu); per_cu = 1; }
        (void)hipGetLastError();
        grid = cus * per_cu;
        fprintf(stderr, "grid = %d (cus %d per_cu %d) ws_size %zu\n", grid, cus, per_cu, ws_size);
    }
    Params p{};
    const float** pin = (const float**)&p;
    for (int i = 0; i < 24; ++i) pin[i] = (const float*)d_in[i];
    p.out = (float*)d_out;
    char* w = (char*)d_ws; size_t off = 0;
    auto take = [&](size_t bytes) { char* r = w + off; off += (bytes + 255) & ~(size_t)255; return r; };
    p.Wff1in = (bf16_t*)take((size_t)DEPTH * D * 2 * DFF * 2);
    p.Wff1out = (bf16_t*)take((size_t)DEPTH * D * DFF * 2);
    p.Wff2in = (bf16_t*)take((size_t)DEPTH * D * 2 * DFF * 2);
    p.Wff2out = (bf16_t*)take((size_t)DEPTH * D * DFF * 2);
    p.Win = (bf16_t*)take((size_t)DEPTH * D * INC * 2);
    p.Wout = (bf16_t*)take((size_t)DEPTH * D * D * 2);
    p.Ws = (bf16_t*)take((size_t)DEPTH * 4 * 128 * 128 * 2);
    p.mods = (float*)take((size_t)DEPTH * 17 * MODW * 4);
    p.ropeA = (float*)take((size_t)SEQ * 32 * 2 * 4);
    p.ropeC = (float*)take((size_t)SEQ * 16 * 2 * 4);
    p.bar = (unsigned*)take((size_t)XCD_BAR_WORDS * 4);
    p.hc = nullptr;
    p.h16 = (_Float16*)take((size_t)NTOK * D * 2);
    p.probe = (float*)take(256);
    p.kmaxC = (unsigned*)take((size_t)DEPTH * NB * 4 * 2 * 4);
    p.dctx = (float*)take((size_t)4 * NCTX * D * 4);
    p.xn = (bf16_t*)d_out;
    p.cat = p.xn;
    p.hid = (bf16_t*)take((size_t)NTOK * DFF * 2);
    {
        char* q = (char*)p.hid; size_t o2 = 0;
        auto take2 = [&](size_t bytes) { char* r = q + o2; o2 += (bytes + 255) & ~(size_t)255; return r; };
        p.QA = (bf16_t*)take2((size_t)NB * 4 * KEYS * 64 * 2);
        p.KA = (bf16_t*)take2((size_t)NB * 2 * KEYS * 64 * 2);
        p.VtA = (bf16_t*)take2((size_t)NB * 2 * 64 * KEYS * 2);
        p.QC = (bf16_t*)take2((size_t)NB * 4 * 2 * KEYS * 32 * 2);
        p.KC = (bf16_t*)take2((size_t)NB * 4 * 2 * KEYS * 32 * 2);
        p.VtC = (bf16_t*)take2((size_t)NB * 4 * 64 * KEYS * 2);
        p.U = (bf16_t*)take2((size_t)NTOK * 256 * 2);
        p.VN = (bf16_t*)take2((size_t)NTOK * 256 * 2);
        p.Y = (bf16_t*)take2((size_t)NTOK * 256 * 2);
    }
    if (off > ws_size) { fprintf(stderr, "workspace too small: need %zu have %zu\n", off, ws_size); return; }
#if N_LAUNCH_MODE == 1
    if (hipMemsetAsync(p.bar, 0, (size_t)XCD_BAR_WORDS * 4, stream) != hipSuccess) fprintf(stderr, "memset of barrier words failed\n");
    int lo = 0, hi = N_PHASES;
    void* args[] = {&p, &lo, &hi};
    hipError_t e = hipLaunchCooperativeKernel((const void*)mega, dim3(grid), dim3(NTHR), args, LDS_BYTES, stream);
    if (e != hipSuccess) fprintf(stderr, "cooperative launch failed: %s (grid %d)\n", hipGetErrorString(e), grid);
#else
    for (int ph = 0; ph < N_PHASES; ++ph) hipLaunchKernelGGL(mega, dim3(grid), dim3(NTHR), LDS_BYTES, stream, p, ph, ph + 1);
#endif
}
```

```cpp
#include <hip/hip_runtime.h>
#include <hip/hip_cooperative_groups.h>
#include <cstdint>
#include <cstdio>
#include <cmath>
namespace cg = cooperative_groups;

#ifndef PROBE_SEL
#define PROBE_SEL 0
#endif
#ifndef N_LAUNCH_MODE
#define N_LAUNCH_MODE 1
#endif

typedef unsigned short bf16_t;
typedef short bf16x8 __attribute__((ext_vector_type(8)));
typedef short s16x4 __attribute__((ext_vector_type(4)));
typedef float f32x4 __attribute__((ext_vector_type(4)));
typedef float f32x2 __attribute__((ext_vector_type(2)));
typedef float f32x16 __attribute__((ext_vector_type(16)));
typedef unsigned u32x2 __attribute__((ext_vector_type(2)));
typedef unsigned u32x4 __attribute__((ext_vector_type(4)));
typedef __bf16 bf2_t __attribute__((ext_vector_type(2)));
#define DI __device__ __forceinline__

constexpr int D = 1024, NB = 16, SEQ = 2048, CTX = 256, NLAT = NB * SEQ, NCTX = NB * CTX, NTOK = NLAT + NCTX;
constexpr int DFF = 2816, INC = 2304, KEYS = SEQ + CTX, DEPTH = 2, MODW = 9 * D;
constexpr int NTHR = 512;
constexpr int LDS_BYTES = 135168;
constexpr float EPS = 1e-6f;

DI unsigned pk2(float a, float b) { f32x2 v = {a, b}; bf2_t r = __builtin_convertvector(v, bf2_t); return __builtin_bit_cast(unsigned, r); }
DI float bf2f(bf16_t v) { return __uint_as_float(((unsigned)v) << 16); }
DI float bflo(unsigned v) { return __uint_as_float(v << 16); }
DI float bfhi(unsigned v) { return __uint_as_float(v & 0xffff0000u); }
DI bf16_t f2bf(float a) { return (bf16_t)(pk2(a, 0.f) & 0xffffu); }
DI float silu_f(float x) { return x * __builtin_amdgcn_rcpf(1.f + __expf(-x)); }
DI float sigmoid_f(float x) { return __builtin_amdgcn_rcpf(1.f + __expf(-x)); }
DI float gelu_f(float x) { float u = 1.5957691216057308f * (x + 0.044715f * x * x * x); return x * __builtin_amdgcn_rcpf(1.f + __expf(-u)); }
DI int TID() { int t = __builtin_amdgcn_workitem_id_x(); asm volatile("" : "+v"(t)); return t; }
DI void lds_barrier() { asm volatile("s_waitcnt lgkmcnt(0)" ::: "memory"); __builtin_amdgcn_s_barrier(); asm volatile("" ::: "memory"); }
DI float wave_sum(float v) {
#pragma unroll
    for (int o = 32; o >= 1; o >>= 1) v += __shfl_xor(v, o);
    return v;
}

struct Params {
    const float *x, *c, *ctx, *c_ctx, *w_ada, *b_ada, *g_norm, *w_ff1_in, *w_ff1_out, *w_ff2_in, *w_ff2_out, *w_in, *w_out, *g_q_a, *g_k_a, *lam_c,
        *g_sub_c, *g_v_b, *w_s_b, *b_s_b, *w_dw_d, *b_dw_d, *g_conv_d, *g_final;
    float* out;
    bf16_t *Wff1in, *Wff1out, *Wff2in, *Wff2out, *Win, *Wout, *Ws;
    float *mods, *ropeA, *ropeC, *hc;
    bf16_t *xn, *hid, *QA, *KA, *VtA, *QC, *KC, *VtC, *U, *VN, *Y, *cat;
    unsigned* bar;
    float* probe;
    unsigned* kmaxC;
    float* dctx;
    _Float16* h16;
};

DI void sincos_d(double x, double& s, double& c) {
    double k = rint(x * 0.15915494309189535);
    double r = fma(-k, 6.283185307179586, x);
    r = fma(-k, 2.4492935982947064e-16, r);
    double r2 = r * r, as = 1.0, ac = 1.0;
#pragma unroll
    for (int n = 14; n >= 1; --n) {
        as = 1.0 - r2 / (double)((2 * n) * (2 * n + 1)) * as;
        ac = 1.0 - r2 / (double)((2 * n - 1) * (2 * n)) * ac;
    }
    s = r * as; c = ac;
}

constexpr int T_FFIN = (D / 64) * (2 * DFF / 256), T_FFOUT = (DFF / 64) * (D / 256), T_WIN = (D / 64) * (INC / 256), T_WOUT = (D / 64) * (D / 256);
constexpr int T_LAYER = 2 * T_FFIN + 2 * T_FFOUT + T_WIN + T_WOUT;
constexpr int U_TR = DEPTH * T_LAYER, U_WS = 32, U_ADA = 288, U_ROPE = 192;
constexpr int U_P0 = U_TR + U_WS + U_ADA + U_ROPE;

DI void transpose_unit(const float* src, bf16_t* dst, int K, int N, int perm, int ti, float* tile) {
    const int tn = N / 256, kt = ti / tn, nt = ti % tn, k0 = kt * 64;
    const int t = TID();
    const int kk = t >> 4, c4 = (t & 15) * 4;
    f32x4 v[4][2];
#pragma unroll
    for (int sub = 0; sub < 4; ++sub) {
        const int n0 = nt * 256 + sub * 64;
        int sc0 = n0;
        if (perm == 1) { const int q = n0 >> 8, j = n0 & 255; sc0 = j < 128 ? q * 128 + j : DFF + q * 128 + (j - 128); }
        else if (perm == 2 && n0 >= 1792) { const int m = n0 - 1792, q = m >> 8, j = m & 255; sc0 = j < 128 ? 1792 + q * 128 + j : 2048 + q * 128 + (j - 128); }
#pragma unroll
        for (int i = 0; i < 2; ++i) v[sub][i] = *(const f32x4*)(src + (size_t)(k0 + kk + 32 * i) * N + sc0 + c4);
    }
#pragma unroll
    for (int sub = 0; sub < 4; ++sub)
#pragma unroll
        for (int i = 0; i < 2; ++i) {
            float* tp = tile + sub * 64 * 65 + (kk + 32 * i) * 65 + c4;
            tp[0] = v[sub][i][0]; tp[1] = v[sub][i][1]; tp[2] = v[sub][i][2]; tp[3] = v[sub][i][3];
        }
    __syncthreads();
    {
        const int n = t >> 3, k8 = (t & 7) * 8;
#pragma unroll
        for (int sub = 0; sub < 4; ++sub) {
            const float* tp = tile + sub * 64 * 65 + k8 * 65 + n;
            u32x4 o;
            o[0] = pk2(tp[0], tp[65]); o[1] = pk2(tp[2 * 65], tp[3 * 65]); o[2] = pk2(tp[4 * 65], tp[5 * 65]); o[3] = pk2(tp[6 * 65], tp[7 * 65]);
            int drow = nt * 256 + sub * 64 + n;
            if (perm == 1) { const int c = drow & 31; drow = (drow & ~31) + ((c >> 2) & 1) * 16 + (c >> 3) * 4 + (c & 3); }
            *(u32x4*)(dst + (size_t)drow * K + k0 + k8) = o;
        }
    }
    __syncthreads();
}

DI void phase_prologue(const Params& p, char* smem) {
    const int t = TID();
    if ((int)blockIdx.x < U_ADA) {
        float* s = (float*)smem;
        float* red = s + 17 * 1024;
        {
            float cv[34];
#pragma unroll
            for (int j = 0; j < 34; ++j) { const int i = t + j * NTHR, r = i >> 10, k = i & 1023; cv[j] = r < 16 ? p.c[r * D + k] : p.c_ctx[k]; }
#pragma unroll
            for (int j = 0; j < 34; ++j) s[t + j * NTHR] = silu_f(cv[j]);
        }
        __syncthreads();
        const int col = t & 63, ks = t >> 6;
        for (int uu = blockIdx.x; uu < U_ADA; uu += gridDim.x) {
            const int l = uu / 144, col0 = (uu % 144) * 64;
            float acc[17];
#pragma unroll
            for (int r = 0; r < 17; ++r) acc[r] = 0.f;
            const float* w = p.w_ada + (size_t)l * D * MODW + (size_t)(ks * 128) * MODW + col0 + col;
            float wv[16], wn[16];
#pragma unroll
            for (int k = 0; k < 16; ++k) wv[k] = w[(size_t)k * MODW];
            for (int k0 = 0; k0 < 128; k0 += 16) {
                if (k0 + 16 < 128) {
#pragma unroll
                    for (int k = 0; k < 16; ++k) wn[k] = w[(size_t)(k0 + 16 + k) * MODW];
                }
#pragma unroll
                for (int r = 0; r < 17; ++r)
#pragma unroll
                    for (int kq = 0; kq < 4; ++kq) {
                        const f32x4 sv = *(const f32x4*)(s + r * 1024 + ks * 128 + k0 + 4 * kq);
                        acc[r] += (sv[0] * wv[4 * kq] + sv[1] * wv[4 * kq + 1]) + (sv[2] * wv[4 * kq + 2] + sv[3] * wv[4 * kq + 3]);
                    }
#pragma unroll
                for (int k = 0; k < 16; ++k) wv[k] = wn[k];
            }
#pragma unroll
            for (int r = 0; r < 17; ++r) red[(ks * 17 + r) * 64 + col] = acc[r];
            __syncthreads();
            for (int i = t; i < 17 * 64; i += NTHR) {
                const int r = i >> 6, cc = i & 63; float sum = 0.f;
#pragma unroll
                for (int q = 0; q < 8; ++q) sum += red[(q * 17 + r) * 64 + cc];
                p.mods[((size_t)l * 17 + r) * MODW + col0 + cc] = sum + p.b_ada[(size_t)l * MODW + col0 + cc];
            }
            __syncthreads();
        }
    }
    if (blockIdx.x == gridDim.x - 1 && t < DEPTH * NB * 4 * 2) p.kmaxC[t] = 0u;
    for (int v = (int)gridDim.x - 1 - (int)blockIdx.x; v < U_WS + U_ROPE; v += gridDim.x) {
        if (v < U_WS) {
            const int e0 = v * 4096 + t * 8;
            f32x4 a = *(const f32x4*)(p.w_s_b + e0), b = *(const f32x4*)(p.w_s_b + e0 + 4);
            u32x4 o; o[0] = pk2(a[0], a[1]); o[1] = pk2(a[2], a[3]); o[2] = pk2(b[0], b[1]); o[3] = pk2(b[2], b[3]);
            *(u32x4*)(p.Ws + e0) = o;
        } else {
            const int e = (v - U_WS) * 512 + t;
            const int pos = e / 48, j = e % 48, row = pos >> 6, col = pos & 63;
            float ang; float* dst;
            if (j < 32) { const float inv = exp2f(-(float)(j & 15) * (13.287712379549449f / 16.f)); ang = (float)(j < 16 ? row : col) * inv; dst = p.ropeA + ((size_t)pos * 32 + j) * 2; }
            else { const int jj = j - 32; const float inv = exp2f(-(float)(jj & 7) * (13.287712379549449f / 8.f)); ang = (float)(jj < 8 ? row : col) * inv; dst = p.ropeC + ((size_t)pos * 16 + jj) * 2; }
            double sn, cs; sincos_d((double)ang, sn, cs);
            dst[0] = (float)cs; dst[1] = (float)sn;
        }
    }
    for (int u = blockIdx.x; u < U_TR; u += gridDim.x) {
        const int l = u / T_LAYER; int r = u % T_LAYER;
        const float* src; bf16_t* dst; int K, N, perm;
        if (r < T_FFIN) { src = p.w_ff1_in + (size_t)l * D * 2 * DFF; dst = p.Wff1in + (size_t)l * D * 2 * DFF; K = D; N = 2 * DFF; perm = 1; }
        else if ((r -= T_FFIN) < T_FFOUT) { src = p.w_ff1_out + (size_t)l * D * DFF; dst = p.Wff1out + (size_t)l * D * DFF; K = DFF; N = D; perm = 0; }
        else if ((r -= T_FFOUT) < T_FFIN) { src = p.w_ff2_in + (size_t)l * D * 2 * DFF; dst = p.Wff2in + (size_t)l * D * 2 * DFF; K = D; N = 2 * DFF; perm = 1; }
        else if ((r -= T_FFIN) < T_FFOUT) { src = p.w_ff2_out + (size_t)l * D * DFF; dst = p.Wff2out + (size_t)l * D * DFF; K = DFF; N = D; perm = 0; }
        else if ((r -= T_FFOUT) < T_WIN) { src = p.w_in + (size_t)l * D * INC; dst = p.Win + (size_t)l * D * INC; K = D; N = INC; perm = 2; }
        else { r -= T_WIN; src = p.w_out + (size_t)l * D * D; dst = p.Wout + (size_t)l * D * D; K = D; N = D; perm = 0; }
        transpose_unit(src, dst, K, N, perm, r, (float*)smem);
    }
}

typedef _Float16 h16x4 __attribute__((ext_vector_type(4)));
template <bool FINAL>
DI void phase_norm(const Params& p, bool first, const float* g, const float* mods_l, int mi, int nrows) {
    constexpr int RW = 4;
    const int wid = TID() >> 6, lane = TID() & 63;
    for (int u = blockIdx.x; u < nrows / (8 * RW); u += gridDim.x) {
        const int row0 = (u * 8 + wid) * RW;
        const bool islat = row0 < NLAT;
        const int mb = islat ? row0 / SEQ : 16;
        f32x4 v[RW][4];
        if (first) {
            const float* src = islat ? p.x + (size_t)row0 * D : p.ctx + (size_t)(row0 - NLAT) * D;
#pragma unroll
            for (int q = 0; q < RW; ++q)
#pragma unroll
                for (int i = 0; i < 4; ++i) v[q][i] = *(const f32x4*)(src + (size_t)q * D + i * 256 + lane * 4);
        } else {
            h16x4 hv[RW][4];
#pragma unroll
            for (int q = 0; q < RW; ++q)
#pragma unroll
                for (int i = 0; i < 4; ++i) hv[q][i] = *(const h16x4*)(p.h16 + (size_t)(row0 + q) * D + i * 256 + lane * 4);
            if (islat) {
#pragma unroll
                for (int q = 0; q < RW; ++q)
#pragma unroll
                    for (int i = 0; i < 4; ++i) v[q][i] = __builtin_convertvector(hv[q][i], f32x4);
            } else {
#pragma unroll
                for (int q = 0; q < RW; ++q)
#pragma unroll
                    for (int i = 0; i < 4; ++i) {
                        const float* pq = p.dctx + (size_t)(row0 + q - NLAT) * D + i * 256 + lane * 4;
                        v[q][i] = __builtin_convertvector(hv[q][i], f32x4) + ((*(const f32x4*)pq + *(const f32x4*)(pq + (size_t)NCTX * D)) + (*(const f32x4*)(pq + (size_t)2 * NCTX * D) + *(const f32x4*)(pq + (size_t)3 * NCTX * D)));
                    }
            }
        }
        float rstd[RW];
#pragma unroll
        for (int q = 0; q < RW; ++q) {
            float ss = 0.f;
#pragma unroll
            for (int i = 0; i < 4; ++i) ss += v[q][i][0] * v[q][i][0] + v[q][i][1] * v[q][i][1] + v[q][i][2] * v[q][i][2] + v[q][i][3] * v[q][i][3];
            rstd[q] = rsqrtf(wave_sum(ss) * (1.f / D) + EPS);
        }
        if (FINAL) {
#pragma unroll
            for (int i = 0; i < 4; ++i) { const int col = i * 256 + lane * 4; const f32x4 gv = *(const f32x4*)(g + col);
#pragma unroll
                for (int q = 0; q < RW; ++q) { f32x4 o = v[q][i] * rstd[q] * gv;
#if PROBE_SEL
                    { const float e = p.probe[0]; o[0] *= 1.f + e; o[1] *= 1.f - e; o[2] *= 1.f + e; o[3] *= 1.f - e; }
#endif
                    *(f32x4*)(p.out + (size_t)(row0 + q) * D + col) = o; } }
        } else {
            if (first || !islat) {
#pragma unroll
                for (int q = 0; q < RW; ++q)
#pragma unroll
                    for (int i = 0; i < 4; ++i) *(h16x4*)(p.h16 + (size_t)(row0 + q) * D + i * 256 + lane * 4) = __builtin_convertvector(v[q][i], h16x4);
            }
            const float* sh = mods_l + (size_t)mb * MODW + mi * D; const float* scl = sh + D;
#pragma unroll
            for (int i = 0; i < 4; ++i) {
                const int col = i * 256 + lane * 4;
                const f32x4 gv = *(const f32x4*)(g + col), sv = *(const f32x4*)(scl + col), bv = *(const f32x4*)(sh + col);
                const f32x4 gs = gv * (1.f + sv);
#pragma unroll
                for (int q = 0; q < RW; ++q) {
                    const f32x4 o = v[q][i] * rstd[q] * gs + bv;
                    u32x2 w; w[0] = pk2(o[0], o[1]); w[1] = pk2(o[2], o[3]);
                    *(u32x2*)(p.xn + (size_t)(row0 + q) * D + col) = w;
                }
            }
        }
    }
}

constexpr int BM = 256, BK = 64, HALF = 128, HT = HALF * BK, NXCD = 8, WGM = 8;
DI int lds_byte(int r, int c) { const int st = (r >> 4) * 2 + (c >> 5), rr = r & 15, cc = c & 31, ob = rr * 64 + cc * 2; return st * 1024 + (ob ^ (((ob >> 9) & 1) << 5)); }
DI void stage_rc(int b, int& R, int& C) { const int st = b / 1024, sb = b % 1024, swz = sb ^ (((sb >> 9) & 1) << 5); R = (st >> 1) * 16 + swz / 64; C = (st & 1) * 32 + (swz % 64) / 2; }

#define LAS __attribute__((address_space(3)))
constexpr int HTB = HALF * BK * 2;
DI void gemm_tile(const bf16_t* A, const bf16_t* Bt, int K  , int kt0, int nt  , int brow, int bcol, f32x4 (&acc)[2][2][4][2], LAS unsigned char* lds) {
    const int tid = TID(), wid = __builtin_amdgcn_readfirstlane(tid >> 6), lane = tid & 63, wr = wid >> 2, wc = wid & 3, fr = lane & 15, fq = lane >> 4;
    unsigned voff[2];
#pragma unroll
    for (int i = 0; i < 2; ++i) { int R, C; stage_rc(tid * 16 + i * 8192, R, C); voff[i] = (unsigned)(R * K + C) * 2u; }
    const size_t kstep = (size_t)(BK * 2), hstep = (size_t)HALF * K * 2;
    const unsigned ldsw = (unsigned)wid * 1024u;
    const int aoff = lds_byte(wr * 64 + fr, fq * 8), boff = lds_byte(wc * 32 + fr, fq * 8);
#define SA(b, h) (((b) * 2 + (h)) * HTB)
#define SB(b, h) ((4 + (b) * 2 + (h)) * HTB)
#define STAGE(bufoff, gbase) do { _Pragma("unroll") for (int _i = 0; _i < 2; ++_i) \
        __builtin_amdgcn_global_load_lds((const unsigned*)((const char*)(gbase) + voff[_i]), (LAS unsigned*)(lds + (bufoff) + ldsw + _i * 8192), 16, 0, 0); } while (0)
#define LDA(dst, b, h) do { _Pragma("unroll") for (int m = 0; m < 4; ++m) _Pragma("unroll") for (int k = 0; k < 2; ++k) dst[m][k] = *(const LAS bf16x8*)(lds + SA(b, h) + aoff + m * 2048 + k * 1024); } while (0)
#define LDB(dst, b, h) do { _Pragma("unroll") for (int n = 0; n < 2; ++n) _Pragma("unroll") for (int k = 0; k < 2; ++k) dst[n][k] = *(const LAS bf16x8*)(lds + SB(b, h) + boff + n * 2048 + k * 1024); } while (0)
#define MMA(ai, bj, At_, Bt_) do { __builtin_amdgcn_s_setprio(1); _Pragma("unroll") for (int m = 0; m < 4; ++m) _Pragma("unroll") for (int n = 0; n < 2; ++n) _Pragma("unroll") for (int k = 0; k < 2; ++k) \
        acc[ai][bj][m][n] = __builtin_amdgcn_mfma_f32_16x16x32_bf16(Bt_[n][k], At_[m][k], acc[ai][bj][m][n], 0, 0, 0); __builtin_amdgcn_s_setprio(0); } while (0)
#define WAIT_V(n) asm volatile("s_waitcnt vmcnt(" #n ")" ::: "memory")
#define WAIT_L(n) asm volatile("s_waitcnt lgkmcnt(" #n ")" ::: "memory")
#define BAR __builtin_amdgcn_s_barrier()
#define SCHED __builtin_amdgcn_sched_barrier(0)
#pragma unroll
    for (int a = 0; a < 2; ++a)
#pragma unroll
        for (int b = 0; b < 2; ++b)
#pragma unroll
            for (int m = 0; m < 4; ++m)
#pragma unroll
                for (int n = 0; n < 2; ++n) acc[a][b][m][n] = (f32x4){0.f, 0.f, 0.f, 0.f};
    bf16x8 At[4][2], B0[2][2], B1[2][2];
    const char* cA = (const char*)A + (size_t)brow * K * 2 + (size_t)kt0 * BK * 2; const char* cB = (const char*)Bt + (size_t)bcol * K * 2 + (size_t)kt0 * BK * 2;
    STAGE(SB(0, 0), cB); STAGE(SB(0, 1), cB + hstep); STAGE(SA(0, 0), cA); STAGE(SA(0, 1), cA + hstep);
    if (wr == 1) BAR;
    WAIT_V(2); BAR;
    STAGE(SB(1, 0), cB + kstep); STAGE(SA(1, 0), cA + kstep); STAGE(SB(1, 1), cB + hstep + kstep);
    WAIT_V(6); BAR;
    for (int t = 0; t < nt; t += 2) {
        const bool lastit = (t == nt - 2);
        const char* a1 = cA + (size_t)(t + 1) * kstep;
        const char* a2 = lastit ? cA : cA + (size_t)(t + 2) * kstep; const char* b2 = lastit ? cB : cB + (size_t)(t + 2) * kstep;
        const char* a3 = a2 + kstep; const char* b3 = b2 + kstep;
        LDB(B0, 0, 0); LDB(B1, 0, 1); SCHED; LDA(At, 0, 0); STAGE(SA(1, 1), a1 + hstep);
        WAIT_V(8); WAIT_L(0); BAR; MMA(0, 0, At, B0); MMA(0, 1, At, B1); BAR; SCHED;
        LDA(At, 0, 1); STAGE(SB(0, 0), b2); STAGE(SB(0, 1), b2 + hstep); STAGE(SA(0, 0), a2);
        WAIT_V(8); WAIT_L(0); BAR; MMA(1, 0, At, B0); MMA(1, 1, At, B1); BAR; SCHED;
        LDB(B0, 1, 0); LDB(B1, 1, 1); SCHED; LDA(At, 1, 0); STAGE(SA(0, 1), a2 + hstep);
        WAIT_V(8); WAIT_L(0); BAR; MMA(0, 0, At, B0); MMA(0, 1, At, B1); BAR; SCHED;
        LDA(At, 1, 1); STAGE(SB(1, 0), b3); STAGE(SB(1, 1), b3 + hstep); STAGE(SA(1, 0), a3);
        WAIT_V(8); WAIT_L(0); BAR; MMA(1, 0, At, B0); MMA(1, 1, At, B1); BAR; SCHED;
    }
    WAIT_V(0);
    if (wr == 0) BAR;
    BAR;
}

DI void tile_order(int L, int nM, int nN, int& pm, int& pn) {
    const int nwg = nM * nN; int wgid = L;
    { const int q = nwg / NXCD, r = nwg % NXCD, xcd = wgid % NXCD, off = wgid / NXCD; wgid = (xcd < r ? xcd * (q + 1) : r * (q + 1) + (xcd - r) * q) + off; }
    const int nig = WGM * nN, gid = wgid / nig, fm = gid * WGM, gsz = (nM - fm) < WGM ? (nM - fm) : WGM;
    pm = fm + ((wgid % nig) % gsz); pn = (wgid % nig) / gsz;
}

struct EpiSwiglu {
    bf16_t* hid;
    DI void operator()(f32x4 (&acc)[2][2][4][2], int pm, int pn, int sl, char* smem) const {
        const int wid = TID() >> 6, lane = TID() & 63, wr = wid >> 2, wc = wid & 3, fr = lane & 15, fq = lane >> 4;
#pragma unroll
        for (int ai = 0; ai < 2; ++ai)
#pragma unroll
            for (int m = 0; m < 4; ++m) {
                const int row = pm * BM + ai * HALF + wr * 64 + m * 16 + fr;
                u32x4 w;
#pragma unroll
                for (int n = 0; n < 2; ++n) {
                    const f32x4 a = acc[ai][0][m][n], b = acc[ai][1][m][n];
                    w[2 * n] = pk2(silu_f(a[0]) * b[0], silu_f(a[1]) * b[1]); w[2 * n + 1] = pk2(silu_f(a[2]) * b[2], silu_f(a[3]) * b[3]);
                }
                *(u32x4*)(hid + (size_t)row * DFF + pn * 128 + wc * 32 + fq * 8) = w;
            }
    }
};
struct EpiResid {
    _Float16* h16; const float* gate; float* dctx; float gs;
    DI void operator()(f32x4 (&acc)[2][2][4][2], int pm, int pn, int sl, char* smem) const {
        const int wid = TID() >> 6, lane = TID() & 63, wr = wid >> 2, wc = wid & 3, fr = lane & 15, fq = lane >> 4;
        const int row0 = pm * BM; const bool islat = row0 < NLAT;
        _Float16* out = h16 + (size_t)(row0 + wr * 64 + fr) * D + pn * BM + wc * 32 + fq * 4;
        const float* gt = gate + (size_t)(islat ? row0 / SEQ : 16) * MODW + pn * BM + wc * 32 + fq * 4;
        f32x4 gv[2][2];
#pragma unroll
        for (int bj = 0; bj < 2; ++bj)
#pragma unroll
            for (int n = 0; n < 2; ++n) gv[bj][n] = *(const f32x4*)(gt + bj * HALF + n * 16) * gs;
        if (sl >= 0) {
            float* po = dctx + ((size_t)sl * NCTX + (row0 - NLAT) + wr * 64 + fr) * D + pn * BM + wc * 32 + fq * 4;
#pragma unroll
            for (int ai = 0; ai < 2; ++ai)
#pragma unroll
                for (int m = 0; m < 4; ++m)
#pragma unroll
                    for (int bj = 0; bj < 2; ++bj)
#pragma unroll
                        for (int n = 0; n < 2; ++n) *(f32x4*)(po + (size_t)(ai * HALF + m * 16) * D + bj * HALF + n * 16) = gv[bj][n] * acc[ai][bj][m][n];
            return;
        }
        h16x4 hv[2][4][2][2];
#pragma unroll
        for (int ai = 0; ai < 2; ++ai)
#pragma unroll
            for (int m = 0; m < 4; ++m)
#pragma unroll
                for (int bj = 0; bj < 2; ++bj)
#pragma unroll
                    for (int n = 0; n < 2; ++n) hv[ai][m][bj][n] = *(const h16x4*)(out + (size_t)(ai * HALF + m * 16) * D + bj * HALF + n * 16);
#pragma unroll
        for (int ai = 0; ai < 2; ++ai)
#pragma unroll
            for (int m = 0; m < 4; ++m)
#pragma unroll
                for (int bj = 0; bj < 2; ++bj)
#pragma unroll
                    for (int n = 0; n < 2; ++n) {
                        const f32x4 v = __builtin_convertvector(hv[ai][m][bj][n], f32x4) + gv[bj][n] * acc[ai][bj][m][n];
                        *(h16x4*)(out + (size_t)(ai * HALF + m * 16) * D + bj * HALF + n * 16) = __builtin_convertvector(v, h16x4);
                    }
    }
};
constexpr float SC_A = 0.125f * 1.4426950408889634f, SC_C = 0.17677669529663687f * 1.4426950408889634f;
constexpr int TS = 260;
struct EpiProj {
    const Params* pp; int l;
    DI void operator()(f32x4 (&acc)[2][2][4][2], int pm, int pn, int sl, char* smem) const {
        const Params& p = *pp;
        LAS float* T = (LAS float*)smem;
        const int tid = TID(), wid = tid >> 6, lane = tid & 63, wr = wid >> 2, wc = wid & 3, fr = lane & 15, fq = lane >> 4;
#pragma unroll
        for (int ai = 0; ai < 2; ++ai) {
            lds_barrier();
#pragma unroll
            for (int bj = 0; bj < 2; ++bj)
#pragma unroll
                for (int m = 0; m < 4; ++m)
#pragma unroll
                    for (int n = 0; n < 2; ++n) *(LAS f32x4*)(T + (wr * 64 + m * 16 + fr) * TS + bj * HALF + wc * 32 + n * 16 + fq * 4) = acc[ai][bj][m][n];
            lds_barrier();
            const int rl = tid & 127, seg = tid >> 7, grow = pm * BM + ai * HALF + rl;
            const bool islat = grow < NLAT;
            const int b = islat ? grow / SEQ : (grow - NLAT) / CTX;
            const int pos = islat ? grow % SEQ : SEQ + (grow - NLAT) % CTX;
            const LAS float* xr = T + rl * TS + seg * 64;
            if (pn >= 7 && seg >= 2) continue;
#define LD8(dstv, off) { const f32x4 _a = *(const LAS f32x4*)(xr + (off)), _b = *(const LAS f32x4*)(xr + (off) + 4); dstv[0] = _a[0]; dstv[1] = _a[1]; dstv[2] = _a[2]; dstv[3] = _a[3]; dstv[4] = _b[0]; dstv[5] = _b[1]; dstv[6] = _b[2]; dstv[7] = _b[3]; }
            if (pn == 0 || (pn == 2 && seg < 2)) {
                const float* g = (pn == 0 ? p.g_q_a : p.g_k_a) + l * 64;
                bf16_t* dst = pn == 0 ? p.QA + ((size_t)(b * 4 + seg) * KEYS + pos) * 64 : p.KA + ((size_t)(b * 2 + seg) * KEYS + pos) * 64;
                float ss = 0.f;
#pragma unroll
                for (int i = 0; i < 16; ++i) { const f32x4 v = *(const LAS f32x4*)(xr + 4 * i); ss += v[0] * v[0] + v[1] * v[1] + v[2] * v[2] + v[3] * v[3]; }
                const float rstd = rsqrtf(ss * (1.f / 64.f) + EPS);
                const float* rp = p.ropeA + (size_t)(islat ? pos : 0) * 64;
#pragma unroll
                for (int i0 = 0; i0 < 32; i0 += 8) {
                    float xa[8], xb[8], o1[8], o2[8];
                    LD8(xa, i0); LD8(xb, i0 + 32);
#pragma unroll
                    for (int i = 0; i < 8; i += 2) {
                        f32x4 cssn = {1.f, 0.f, 1.f, 0.f};
                        if (islat) cssn = *(const f32x4*)(rp + (i0 + i) * 2);
#pragma unroll
                        for (int e = 0; e < 2; ++e) {
                            const float a = xa[i + e] * rstd * g[i0 + i + e], bb = xb[i + e] * rstd * g[i0 + i + e + 32];
                            o1[i + e] = a * cssn[2 * e] - bb * cssn[2 * e + 1]; o2[i + e] = a * cssn[2 * e + 1] + bb * cssn[2 * e];
                        }
                    }
                    const float qs = pn == 0 ? SC_A : 1.f;
                    u32x4 w1, w2;
#pragma unroll
                    for (int i = 0; i < 4; ++i) { w1[i] = pk2(o1[2 * i] * qs, o1[2 * i + 1] * qs); w2[i] = pk2(o2[2 * i] * qs, o2[2 * i + 1] * qs); }
                    *(u32x4*)(dst + i0) = w1; *(u32x4*)(dst + 32 + i0) = w2;
                }
            } else if (pn == 1 || pn == 3) {
                bf16_t* base = (pn == 1 ? p.QC : p.KC);
                const float* rp = p.ropeC + (size_t)(islat ? pos : 0) * 32;
#pragma unroll
                for (int mp = 0; mp < 2; ++mp) {
                    bf16_t* dst = base + ((size_t)(b * 4 + seg) * KEYS + pos) * 64 + mp * 32;
                    float k2 = 0.f;
#pragma unroll
                    for (int i0 = 0; i0 < 16; i0 += 8) {
                        float xa[8], xb[8], o1[8], o2[8];
                        LD8(xa, mp * 32 + i0); LD8(xb, mp * 32 + i0 + 16);
#pragma unroll
                        for (int i = 0; i < 8; ++i) k2 += xa[i] * xa[i] + xb[i] * xb[i];
#pragma unroll
                        for (int i = 0; i < 8; i += 2) {
                            f32x4 cssn = {1.f, 0.f, 1.f, 0.f};
                            if (islat) cssn = *(const f32x4*)(rp + (i0 + i) * 2);
#pragma unroll
                            for (int e = 0; e < 2; ++e) {
                                const float a = xa[i + e], bb = xb[i + e];
                                o1[i + e] = a * cssn[2 * e] - bb * cssn[2 * e + 1]; o2[i + e] = a * cssn[2 * e + 1] + bb * cssn[2 * e];
                            }
                        }
                        const float qs = pn == 1 ? SC_C : 1.f;
                        u32x4 w1, w2;
#pragma unroll
                        for (int i = 0; i < 4; ++i) { w1[i] = pk2(o1[2 * i] * qs, o1[2 * i + 1] * qs); w2[i] = pk2(o2[2 * i] * qs, o2[2 * i + 1] * qs); }
                        *(u32x4*)(dst + i0) = w1; *(u32x4*)(dst + 16 + i0) = w2;
                    }
                    if (pn == 3) {
#pragma unroll
                        for (int o = 32; o >= 1; o >>= 1) k2 = fmaxf(k2, __shfl_xor(k2, o));
                        if (lane == 0) atomicMax(p.kmaxC + (size_t)l * NB * 8 + (b * 4 + seg) * 2 + mp, __float_as_uint(k2));
                    }
                }
            } else if (pn == 2 || pn == 4) {
                bf16_t* dst = pn == 2 ? p.VtA + ((size_t)(b * 2 + (seg - 2)) * 64) * KEYS + pos : p.VtC + ((size_t)(b * 4 + seg) * 64) * KEYS + pos;
#pragma unroll
                for (int d0 = 0; d0 < 64; d0 += 8) {
                    float xa[8]; LD8(xa, d0);
#pragma unroll
                    for (int d = 0; d < 8; ++d) dst[(size_t)(d0 + d) * KEYS] = f2bf(xa[d]);
                }
            } else if (pn == 5) {
                bf16_t* dst = p.U + (size_t)grow * 256 + seg * 64;
#pragma unroll
                for (int i0 = 0; i0 < 64; i0 += 8) {
                    float xa[8]; LD8(xa, i0);
                    u32x4 w;
#pragma unroll
                    for (int i = 0; i < 4; ++i) w[i] = pk2(gelu_f(xa[2 * i]), gelu_f(xa[2 * i + 1]));
                    *(u32x4*)(dst + i0) = w;
                }
            } else if (pn == 6) {
                float ss = 0.f;
#pragma unroll
                for (int i0 = 0; i0 < 64; i0 += 8) {
                    float xa[8]; LD8(xa, i0);
#pragma unroll
                    for (int i = 0; i < 8; ++i) { const float gv = gelu_f(xa[i]); ss += gv * gv; }
                }
                T[rl * TS + 256 + seg] = ss;
                lds_barrier();
                const f32x4 pt = *(const LAS f32x4*)(T + rl * TS + 256);
                const float rstd = rsqrtf(((pt[0] + pt[1]) + (pt[2] + pt[3])) * (1.f / 256.f) + EPS);
                const float* g = p.g_v_b + l * 256 + seg * 64;
                bf16_t* dst = p.VN + (size_t)grow * 256 + seg * 64;
#pragma unroll
                for (int i0 = 0; i0 < 64; i0 += 8) {
                    float xa[8]; LD8(xa, i0);
                    u32x4 w;
#pragma unroll
                    for (int i = 0; i < 4; ++i) w[i] = pk2(gelu_f(xa[2 * i]) * rstd * g[i0 + 2 * i], gelu_f(xa[2 * i + 1]) * rstd * g[i0 + 2 * i + 1]);
                    *(u32x4*)(dst + i0) = w;
                }
            } else {
                bf16_t* dst = p.Y + (size_t)grow * 256 + (pn - 7) * 128 + seg * 64;
#pragma unroll
                for (int i0 = 0; i0 < 64; i0 += 8) {
                    float xa[8], ga[8]; LD8(xa, i0); LD8(ga, 128 + i0);
                    u32x4 w;
#pragma unroll
                    for (int i = 0; i < 4; ++i) w[i] = pk2(xa[2 * i] * sigmoid_f(ga[2 * i]), xa[2 * i + 1] * sigmoid_f(ga[2 * i + 1]));
                    *(u32x4*)(dst + i0) = w;
                }
            }
#undef LD8
        }
        lds_barrier();
    }
};

struct UnitList {
    int nM, nN, nwg, nsp, ntk, split, kvonly;
    DI void init(int M, int N, int K, bool splitctx, bool kvonlyctx) {
        nN = N / BM; ntk = K / BK; split = splitctx; kvonly = kvonlyctx;
        nM = ((splitctx || kvonlyctx) ? NLAT : M) / BM; nwg = nM * nN; nsp = splitctx ? (NCTX / BM) * nN * 4 : (kvonlyctx ? (NCTX / BM) * 3 : 0);
    }
    DI bool get(int L, int& pm, int& pn, int& sl, int& kt0, int& nt) const {
        if (L >= nwg + nsp) return false;
        sl = -1; kt0 = 0; nt = ntk;
        if (L < nwg) tile_order(L, nM, nN, pm, pn);
        else if (kvonly) { const int c = L - nwg; pm = NLAT / BM + c / 3; pn = 2 + c % 3; }
        else {
            const int c = L - nwg, tile = c >> 2; sl = c & 3; pm = NLAT / BM + tile / nN; pn = tile % nN;
            const int q = ntk / 8 * 2, rem2 = (ntk - 4 * q) / 2;
            kt0 = sl * q + 2 * (sl < rem2 ? sl : rem2); nt = q + (sl < rem2 ? 2 : 0);
        }
        return true;
    }
};

template <class Epi>
DI void phase_gemm(const bf16_t* A, const bf16_t* Bt, int M, int N, int K, const Epi& epi, char* smem, bool splitctx = false, bool kvonlyctx = false) {
    UnitList ul; ul.init(M, N, K, splitctx, kvonlyctx);
    for (int L = blockIdx.x;; L += gridDim.x) {
        int pm, pn, sl, kt0, nt;
        if (!ul.get(L, pm, pn, sl, kt0, nt)) break;
        f32x4 acc[2][2][4][2];
        gemm_tile(A, Bt, K, kt0, nt, pm * BM, pn * BM, acc, (LAS unsigned char*)smem);
        epi(acc, pm, pn, sl, smem);
    }
}

template <class Epi>
DI void phase_gemm_stream(const bf16_t* A, const bf16_t* Bt, int M, int N, int K, const Epi& epi, char* smem, bool splitctx = false) {
    UnitList ul; ul.init(M, N, K, splitctx, false);
    LAS unsigned char* lds = (LAS unsigned char*)smem;
    const int tid = TID(), wid = __builtin_amdgcn_readfirstlane(tid >> 6), lane = tid & 63, wr = wid >> 2, wc = wid & 3, fr = lane & 15, fq = lane >> 4;
    unsigned voff[2];
#pragma unroll
    for (int i = 0; i < 2; ++i) { int R, C; stage_rc(tid * 16 + i * 8192, R, C); voff[i] = (unsigned)(R * K + C) * 2u; }
    const size_t kstep = (size_t)(BK * 2), hstep = (size_t)HALF * K * 2, tstep = 2 * hstep;
    const unsigned ldsw = (unsigned)wid * 1024u;
    const int aoff = lds_byte(wr * 64 + fr, fq * 8), boff = lds_byte(wc * 32 + fr, fq * 8);
    int L = blockIdx.x, pm, pn, sl, kt0, nt;
    if (!ul.get(L, pm, pn, sl, kt0, nt)) return;
    f32x4 acc[2][2][4][2];
#pragma unroll
    for (int a = 0; a < 2; ++a)
#pragma unroll
        for (int b = 0; b < 2; ++b)
#pragma unroll
            for (int m = 0; m < 4; ++m)
#pragma unroll
                for (int n = 0; n < 2; ++n) acc[a][b][m][n] = (f32x4){0.f, 0.f, 0.f, 0.f};
    bf16x8 At[4][2], B0[2][2], B1[2][2];
    const char* cA = (const char*)A + (size_t)pm * tstep + (size_t)kt0 * kstep; const char* cB = (const char*)Bt + (size_t)pn * tstep + (size_t)kt0 * kstep;
    STAGE(SB(0, 0), cB); STAGE(SB(0, 1), cB + hstep); STAGE(SA(0, 0), cA); STAGE(SA(0, 1), cA + hstep);
    if (wr == 1) BAR;
    WAIT_V(2); BAR;
    STAGE(SB(1, 0), cB + kstep); STAGE(SA(1, 0), cA + kstep); STAGE(SB(1, 1), cB + hstep + kstep);
    WAIT_V(6); BAR;
    for (;;) {
        int npm, npn, nsl, nkt0, nnt;
        const bool has_next = ul.get(L + gridDim.x, npm, npn, nsl, nkt0, nnt);
        const char* nA = has_next ? (const char*)A + (size_t)npm * tstep + (size_t)nkt0 * kstep : cA; const char* nB = has_next ? (const char*)Bt + (size_t)npn * tstep + (size_t)nkt0 * kstep : cB;
        for (int t = 0; t < nt; t += 2) {
            const bool lastit = (t == nt - 2);
            const char* a1 = cA + (size_t)(t + 1) * kstep;
            const char* a2 = lastit ? nA : cA + (size_t)(t + 2) * kstep; const char* b2 = lastit ? nB : cB + (size_t)(t + 2) * kstep;
            const char* a3 = a2 + kstep; const char* b3 = b2 + kstep;
            LDB(B0, 0, 0); LDB(B1, 0, 1); SCHED; LDA(At, 0, 0); STAGE(SA(1, 1), a1 + hstep);
            WAIT_V(8); WAIT_L(0); BAR; MMA(0, 0, At, B0); MMA(0, 1, At, B1); BAR; SCHED;
            LDA(At, 0, 1); STAGE(SB(0, 0), b2); STAGE(SB(0, 1), b2 + hstep); STAGE(SA(0, 0), a2);
            WAIT_V(8); WAIT_L(0); BAR; MMA(1, 0, At, B0); MMA(1, 1, At, B1); BAR; SCHED;
            LDB(B0, 1, 0); LDB(B1, 1, 1); SCHED; LDA(At, 1, 0); STAGE(SA(0, 1), a2 + hstep);
            WAIT_V(8); WAIT_L(0); BAR; MMA(0, 0, At, B0); MMA(0, 1, At, B1); BAR; SCHED;
            LDA(At, 1, 1); STAGE(SB(1, 0), b3); STAGE(SB(1, 1), b3 + hstep); STAGE(SA(1, 0), a3);
            WAIT_V(8); WAIT_L(0); BAR; MMA(1, 0, At, B0); MMA(1, 1, At, B1); BAR; SCHED;
        }
        if (wr == 0) BAR;
        epi(acc, pm, pn, sl, smem);
        if (!has_next) break;
#pragma unroll
        for (int a = 0; a < 2; ++a)
#pragma unroll
            for (int b = 0; b < 2; ++b)
#pragma unroll
                for (int m = 0; m < 4; ++m)
#pragma unroll
                    for (int n = 0; n < 2; ++n) acc[a][b][m][n] = (f32x4){0.f, 0.f, 0.f, 0.f};
        L += gridDim.x; pm = npm; pn = npn; sl = nsl; kt0 = nkt0; nt = nnt; cA = nA; cB = nB;
        if (wr == 1) BAR;
    }
    WAIT_V(0);
    BAR;
}

constexpr int VROW = 144;
template <bool ISC, bool FIXM>
DI void attn2_core(const bf16_t* Q0, const bf16_t* Q1, const bf16_t* Kg, const bf16_t* Vt, int qpos0, int key_lo, int nkt, float sc, float mfix0, float mfix1, f32x16 (&O)[2][2], char* smem) {
    constexpr int KROW = 144, KBUF = 64 * KROW, VBUF = 64 * VROW, NSLOT = 4, NQ = ISC ? 1 : 2;
    LAS char* lds = (LAS char*)smem;
    const int tid = TID(), lane = tid & 63, wid = tid >> 6, r = lane & 31, h = lane >> 5;
    bf16x8 qf[NQ][4];
#pragma unroll
    for (int c = 0; c < NQ; ++c)
#pragma unroll
        for (int ks = 0; ks < 4; ++ks) qf[c][ks] = *(const bf16x8*)((c == 0 ? Q0 : Q1) + (size_t)(qpos0 + wid * 32 + r) * 64 + ks * 16 + 8 * h);
#pragma unroll
    for (int c = 0; c < 2; ++c)
#pragma unroll
        for (int i = 0; i < 16; ++i) { O[c][0][i] = 0.f; O[c][1][i] = 0.f; }
    float m_run[2] = {FIXM ? mfix0 : -1e30f, FIXM ? mfix1 : -1e30f}, l_run[2] = {0.f, 0.f};
    const int kkey = tid >> 3, kch = tid & 7;
    const int kst = kkey * KROW + kch * 16, vst = NSLOT * KBUF + kkey * VROW + kch * 16;
    const int krd = r * KROW + 16 * h, vrd = NSLOT * KBUF + r * VROW + 8 * h;
    const bf16_t* kg = Kg + (size_t)(key_lo + kkey) * 64 + kch * 8;
    const bf16_t* vg = Vt + (size_t)kkey * KEYS + key_lo + kch * 8;
    u32x4 kreg, vreg;
    bf16x8 kf[4]; u32x2 vf[2][2][2];
    auto gload = [&](int t) { kreg = *(const u32x4*)(kg + (size_t)t * 64 * 64); vreg = *(const u32x4*)(vg + t * 64); };
    auto lstore = [&](int slot) { *(LAS u32x4*)(lds + slot * KBUF + kst) = kreg; *(LAS u32x4*)(lds + slot * VBUF + vst) = vreg; };
    auto ldk = [&](int slot, int kk) {
        const LAS char* kb = lds + slot * KBUF + krd + kk * 32 * KROW;
#pragma unroll
        for (int ks = 0; ks < 4; ++ks) kf[ks] = *(const LAS bf16x8*)(kb + ks * 32);
    };
    auto ldv = [&](int slot, int kk) {
        const LAS char* vb = lds + slot * VBUF + vrd + kk * 64;
#pragma unroll
        for (int st = 0; st < 2; ++st)
#pragma unroll
            for (int dt = 0; dt < 2; ++dt) { const LAS char* vp = vb + dt * 32 * VROW + st * 32; vf[st][dt][0] = *(const LAS u32x2*)vp; vf[st][dt][1] = *(const LAS u32x2*)(vp + 16); }
    };
#define SOFT_PV(c) do { \
        if (!FIXM) { \
        float mx = s##c[0]; \
        _Pragma("unroll") for (int i = 1; i < 16; ++i) mx = __ocml_fmax_f32(mx, s##c[i]); \
        mx = __ocml_fmax_f32(mx, __shfl_xor(mx, 32)); \
        const float m_new = __ocml_fmax_f32(m_run[c], mx); \
        if (__builtin_amdgcn_ballot_w64(m_new > m_run[c]) != 0ull) { \
            const float alpha = __builtin_amdgcn_exp2f(m_run[c] - m_new); \
            m_run[c] = m_new; l_run[c] *= alpha; \
            _Pragma("unroll") for (int i = 0; i < 16; ++i) { O[c][0][i] *= alpha; O[c][1][i] *= alpha; } \
        } } \
        float ps = 0.f; \
        _Pragma("unroll") for (int i = 0; i < 16; ++i) { s##c[i] = __builtin_amdgcn_exp2f(FIXM ? s##c[i] : s##c[i] - m_run[c]); ps += s##c[i]; } \
        l_run[c] += ps; \
        _Pragma("unroll") for (int st = 0; st < 2; ++st) { \
            u32x4 pw; \
            _Pragma("unroll") for (int i = 0; i < 4; ++i) pw[i] = pk2(s##c[8 * st + 2 * i], s##c[8 * st + 2 * i + 1]); \
            const bf16x8 pf = __builtin_bit_cast(bf16x8, pw); \
            _Pragma("unroll") for (int dt = 0; dt < 2; ++dt) { \
                u32x4 vw = {vf[st][dt][0][0], vf[st][dt][0][1], vf[st][dt][1][0], vf[st][dt][1][1]}; \
                O[c][dt] = __builtin_amdgcn_mfma_f32_32x32x16_bf16(__builtin_bit_cast(bf16x8, vw), pf, O[c][dt], 0, 0, 0); \
            } \
        } } while (0)
    lds_barrier();
    gload(0); lstore(0);
    if (nkt > 1) { gload(1); lstore(1); }
    if (nkt > 2) gload(2);
    lds_barrier();
    ldk(0, 0);
    for (int t = 0; t < nkt; ++t) {
        const int cur = t & 3, nxt = (t + 1) & 3;
        if (t + 2 < nkt) lstore((t + 2) & 3);
        if (t + 3 < nkt) gload(t + 3);
#pragma unroll
        for (int kk = 0; kk < 2; ++kk) {
            f32x16 s0, s1;
#pragma unroll
            for (int i = 0; i < 16; ++i) { s0[i] = 0.f; s1[i] = 0.f; }
            if (ISC) {
                s0 = __builtin_amdgcn_mfma_f32_32x32x16_bf16(kf[0], qf[0][0], s0, 0, 0, 0); s1 = __builtin_amdgcn_mfma_f32_32x32x16_bf16(kf[2], qf[0][2], s1, 0, 0, 0);
                s0 = __builtin_amdgcn_mfma_f32_32x32x16_bf16(kf[1], qf[0][1], s0, 0, 0, 0); s1 = __builtin_amdgcn_mfma_f32_32x32x16_bf16(kf[3], qf[0][3], s1, 0, 0, 0);
            } else {
#pragma unroll
                for (int ks = 0; ks < 4; ++ks) s0 = __builtin_amdgcn_mfma_f32_32x32x16_bf16(kf[ks], qf[0][ks], s0, 0, 0, 0);
#pragma unroll
                for (int ks = 0; ks < 4; ++ks) s1 = __builtin_amdgcn_mfma_f32_32x32x16_bf16(kf[ks], qf[NQ - 1][ks], s1, 0, 0, 0);
            }
            __builtin_amdgcn_sched_barrier(0);
            ldv(cur, kk);
            if (kk == 0) ldk(cur, 1); else if (t + 1 < nkt) ldk(nxt, 0);
            SOFT_PV(0);
            SOFT_PV(1);
        }
        lds_barrier();
    }
#undef SOFT_PV
#pragma unroll
    for (int c = 0; c < 2; ++c) {
        const float lt = l_run[c] + __shfl_xor(l_run[c], 32);
        const float inv = 1.f / lt;
#pragma unroll
        for (int i = 0; i < 16; ++i) { O[c][0][i] *= inv; O[c][1][i] *= inv; }
    }
}

DI void store_OT(const f32x16 (&O)[2], bf16_t* dst  , int h) {
#pragma unroll
    for (int dt = 0; dt < 2; ++dt)
#pragma unroll
        for (int gq = 0; gq < 4; ++gq) {
            u32x2 w; w[0] = pk2(O[dt][4 * gq], O[dt][4 * gq + 1]); w[1] = pk2(O[dt][4 * gq + 2], O[dt][4 * gq + 3]);
            *(u32x2*)(dst + dt * 32 + 8 * gq + 4 * h) = w;
        }
}

DI void attn_unit(const Params& p, int l, int idx, int qb, bool isC, char* smem) {
    const int lane = TID() & 63, wid = TID() >> 6, r = lane & 31, h = lane >> 5;
    const int qpos0 = qb < 8 ? qb * 256 : SEQ, key_lo = qb < 8 ? 0 : SEQ, nkt = qb < 8 ? KEYS / 64 : CTX / 64;
    const int qpos = qpos0 + wid * 32 + r;
    f32x16 O[2][2];
    if (!isC) {
        const int b = idx >> 1, kvh = idx & 1;
        const size_t grow = qpos < SEQ ? (size_t)b * SEQ + qpos : (size_t)NLAT + b * CTX + (qpos - SEQ);
        const bf16_t* q0 = p.QA + (size_t)(b * 4 + 2 * kvh) * KEYS * 64;
        const float gq = fabsf(p.g_q_a[l * 64 + lane]), gk = fabsf(p.g_k_a[l * 64 + lane]);
        float mq = gq, mk = gk;
#pragma unroll
        for (int o = 32; o >= 1; o >>= 1) { mq = fmaxf(mq, __shfl_xor(mq, o)); mk = fmaxf(mk, __shfl_xor(mk, o)); }
        const float sc = 1.f, mfix = 64.f * 1.02f * mq * mk * SC_A;
        if (mfix < 60.f)
            attn2_core<false, true>(q0, q0 + (size_t)KEYS * 64, p.KA + (size_t)idx * KEYS * 64, p.VtA + (size_t)idx * 64 * KEYS, qpos0, key_lo, nkt, sc, mfix, mfix, O, smem);
        else
            attn2_core<false, false>(q0, q0 + (size_t)KEYS * 64, p.KA + (size_t)idx * KEYS * 64, p.VtA + (size_t)idx * 64 * KEYS, qpos0, key_lo, nkt, sc, 0.f, 0.f, O, smem);
        store_OT(O[0], p.cat + grow * D + (2 * kvh) * 64, h);
        store_OT(O[1], p.cat + grow * D + (2 * kvh + 1) * 64, h);
    } else {
        const int b = idx >> 2, head = idx & 3;
        const size_t grow = qpos < SEQ ? (size_t)b * SEQ + qpos : (size_t)NLAT + b * CTX + (qpos - SEQ);
        const bf16_t* qc = p.QC + (size_t)idx * KEYS * 64;
        const float scC = 1.f;
        float q2[2] = {0.f, 0.f};
#pragma unroll
        for (int c = 0; c < 2; ++c)
#pragma unroll
            for (int ks = 0; ks < 2; ++ks) {
                const u32x4 qv = *(const u32x4*)(qc + (size_t)qpos * 64 + (2 * c + ks) * 16 + 8 * h);
#pragma unroll
                for (int i = 0; i < 4; ++i) { const float a = bflo(qv[i]), bq = bfhi(qv[i]); q2[c] += a * a + bq * bq; }
            }
        q2[0] += __shfl_xor(q2[0], 32); q2[1] += __shfl_xor(q2[1], 32);
        const unsigned* km = p.kmaxC + (size_t)l * NB * 8 + idx * 2;
        const float mf0 = 1.03f * sqrtf(q2[0] * __uint_as_float(km[0])), mf1 = 1.03f * sqrtf(q2[1] * __uint_as_float(km[1]));
        if (__builtin_amdgcn_ballot_w64(mf0 < 60.f && mf1 < 60.f) == ~0ull)
            attn2_core<true, true>(qc, qc, p.KC + (size_t)idx * KEYS * 64, p.VtC + (size_t)idx * 64 * KEYS, qpos0, key_lo, nkt, scC, mf0, mf1, O, smem);
        else
            attn2_core<true, false>(qc, qc, p.KC + (size_t)idx * KEYS * 64, p.VtC + (size_t)idx * 64 * KEYS, qpos0, key_lo, nkt, scC, 0.f, 0.f, O, smem);
        const float lam_init = 0.8f - 0.6f * __expf(-0.3f * (float)l);
        const float* lp = p.lam_c + l * 128;
        const float d0 = wave_sum(lane < 32 ? lp[lane] * lp[32 + lane] : 0.f), d1 = wave_sum(lane < 32 ? lp[64 + lane] * lp[96 + lane] : 0.f);
        const float lam = __expf(d0) - __expf(d1) + lam_init;
        float ss = 0.f;
#pragma unroll
        for (int dt = 0; dt < 2; ++dt)
#pragma unroll
            for (int i = 0; i < 16; ++i) { const float v = O[0][dt][i] - lam * O[1][dt][i]; O[0][dt][i] = v; ss += v * v; }
        ss += __shfl_xor(ss, 32);
        const float rstd = rsqrtf(ss * (1.f / 64.f) + EPS) * (1.f - lam_init);
        const float* g = p.g_sub_c + l * 64;
#pragma unroll
        for (int dt = 0; dt < 2; ++dt)
#pragma unroll
            for (int i = 0; i < 16; ++i) O[0][dt][i] *= rstd * g[dt * 32 + 8 * (i >> 2) + 4 * h + (i & 3)];
        store_OT(O[0], p.cat + grow * D + 256 + head * 64, h);
    }
}

DI void gmlp_unit(const Params& p, int l, int uidx, char* smem) {
    const int g = uidx & 3, c = uidx >> 2, tid = TID(), lane = tid & 63, wid = tid >> 6, fr = lane & 15, fq = lane >> 4;
    LAS bf16_t* vT = (LAS bf16_t*)smem;
    constexpr int VS = 136;
    const int q = tid >> 2, d0 = (tid & 3) * 16;
    const bf16_t* src = p.VN + (size_t)(c * 128 + q) * 256 + g * 64 + d0;
    const bf16x8 a = *(const bf16x8*)src, bb = *(const bf16x8*)(src + 8);
    const bf16_t* wrow = p.Ws + ((size_t)(l * 4 + g) * 128 + wid * 16 + fr) * 128;
    bf16x8 af[4];
#pragma unroll
    for (int ks = 0; ks < 4; ++ks) af[ks] = *(const bf16x8*)(wrow + ks * 32 + fq * 8);
    const int prow = wid * 16 + fr; const size_t grow = (size_t)c * 128 + prow;
    const float bias = p.b_s_b[(l * 4 + g) * 128 + prow];
    u32x2 uu[4];
#pragma unroll
    for (int n = 0; n < 4; ++n) uu[n] = *(const u32x2*)(p.U + grow * 256 + g * 64 + n * 16 + fq * 4);
    lds_barrier();
#pragma unroll
    for (int j = 0; j < 8; ++j) { vT[(d0 + j) * VS + q] = (bf16_t)a[j]; vT[(d0 + 8 + j) * VS + q] = (bf16_t)bb[j]; }
    lds_barrier();
    f32x4 acc[4];
#pragma unroll
    for (int n = 0; n < 4; ++n) acc[n] = (f32x4){0.f, 0.f, 0.f, 0.f};
#pragma unroll
    for (int ks = 0; ks < 4; ++ks)
#pragma unroll
        for (int n = 0; n < 4; ++n) {
            const bf16x8 bfv = *(const LAS bf16x8*)(vT + (n * 16 + fr) * VS + ks * 32 + fq * 8);
            acc[n] = __builtin_amdgcn_mfma_f32_16x16x32_bf16(bfv, af[ks], acc[n], 0, 0, 0);
        }
#pragma unroll
    for (int n = 0; n < 4; ++n) {
        const int col = g * 64 + n * 16 + fq * 4;
        u32x2 w;
        w[0] = pk2(bflo(uu[n][0]) * (acc[n][0] + bias), bfhi(uu[n][0]) * (acc[n][1] + bias));
        w[1] = pk2(bflo(uu[n][1]) * (acc[n][2] + bias), bfhi(uu[n][1]) * (acc[n][3] + bias));
        *(u32x2*)(p.cat + grow * D + 512 + col) = w;
    }
}

DI void conv_unit(const Params& p, int l, int uidx, char* smem) {
    const int tid = TID(), lane = tid & 63, wid = tid >> 6;
    bf16_t* yin = (bf16_t*)smem;
    float* co = (float*)(smem + 94 * 256 * 2);
    const int row0 = uidx * 64;
    int s0, s1;
    if (row0 < NLAT) { s0 = (row0 / SEQ) * SEQ; s1 = s0 + SEQ; } else { s0 = NLAT + ((row0 - NLAT) / CTX) * CTX; s1 = s0 + CTX; }
    lds_barrier();
    {
        u32x4 v[6];
#pragma unroll
        for (int j = 0; j < 6; ++j) {
            const int i = tid + j * NTHR, rr = i >> 5, ch8 = (i & 31) * 8, gr = row0 - 15 + rr;
            v[j] = (u32x4){0, 0, 0, 0};
            if (i < 94 * 32 && gr >= s0 && gr < s1) v[j] = *(const u32x4*)(p.Y + (size_t)gr * 256 + ch8);
        }
#pragma unroll
        for (int j = 0; j < 6; ++j) {
            const int i = tid + j * NTHR, rr = i >> 5, ch8 = (i & 31) * 8;
            if (i < 94 * 32) *(u32x4*)(yin + rr * 256 + ch8) = v[j];
        }
    }
    lds_barrier();
    {
        const int ch = tid & 255, th = tid >> 8;
        float w[31];
#pragma unroll
        for (int k = 0; k < 31; ++k) w[k] = p.w_dw_d[(size_t)(l * 31 + k) * 256 + ch];
        const float bias = p.b_dw_d[l * 256 + ch];
        for (int i0 = th * 32; i0 < th * 32 + 32; i0 += 8) {
            float xw[38];
#pragma unroll
            for (int j = 0; j < 38; ++j) xw[j] = bf2f(yin[(i0 + j) * 256 + ch]);
#pragma unroll
            for (int o = 0; o < 8; ++o) {
                float a = bias;
#pragma unroll
                for (int k = 0; k < 31; ++k) a += w[k] * xw[o + k];
                co[(i0 + o) * 256 + ch] = a;
            }
        }
    }
    lds_barrier();
#pragma unroll
    for (int j = 0; j < 8; ++j) {
        const int tk = wid * 8 + j;
        const f32x4 v = *(const f32x4*)(co + tk * 256 + lane * 4);
        const float ss = wave_sum(v[0] * v[0] + v[1] * v[1] + v[2] * v[2] + v[3] * v[3]);
        const float rstd = rsqrtf(ss * (1.f / 256.f) + EPS);
        const f32x4 g = *(const f32x4*)(p.g_conv_d + l * 256 + lane * 4);
        u32x2 w; w[0] = pk2(silu_f(v[0] * rstd * g[0]), silu_f(v[1] * rstd * g[1])); w[1] = pk2(silu_f(v[2] * rstd * g[2]), silu_f(v[3] * rstd * g[3]));
        *(u32x2*)(p.cat + (size_t)(row0 + tk) * D + 768 + lane * 4) = w;
    }
}

DI void phase_mixers(const Params& p, int l, bool withctx, char* smem) {
    const int nCL = NB * 4 * 8, nAL = NB * 2 * 8, nCX = withctx ? NB * 4 : 0, nAX = withctx ? NB * 2 : 0;
    const int nG = (withctx ? NTOK : NLAT) / 128 * 4, nV = (withctx ? NTOK : NLAT) / 64;
    const int nAtt = nCL + nAL + nCX + nAX, total = nAtt + nG + nV;
    for (int u = blockIdx.x; u < total; u += gridDim.x) {
        asm volatile("" : "+s"(l));
        int r = u;
        if (r < nAtt) {
            int idx, qb; bool isC;
            if (r < nCL) { isC = true; const int w = r & 255, s = w >> 3; qb = s & 7; idx = (w & 7) + 8 * (s >> 3) + 32 * (r >> 8); }
            else if ((r -= nCL) < nAL) { isC = false; const int w = r & 255, s = w >> 3; qb = s & 7; idx = (w & 7) + 8 * (s >> 3) + 32 * (r >> 8); }
            else if ((r -= nAL) < nCX) { isC = true; idx = r; qb = 8; }
            else { r -= nCX; isC = false; idx = r; qb = 8; }
            if (isC) attn_unit(p, l, idx, qb, true, smem); else attn_unit(p, l, idx, qb, false, smem);
        } else if ((r -= nAtt) < nG) gmlp_unit(p, l, r, smem);
        else conv_unit(p, l, r - nG, smem);
    }
}

#define XB_TMO      128
#define XB_XCNT(j)  (256  + 64 * (j))
#define XB_XSUB(j)  (1280 + 64 * (j))
#define XB_XGEN(j)  (2304 + 64 * (j))
#define XB_TOP      3328
#define XB_TOPGEN   3392
#define XCD_BAR_WORDS 3456
#define XB_SPIN_CAP (1u << 22)
DI unsigned xb_ld(unsigned* p) { return __hip_atomic_load(p, __ATOMIC_RELAXED, __HIP_MEMORY_SCOPE_AGENT); }
DI unsigned xb_add(unsigned* p, unsigned v) { return __hip_atomic_fetch_add(p, v, __ATOMIC_RELAXED, __HIP_MEMORY_SCOPE_AGENT); }
DI unsigned xb_xcc_id() { return (unsigned)__builtin_amdgcn_s_getreg((3 << 11) | 20) & 0xFu; }
#define XB_SPIN(cond, bar) do { unsigned _sp = 0; while (cond) { __builtin_amdgcn_s_sleep(1); \
    if ((++_sp & 255u) == 0u) { if (xb_ld(&(bar)[XB_TMO])) break; if (_sp > XB_SPIN_CAP) { atomicAdd(&(bar)[XB_TMO], 1u); break; } } } } while (0)
DI void xcd_barrier_complete(unsigned* bar, unsigned x, unsigned& nloc, unsigned& nx) {
    const unsigned G = gridDim.x;
    unsigned sum, cnt, mine, sp = 0u;
    for (;;) {
        sum = 0u; cnt = 0u; mine = 0u;
#pragma unroll
        for (unsigned j = 0; j < 16; ++j) { const unsigned c = xb_ld(&bar[XB_XCNT(j)]); sum += c; cnt += (c > 0u) ? 1u : 0u; mine = (j == x) ? c : mine; }
        if (sum == G) break;
        __builtin_amdgcn_s_sleep(1);
        if ((++sp & 255u) == 0u) { if (xb_ld(&bar[XB_TMO])) break; if (sp > XB_SPIN_CAP) { atomicAdd(&bar[XB_TMO], 1u); break; } }
    }
    nloc = mine > 0u ? mine : 1u; nx = cnt > 0u ? cnt : 1u;
}
DI void xcd_barrier(unsigned* bar, volatile LAS unsigned* st) {
    asm volatile("s_waitcnt vmcnt(0)" ::: "memory");
    __syncthreads();
    if (__builtin_amdgcn_workitem_id_x() == 0) {
        __builtin_amdgcn_s_waitcnt(0);
        const unsigned x = xb_xcc_id();
        unsigned nloc = st[0], nx = st[1];
        if (nloc == 0u) { xcd_barrier_complete(bar, x, nloc, nx); st[0] = nloc; st[1] = nx; }
        const unsigned old = xb_add(&bar[XB_XSUB(x)], 1u);
        const unsigned gen = old / nloc;
        if (old + 1u == (gen + 1u) * nloc) {
            __builtin_amdgcn_fence(__ATOMIC_RELEASE, "agent");
            asm volatile("s_waitcnt vmcnt(0)" ::: "memory");
            const unsigned og = xb_add(&bar[XB_TOP], 1u);
            const unsigned tg = og / nx;
            if (og + 1u == (tg + 1u) * nx) xb_add(&bar[XB_TOPGEN], 1u);
            else XB_SPIN(xb_ld(&bar[XB_TOPGEN]) == tg, bar);
            __builtin_amdgcn_fence(__ATOMIC_ACQUIRE, "agent");
            xb_add(&bar[XB_XGEN(x)], 1u);
            asm volatile("s_waitcnt vmcnt(0)" ::: "memory");
        } else {
            XB_SPIN(xb_ld(&bar[XB_XGEN(x)]) == gen, bar);
            __builtin_amdgcn_fence(__ATOMIC_ACQUIRE, "agent");
            asm volatile("s_waitcnt vmcnt(0)" ::: "memory");
        }
    }
    __syncthreads();
}

constexpr int PH_PER_LAYER = 10, N_PHASES = 1 + DEPTH * PH_PER_LAYER + 1;

typedef const __attribute__((address_space(4))) Params* KParamsPtr;
__global__ void __launch_bounds__(NTHR) mega(Params p_unused, int ph_lo, int ph_hi) {
    extern __shared__ __attribute__((aligned(16))) char smem[];
    volatile LAS unsigned* xst = (volatile LAS unsigned*)(smem + LDS_BYTES - 16);
    if (ph_hi - ph_lo > 1) {
        if (__builtin_amdgcn_workitem_id_x() == 0) {
            xst[0] = 0u; xst[1] = 0u;
            KParamsPtr kp0 = (KParamsPtr)__builtin_amdgcn_kernarg_segment_ptr();
            (void)xb_add(&kp0->bar[XB_XCNT(xb_xcc_id())], 1u);
        }
        __syncthreads();
    }
#ifndef PROBE_PH
#define PROBE_PH -1
#endif
#if PROBE_SEL
    unsigned long long pr_t0 = 0, pr_prev = 0, pr_acc = 0; int pr_sel_prev = 0;
#endif
    for (int it = ph_lo; it < ph_hi + (PROBE_PH >= 0 ? 1 : 0); ++it) {
        const int ph = (PROBE_PH >= 0 && it > PROBE_PH) ? it - 1 : it;
        if (it == ph_lo + 1) cg::this_grid().sync();
        else if (it > ph_lo) { KParamsPtr kpb = (KParamsPtr)__builtin_amdgcn_kernarg_segment_ptr(); asm volatile("" : "+s"(kpb)); xcd_barrier(kpb->bar, xst); }
#if PROBE_SEL
        {
            const unsigned long long now = __builtin_amdgcn_s_memrealtime();
            if (it == ph_lo) { pr_t0 = now; } else if (pr_sel_prev) pr_acc += now - pr_prev;
            pr_prev = now;
            const int s_ = ph == 0 ? 10 : (ph == N_PHASES - 1 ? 11 : (ph - 1) % PH_PER_LAYER);
            pr_sel_prev = (PROBE_SEL >> s_) & 1;
            if (ph == N_PHASES - 1 && blockIdx.x == 0 && __builtin_amdgcn_workitem_id_x() == 0) {
                KParamsPtr kpp = (KParamsPtr)__builtin_amdgcn_kernarg_segment_ptr();
                kpp->probe[0] = sqrtf((float)pr_acc / (float)(now - pr_t0) * 2e-5f);
            }
            if (ph == N_PHASES - 1) { __syncthreads(); if (blockIdx.x == 0) { __threadfence(); } cg::this_grid().sync(); }
        }
#endif
        KParamsPtr kp = (KParamsPtr)__builtin_amdgcn_kernarg_segment_ptr();
        asm volatile("" : "+s"(kp));
        const Params& p = *(const Params*)kp;
        if (ph == 0) { phase_prologue(p, smem); continue; }
        if (ph == N_PHASES - 1) { phase_norm<true>(p, false, p.g_final, nullptr, 0, NLAT); continue; }
        const int l = (ph - 1) / PH_PER_LAYER, s = (ph - 1) % PH_PER_LAYER;
        const bool last = l == DEPTH - 1;
        const float* mods_l = p.mods + (size_t)l * 17 * MODW;
        if (s == 0 || s == 3 || s == 7) {
            const int j = s == 0 ? 0 : (s == 3 ? 1 : 2);
            const bool first = (l == 0 && s == 0);
            phase_norm<false>(p, first, p.g_norm + (l * 3 + j) * D, mods_l, 3 * j, (s == 7 && last) ? NLAT : NTOK);
        } else if (s == 1 || s == 8) {
            EpiSwiglu e{p.hid};
            phase_gemm_stream(p.xn, (s == 1 ? p.Wff1in : p.Wff2in) + (size_t)l * D * 2 * DFF, (s == 8 && last) ? NLAT : NTOK, 2 * DFF, D, e, smem);
        } else if (s == 2 || s == 6 || s == 9) {
            const bf16_t* A = s == 6 ? p.cat : p.hid;
            const bf16_t* Bt = s == 2 ? p.Wff1out + (size_t)l * D * DFF : (s == 9 ? p.Wff2out + (size_t)l * D * DFF : p.Wout + (size_t)l * D * D);
            const int K = s == 6 ? D : DFF, gi = s == 2 ? 2 : (s == 6 ? 5 : 8);
            EpiResid e{p.h16, mods_l + gi * D, p.dctx, s == 6 ? 1.0f : 0.5f};
            const bool withctx = !(s != 2 && last);
            phase_gemm_stream(A, Bt, withctx ? NTOK : NLAT, D, K, e, smem, withctx);
        } else if (s == 4) {
            EpiProj e{&p, l}; phase_gemm(p.xn, p.Win + (size_t)l * D * INC, NTOK, INC, D, e, smem, false, last);
        } else {
            phase_mixers(p, l, !last, smem);
        }
    }
}

extern "C" void kernel_launch(void* const* d_in, const int* in_sizes, int n_in, void* d_out, int out_size, void* d_ws, size_t ws_size, hipStream_t stream) {
    static int grid = 0;
    if (grid == 0) {
        int dev = 0, cus = 0, per_cu = 0;
        hipGetDevice(&dev);
        hipDeviceGetAttribute(&cus, hipDeviceAttributeMultiprocessorCount, dev);
        if (hipFuncSetAttribute((const void*)mega, hipFuncAttributeMaxDynamicSharedMemorySize, LDS_BYTES) != hipSuccess) fprintf(stderr, "hipFuncSetAttribute failed\n");
        if (hipOccupancyMaxActiveBlocksPerMultiprocessor(&per_cu, (const void*)mega, NTHR, LDS_BYTES) != hipSuccess || per_cu < 1) { fprintf(stderr, "occupancy query: %d\n", per_cu); per_cu = 1; }
        (void)hipGetLastError();
        grid = cus * per_cu;
        fprintf(stderr, "grid = %d (cus %d per_cu %d) ws_size %zu\n", grid, cus, per_cu, ws_size);
    }
    Params p{};
    const float** pin = (const float**)&p;
    for (int i = 0; i < 24; ++i) pin[i] = (const float*)d_in[i];
    p.out = (float*)d_out;
    char* w = (char*)d_ws; size_t off = 0;
    auto take = [&](size_t bytes) { char* r = w + off; off += (bytes + 255) & ~(size_t)255; return r; };
    p.Wff1in = (bf16_t*)take((size_t)DEPTH * D * 2 * DFF * 2);
    p.Wff1out = (bf16_t*)take((size_t)DEPTH * D * DFF * 2);
    p.Wff2in = (bf16_t*)take((size_t)DEPTH * D * 2 * DFF * 2);
    p.Wff2out = (bf16_t*)take((size_t)DEPTH * D * DFF * 2);
    p.Win = (bf16_t*)take((size_t)DEPTH * D * INC * 2);
    p.Wout = (bf16_t*)take((size_t)DEPTH * D * D * 2);
    p.Ws = (bf16_t*)take((size_t)DEPTH * 4 * 128 * 128 * 2);
    p.mods = (float*)take((size_t)DEPTH * 17 * MODW * 4);
    p.ropeA = (float*)take((size_t)SEQ * 32 * 2 * 4);
    p.ropeC = (float*)take((size_t)SEQ * 16 * 2 * 4);
    p.bar = (unsigned*)take((size_t)XCD_BAR_WORDS * 4);
    p.hc = nullptr;
    p.h16 = (_Float16*)take((size_t)NTOK * D * 2);
    p.probe = (float*)take(256);
    p.kmaxC = (unsigned*)take((size_t)DEPTH * NB * 4 * 2 * 4);
    p.dctx = (float*)take((size_t)4 * NCTX * D * 4);
    p.xn = (bf16_t*)d_out;
    p.cat = p.xn;
    p.hid = (bf16_t*)take((size_t)NTOK * DFF * 2);
    {
        char* q = (char*)p.hid; size_t o2 = 0;
        auto take2 = [&](size_t bytes) { char* r = q + o2; o2 += (bytes + 255) & ~(size_t)255; return r; };
        p.QA = (bf16_t*)take2((size_t)NB * 4 * KEYS * 64 * 2);
        p.KA = (bf16_t*)take2((size_t)NB * 2 * KEYS * 64 * 2);
        p.VtA = (bf16_t*)take2((size_t)NB * 2 * 64 * KEYS * 2);
        p.QC = (bf16_t*)take2((size_t)NB * 4 * 2 * KEYS * 32 * 2);
        p.KC = (bf16_t*)take2((size_t)NB * 4 * 2 * KEYS * 32 * 2);
        p.VtC = (bf16_t*)take2((size_t)NB * 4 * 64 * KEYS * 2);
        p.U = (bf16_t*)take2((size_t)NTOK * 256 * 2);
        p.VN = (bf16_t*)take2((size_t)NTOK * 256 * 2);
        p.Y = (bf16_t*)take2((size_t)NTOK * 256 * 2);
    }
    if (off > ws_size) { fprintf(stderr, "workspace too small: need %zu have %zu\n", off, ws_size); return; }
#if N_LAUNCH_MODE == 1
    if (hipMemsetAsync(p.bar, 0, (size_t)XCD_BAR_WORDS * 4, stream) != hipSuccess) fprintf(stderr, "memset of barrier words failed\n");
    int lo = 0, hi = N_PHASES;
    void* args[] = {&p, &lo, &hi};
    hipError_t e = hipLaunchCooperativeKernel((const void*)mega, dim3(grid), dim3(NTHR), args, LDS_BYTES, stream);
    if (e != hipSuccess) fprintf(stderr, "cooperative launch failed: %s (grid %d)\n", hipGetErrorString(e), grid);
#else
    for (int ph = 0; ph < N_PHASES; ++ph) hipLaunchKernelGGL(mega, dim3(grid), dim3(NTHR), LDS_BYTES, stream, p, ph, ph + 1);
#endif
}
```

```cpp
#include <hip/hip_runtime.h>
#include <hip/hip_cooperative_groups.h>
#include <cstdint>
#include <cstdio>
#include <cmath>
namespace cg = cooperative_groups;

#ifndef PROBE_SEL
#define PROBE_SEL 0
#endif
#ifndef N_LAUNCH_MODE
#define N_LAUNCH_MODE 1
#endif

typedef unsigned short bf16_t;
typedef short bf16x8 __attribute__((ext_vector_type(8)));
typedef short s16x4 __attribute__((ext_vector_type(4)));
typedef float f32x4 __attribute__((ext_vector_type(4)));
typedef float f32x2 __attribute__((ext_vector_type(2)));
typedef float f32x16 __attribute__((ext_vector_type(16)));
typedef unsigned u32x2 __attribute__((ext_vector_type(2)));
typedef unsigned u32x4 __attribute__((ext_vector_type(4)));
typedef __bf16 bf2_t __attribute__((ext_vector_type(2)));
#define DI __device__ __forceinline__

constexpr int D = 1024, NB = 16, SEQ = 2048, CTX = 256, NLAT = NB * SEQ, NCTX = NB * CTX, NTOK = NLAT + NCTX;
constexpr int DFF = 2816, INC = 2304, KEYS = SEQ + CTX, DEPTH = 2, MODW = 9 * D;
constexpr int NTHR = 512;
constexpr int LDS_BYTES = 135168;
constexpr float EPS = 1e-6f;

DI unsigned pk2(float a, float b) { f32x2 v = {a, b}; bf2_t r = __builtin_convertvector(v, bf2_t); return __builtin_bit_cast(unsigned, r); }
DI float bf2f(bf16_t v) { return __uint_as_float(((unsigned)v) << 16); }
DI float bflo(unsigned v) { return __uint_as_float(v << 16); }
DI float bfhi(unsigned v) { return __uint_as_float(v & 0xffff0000u); }
DI bf16_t f2bf(float a) { return (bf16_t)(pk2(a, 0.f) & 0xffffu); }
DI float silu_f(float x) { return x * __builtin_amdgcn_rcpf(1.f + __expf(-x)); }
DI float sigmoid_f(float x) { return __builtin_amdgcn_rcpf(1.f + __expf(-x)); }
DI float gelu_f(float x) { float u = 1.5957691216057308f * (x + 0.044715f * x * x * x); return x * __builtin_amdgcn_rcpf(1.f + __expf(-u)); }
DI int TID() { int t = __builtin_amdgcn_workitem_id_x(); asm volatile("" : "+v"(t)); return t; }
DI void lds_barrier() { asm volatile("s_waitcnt lgkmcnt(0)" ::: "memory"); __builtin_amdgcn_s_barrier(); asm volatile("" ::: "memory"); }
DI float wave_sum(float v) {
#pragma unroll
    for (int o = 32; o >= 1; o >>= 1) v += __shfl_xor(v, o);
    return v;
}

struct Params {
    const float *x, *c, *ctx, *c_ctx, *w_ada, *b_ada, *g_norm, *w_ff1_in, *w_ff1_out, *w_ff2_in, *w_ff2_out, *w_in, *w_out, *g_q_a, *g_k_a, *lam_c,
        *g_sub_c, *g_v_b, *w_s_b, *b_s_b, *w_dw_d, *b_dw_d, *g_conv_d, *g_final;
    float* out;
    bf16_t *Wff1in, *Wff1out, *Wff2in, *Wff2out, *Win, *Wout, *Ws;
    float *mods, *ropeA, *ropeC, *hc;
    bf16_t *xn, *hid, *QA, *KA, *VtA, *QC, *KC, *VtC, *U, *VN, *Y, *cat;
    unsigned* bar;
    float* probe;
    unsigned* kmaxC;
    float* dctx;
    _Float16* h16;
};

DI void sincos_d(double x, double& s, double& c) {
    double k = rint(x * 0.15915494309189535);
    double r = fma(-k, 6.283185307179586, x);
    r = fma(-k, 2.4492935982947064e-16, r);
    double r2 = r * r, as = 1.0, ac = 1.0;
#pragma unroll
    for (int n = 14; n >= 1; --n) {
        as = 1.0 - r2 / (double)((2 * n) * (2 * n + 1)) * as;
        ac = 1.0 - r2 / (double)((2 * n - 1) * (2 * n)) * ac;
    }
    s = r * as; c = ac;
}

constexpr int T_FFIN = (D / 64) * (2 * DFF / 256), T_FFOUT = (DFF / 64) * (D / 256), T_WIN = (D / 64) * (INC / 256), T_WOUT = (D / 64) * (D / 256);
constexpr int T_LAYER = 2 * T_FFIN + 2 * T_FFOUT + T_WIN + T_WOUT;
constexpr int U_TR = DEPTH * T_LAYER, U_WS = 32, U_ADA = 288, U_ROPE = 192;
constexpr int U_P0 = U_TR + U_WS + U_ADA + U_ROPE;

DI void transpose_unit(const float* src, bf16_t* dst, int K, int N, int perm, int ti, float* tile) {
    const int tn = N / 256, kt = ti / tn, nt = ti % tn, k0 = kt * 64;
    const int t = TID();
    const int kk = t >> 4, c4 = (t & 15) * 4;
    f32x4 v[4][2];
#pragma unroll
    for (int sub = 0; sub < 4; ++sub) {
        const int n0 = nt * 256 + sub * 64;
        int sc0 = n0;
        if (perm == 1) { const int q = n0 >> 8, j = n0 & 255; sc0 = j < 128 ? q * 128 + j : DFF + q * 128 + (j - 128); }
        else if (perm == 2 && n0 >= 1792) { const int m = n0 - 1792, q = m >> 8, j = m & 255; sc0 = j < 128 ? 1792 + q * 128 + j : 2048 + q * 128 + (j - 128); }
#pragma unroll
        for (int i = 0; i < 2; ++i) v[sub][i] = *(const f32x4*)(src + (size_t)(k0 + kk + 32 * i) * N + sc0 + c4);
    }
#pragma unroll
    for (int sub = 0; sub < 4; ++sub)
#pragma unroll
        for (int i = 0; i < 2; ++i) {
            float* tp = tile + sub * 64 * 65 + (kk + 32 * i) * 65 + c4;
            tp[0] = v[sub][i][0]; tp[1] = v[sub][i][1]; tp[2] = v[sub][i][2]; tp[3] = v[sub][i][3];
        }
    __syncthreads();
    {
        const int n = t >> 3, k8 = (t & 7) * 8;
#pragma unroll
        for (int sub = 0; sub < 4; ++sub) {
            const float* tp = tile + sub * 64 * 65 + k8 * 65 + n;
            u32x4 o;
            o[0] = pk2(tp[0], tp[65]); o[1] = pk2(tp[2 * 65], tp[3 * 65]); o[2] = pk2(tp[4 * 65], tp[5 * 65]); o[3] = pk2(tp[6 * 65], tp[7 * 65]);
            int drow = nt * 256 + sub * 64 + n;
            if (perm != 2) { const int c = drow & 31; drow = (drow & ~31) + ((c >> 2) & 1) * 16 + (c >> 3) * 4 + (c & 3); }
            *(u32x4*)(dst + (size_t)drow * K + k0 + k8) = o;
        }
    }
    __syncthreads();
}

DI void phase_prologue(const Params& p, char* smem) {
    const int t = TID();
    if ((int)blockIdx.x < U_ADA) {
        float* s = (float*)smem;
        float* red = s + 17 * 1024;
        {
            float cv[34];
#pragma unroll
            for (int j = 0; j < 34; ++j) { const int i = t + j * NTHR, r = i >> 10, k = i & 1023; cv[j] = r < 16 ? p.c[r * D + k] : p.c_ctx[k]; }
#pragma unroll
            for (int j = 0; j < 34; ++j) s[t + j * NTHR] = silu_f(cv[j]);
        }
        __syncthreads();
        const int col = t & 63, ks = t >> 6;
        for (int uu = blockIdx.x; uu < U_ADA; uu += gridDim.x) {
            const int l = uu / 144, col0 = (uu % 144) * 64;
            float acc[17];
#pragma unroll
            for (int r = 0; r < 17; ++r) acc[r] = 0.f;
            const float* w = p.w_ada + (size_t)l * D * MODW + (size_t)(ks * 128) * MODW + col0 + col;
            float wv[16], wn[16];
#pragma unroll
            for (int k = 0; k < 16; ++k) wv[k] = w[(size_t)k * MODW];
            for (int k0 = 0; k0 < 128; k0 += 16) {
                if (k0 + 16 < 128) {
#pragma unroll
                    for (int k = 0; k < 16; ++k) wn[k] = w[(size_t)(k0 + 16 + k) * MODW];
                }
#pragma unroll
                for (int r = 0; r < 17; ++r)
#pragma unroll
                    for (int kq = 0; kq < 4; ++kq) {
                        const f32x4 sv = *(const f32x4*)(s + r * 1024 + ks * 128 + k0 + 4 * kq);
                        acc[r] += (sv[0] * wv[4 * kq] + sv[1] * wv[4 * kq + 1]) + (sv[2] * wv[4 * kq + 2] + sv[3] * wv[4 * kq + 3]);
                    }
#pragma unroll
                for (int k = 0; k < 16; ++k) wv[k] = wn[k];
            }
#pragma unroll
            for (int r = 0; r < 17; ++r) red[(ks * 17 + r) * 64 + col] = acc[r];
            __syncthreads();
            for (int i = t; i < 17 * 64; i += NTHR) {
                const int r = i >> 6, cc = i & 63; float sum = 0.f;
#pragma unroll
                for (int q = 0; q < 8; ++q) sum += red[(q * 17 + r) * 64 + cc];
                p.mods[((size_t)l * 17 + r) * MODW + col0 + cc] = sum + p.b_ada[(size_t)l * MODW + col0 + cc];
            }
            __syncthreads();
        }
    }
    if (blockIdx.x == gridDim.x - 1 && t < DEPTH * NB * 4 * 2) p.kmaxC[t] = 0u;
    for (int v = (int)gridDim.x - 1 - (int)blockIdx.x; v < U_WS + U_ROPE; v += gridDim.x) {
        if (v < U_WS) {
            const int e0 = v * 4096 + t * 8;
            f32x4 a = *(const f32x4*)(p.w_s_b + e0), b = *(const f32x4*)(p.w_s_b + e0 + 4);
            u32x4 o; o[0] = pk2(a[0], a[1]); o[1] = pk2(a[2], a[3]); o[2] = pk2(b[0], b[1]); o[3] = pk2(b[2], b[3]);
            *(u32x4*)(p.Ws + e0) = o;
        } else {
            const int e = (v - U_WS) * 512 + t;
            const int pos = e / 48, j = e % 48, row = pos >> 6, col = pos & 63;
            float ang; float* dst;
            if (j < 32) { const float inv = exp2f(-(float)(j & 15) * (13.287712379549449f / 16.f)); ang = (float)(j < 16 ? row : col) * inv; dst = p.ropeA + ((size_t)pos * 32 + j) * 2; }
            else { const int jj = j - 32; const float inv = exp2f(-(float)(jj & 7) * (13.287712379549449f / 8.f)); ang = (float)(jj < 8 ? row : col) * inv; dst = p.ropeC + ((size_t)pos * 16 + jj) * 2; }
            double sn, cs; sincos_d((double)ang, sn, cs);
            dst[0] = (float)cs; dst[1] = (float)sn;
        }
    }
    for (int u = blockIdx.x; u < U_TR; u += gridDim.x) {
        const int l = u / T_LAYER; int r = u % T_LAYER;
        const float* src; bf16_t* dst; int K, N, perm;
        if (r < T_FFIN) { src = p.w_ff1_in + (size_t)l * D * 2 * DFF; dst = p.Wff1in + (size_t)l * D * 2 * DFF; K = D; N = 2 * DFF; perm = 1; }
        else if ((r -= T_FFIN) < T_FFOUT) { src = p.w_ff1_out + (size_t)l * D * DFF; dst = p.Wff1out + (size_t)l * D * DFF; K = DFF; N = D; perm = 0; }
        else if ((r -= T_FFOUT) < T_FFIN) { src = p.w_ff2_in + (size_t)l * D * 2 * DFF; dst = p.Wff2in + (size_t)l * D * 2 * DFF; K = D; N = 2 * DFF; perm = 1; }
        else if ((r -= T_FFIN) < T_FFOUT) { src = p.w_ff2_out + (size_t)l * D * DFF; dst = p.Wff2out + (size_t)l * D * DFF; K = DFF; N = D; perm = 0; }
        else if ((r -= T_FFOUT) < T_WIN) { src = p.w_in + (size_t)l * D * INC; dst = p.Win + (size_t)l * D * INC; K = D; N = INC; perm = 2; }
        else { r -= T_WIN; src = p.w_out + (size_t)l * D * D; dst = p.Wout + (size_t)l * D * D; K = D; N = D; perm = 0; }
        transpose_unit(src, dst, K, N, perm, r, (float*)smem);
    }
}

typedef _Float16 h16x4 __attribute__((ext_vector_type(4)));
template <bool FINAL>
DI void phase_norm(const Params& p, bool first, const float* g, const float* mods_l, int mi, int nrows) {
    constexpr int RW = 4;
    const int wid = TID() >> 6, lane = TID() & 63;
    for (int u = blockIdx.x; u < nrows / (8 * RW); u += gridDim.x) {
        const int row0 = (u * 8 + wid) * RW;
        const bool islat = row0 < NLAT;
        const int mb = islat ? row0 / SEQ : 16;
        f32x4 v[RW][4];
        if (first) {
            const float* src = islat ? p.x + (size_t)row0 * D : p.ctx + (size_t)(row0 - NLAT) * D;
#pragma unroll
            for (int q = 0; q < RW; ++q)
#pragma unroll
                for (int i = 0; i < 4; ++i) v[q][i] = *(const f32x4*)(src + (size_t)q * D + i * 256 + lane * 4);
        } else {
            h16x4 hv[RW][4];
#pragma unroll
            for (int q = 0; q < RW; ++q)
#pragma unroll
                for (int i = 0; i < 4; ++i) hv[q][i] = *(const h16x4*)(p.h16 + (size_t)(row0 + q) * D + i * 256 + lane * 4);
            if (islat) {
#pragma unroll
                for (int q = 0; q < RW; ++q)
#pragma unroll
                    for (int i = 0; i < 4; ++i) v[q][i] = __builtin_convertvector(hv[q][i], f32x4);
            } else {
#pragma unroll
                for (int q = 0; q < RW; ++q)
#pragma unroll
                    for (int i = 0; i < 4; ++i) {
                        const float* pq = p.dctx + (size_t)(row0 + q - NLAT) * D + i * 256 + lane * 4;
                        v[q][i] = __builtin_convertvector(hv[q][i], f32x4) + ((*(const f32x4*)pq + *(const f32x4*)(pq + (size_t)NCTX * D)) + (*(const f32x4*)(pq + (size_t)2 * NCTX * D) + *(const f32x4*)(pq + (size_t)3 * NCTX * D)));
                    }
            }
        }
        float rstd[RW];
#pragma unroll
        for (int q = 0; q < RW; ++q) {
            float ss = 0.f;
#pragma unroll
            for (int i = 0; i < 4; ++i) ss += v[q][i][0] * v[q][i][0] + v[q][i][1] * v[q][i][1] + v[q][i][2] * v[q][i][2] + v[q][i][3] * v[q][i][3];
            rstd[q] = rsqrtf(wave_sum(ss) * (1.f / D) + EPS);
        }
        if (FINAL) {
#pragma unroll
            for (int i = 0; i < 4; ++i) { const int col = i * 256 + lane * 4; const f32x4 gv = *(const f32x4*)(g + col);
#pragma unroll
                for (int q = 0; q < RW; ++q) { f32x4 o = v[q][i] * rstd[q] * gv;
#if PROBE_SEL
                    { const float e = p.probe[0]; o[0] *= 1.f + e; o[1] *= 1.f - e; o[2] *= 1.f + e; o[3] *= 1.f - e; }
#endif
                    *(f32x4*)(p.out + (size_t)(row0 + q) * D + col) = o; } }
        } else {
            if (first || !islat) {
#pragma unroll
                for (int q = 0; q < RW; ++q)
#pragma unroll
                    for (int i = 0; i < 4; ++i) *(h16x4*)(p.h16 + (size_t)(row0 + q) * D + i * 256 + lane * 4) = __builtin_convertvector(v[q][i], h16x4);
            }
            const float* sh = mods_l + (size_t)mb * MODW + mi * D; const float* scl = sh + D;
#pragma unroll
            for (int i = 0; i < 4; ++i) {
                const int col = i * 256 + lane * 4;
                const f32x4 gv = *(const f32x4*)(g + col), sv = *(const f32x4*)(scl + col), bv = *(const f32x4*)(sh + col);
                const f32x4 gs = gv * (1.f + sv);
#pragma unroll
                for (int q = 0; q < RW; ++q) {
                    const f32x4 o = v[q][i] * rstd[q] * gs + bv;
                    u32x2 w; w[0] = pk2(o[0], o[1]); w[1] = pk2(o[2], o[3]);
                    *(u32x2*)(p.xn + (size_t)(row0 + q) * D + col) = w;
                }
            }
        }
    }
}

constexpr int BM = 256, BK = 64, HALF = 128, HT = HALF * BK, NXCD = 8, WGM = 8;
DI int lds_byte(int r, int c) { const int st = (r >> 4) * 2 + (c >> 5), rr = r & 15, cc = c & 31, ob = rr * 64 + cc * 2; return st * 1024 + (ob ^ (((ob >> 9) & 1) << 5)); }
DI void stage_rc(int b, int& R, int& C) { const int st = b / 1024, sb = b % 1024, swz = sb ^ (((sb >> 9) & 1) << 5); R = (st >> 1) * 16 + swz / 64; C = (st & 1) * 32 + (swz % 64) / 2; }

#define LAS __attribute__((address_space(3)))
constexpr int HTB = HALF * BK * 2;
DI void gemm_tile(const bf16_t* A, const bf16_t* Bt, int K  , int kt0, int nt  , int brow, int bcol, f32x4 (&acc)[2][2][4][2], LAS unsigned char* lds) {
    const int tid = TID(), wid = __builtin_amdgcn_readfirstlane(tid >> 6), lane = tid & 63, wr = wid >> 2, wc = wid & 3, fr = lane & 15, fq = lane >> 4;
    unsigned voff[2];
#pragma unroll
    for (int i = 0; i < 2; ++i) { int R, C; stage_rc(tid * 16 + i * 8192, R, C); voff[i] = (unsigned)(R * K + C) * 2u; }
    const size_t kstep = (size_t)(BK * 2), hstep = (size_t)HALF * K * 2;
    const unsigned ldsw = (unsigned)wid * 1024u;
    const int aoff = lds_byte(wr * 64 + fr, fq * 8), boff = lds_byte(wc * 32 + fr, fq * 8);
#define SA(b, h) (((b) * 2 + (h)) * HTB)
#define SB(b, h) ((4 + (b) * 2 + (h)) * HTB)
#define STAGE(bufoff, gbase) do { _Pragma("unroll") for (int _i = 0; _i < 2; ++_i) \
        __builtin_amdgcn_global_load_lds((const unsigned*)((const char*)(gbase) + voff[_i]), (LAS unsigned*)(lds + (bufoff) + ldsw + _i * 8192), 16, 0, 0); } while (0)
#define LDA(dst, b, h) do { _Pragma("unroll") for (int m = 0; m < 4; ++m) _Pragma("unroll") for (int k = 0; k < 2; ++k) dst[m][k] = *(const LAS bf16x8*)(lds + SA(b, h) + aoff + m * 2048 + k * 1024); } while (0)
#define LDB(dst, b, h) do { _Pragma("unroll") for (int n = 0; n < 2; ++n) _Pragma("unroll") for (int k = 0; k < 2; ++k) dst[n][k] = *(const LAS bf16x8*)(lds + SB(b, h) + boff + n * 2048 + k * 1024); } while (0)
#define MMA(ai, bj, At_, Bt_) do { __builtin_amdgcn_s_setprio(1); _Pragma("unroll") for (int m = 0; m < 4; ++m) _Pragma("unroll") for (int n = 0; n < 2; ++n) _Pragma("unroll") for (int k = 0; k < 2; ++k) \
        acc[ai][bj][m][n] = __builtin_amdgcn_mfma_f32_16x16x32_bf16(Bt_[n][k], At_[m][k], acc[ai][bj][m][n], 0, 0, 0); __builtin_amdgcn_s_setprio(0); } while (0)
#define WAIT_V(n) asm volatile("s_waitcnt vmcnt(" #n ")" ::: "memory")
#define WAIT_L(n) asm volatile("s_waitcnt lgkmcnt(" #n ")" ::: "memory")
#define BAR __builtin_amdgcn_s_barrier()
#define SCHED __builtin_amdgcn_sched_barrier(0)
#pragma unroll
    for (int a = 0; a < 2; ++a)
#pragma unroll
        for (int b = 0; b < 2; ++b)
#pragma unroll
            for (int m = 0; m < 4; ++m)
#pragma unroll
                for (int n = 0; n < 2; ++n) acc[a][b][m][n] = (f32x4){0.f, 0.f, 0.f, 0.f};
    bf16x8 At[4][2], B0[2][2], B1[2][2];
    const char* cA = (const char*)A + (size_t)brow * K * 2 + (size_t)kt0 * BK * 2; const char* cB = (const char*)Bt + (size_t)bcol * K * 2 + (size_t)kt0 * BK * 2;
    STAGE(SB(0, 0), cB); STAGE(SB(0, 1), cB + hstep); STAGE(SA(0, 0), cA); STAGE(SA(0, 1), cA + hstep);
    if (wr == 1) BAR;
    WAIT_V(2); BAR;
    STAGE(SB(1, 0), cB + kstep); STAGE(SA(1, 0), cA + kstep); STAGE(SB(1, 1), cB + hstep + kstep);
    WAIT_V(6); BAR;
    for (int t = 0; t < nt; t += 2) {
        const bool lastit = (t == nt - 2);
        const char* a1 = cA + (size_t)(t + 1) * kstep;
        const char* a2 = lastit ? cA : cA + (size_t)(t + 2) * kstep; const char* b2 = lastit ? cB : cB + (size_t)(t + 2) * kstep;
        const char* a3 = a2 + kstep; const char* b3 = b2 + kstep;
        LDB(B0, 0, 0); LDB(B1, 0, 1); SCHED; LDA(At, 0, 0); STAGE(SA(1, 1), a1 + hstep);
        WAIT_V(8); WAIT_L(0); BAR; MMA(0, 0, At, B0); MMA(0, 1, At, B1); BAR; SCHED;
        LDA(At, 0, 1); STAGE(SB(0, 0), b2); STAGE(SB(0, 1), b2 + hstep); STAGE(SA(0, 0), a2);
        WAIT_V(8); WAIT_L(0); BAR; MMA(1, 0, At, B0); MMA(1, 1, At, B1); BAR; SCHED;
        LDB(B0, 1, 0); LDB(B1, 1, 1); SCHED; LDA(At, 1, 0); STAGE(SA(0, 1), a2 + hstep);
        WAIT_V(8); WAIT_L(0); BAR; MMA(0, 0, At, B0); MMA(0, 1, At, B1); BAR; SCHED;
        LDA(At, 1, 1); STAGE(SB(1, 0), b3); STAGE(SB(1, 1), b3 + hstep); STAGE(SA(1, 0), a3);
        WAIT_V(8); WAIT_L(0); BAR; MMA(1, 0, At, B0); MMA(1, 1, At, B1); BAR; SCHED;
    }
    WAIT_V(0);
    if (wr == 0) BAR;
    BAR;
}

DI void tile_order(int L, int nM, int nN, int& pm, int& pn) {
    const int nwg = nM * nN; int wgid = L;
    { const int q = nwg / NXCD, r = nwg % NXCD, xcd = wgid % NXCD, off = wgid / NXCD; wgid = (xcd < r ? xcd * (q + 1) : r * (q + 1) + (xcd - r) * q) + off; }
    const int nig = WGM * nN, gid = wgid / nig, fm = gid * WGM, gsz = (nM - fm) < WGM ? (nM - fm) : WGM;
    pm = fm + ((wgid % nig) % gsz); pn = (wgid % nig) / gsz;
}

struct EpiSwiglu {
    bf16_t* hid;
    DI void operator()(f32x4 (&acc)[2][2][4][2], int pm, int pn, int sl, char* smem) const {
        const int wid = TID() >> 6, lane = TID() & 63, wr = wid >> 2, wc = wid & 3, fr = lane & 15, fq = lane >> 4;
#pragma unroll
        for (int ai = 0; ai < 2; ++ai)
#pragma unroll
            for (int m = 0; m < 4; ++m) {
                const int row = pm * BM + ai * HALF + wr * 64 + m * 16 + fr;
                u32x4 w;
#pragma unroll
                for (int n = 0; n < 2; ++n) {
                    const f32x4 a = acc[ai][0][m][n], b = acc[ai][1][m][n];
                    w[2 * n] = pk2(silu_f(a[0]) * b[0], silu_f(a[1]) * b[1]); w[2 * n + 1] = pk2(silu_f(a[2]) * b[2], silu_f(a[3]) * b[3]);
                }
                *(u32x4*)(hid + (size_t)row * DFF + pn * 128 + wc * 32 + fq * 8) = w;
            }
    }
};
struct EpiResid {
    _Float16* h16; const float* gate; float* dctx; float gs;
    DI void operator()(f32x4 (&acc)[2][2][4][2], int pm, int pn, int sl, char* smem) const {
        typedef _Float16 h16x8 __attribute__((ext_vector_type(8)));
        typedef float f32x8 __attribute__((ext_vector_type(8)));
        const int wid = TID() >> 6, lane = TID() & 63, wr = wid >> 2, wc = wid & 3, fr = lane & 15, fq = lane >> 4;
        const int row0 = pm * BM; const bool islat = row0 < NLAT;
        _Float16* out = h16 + (size_t)(row0 + wr * 64 + fr) * D + pn * BM + wc * 32 + fq * 8;
        const float* gt = gate + (size_t)(islat ? row0 / SEQ : 16) * MODW + pn * BM + wc * 32 + fq * 8;
        f32x4 gv[2][2];
#pragma unroll
        for (int bj = 0; bj < 2; ++bj)
#pragma unroll
            for (int n = 0; n < 2; ++n) gv[bj][n] = *(const f32x4*)(gt + bj * HALF + n * 4) * gs;
        if (sl >= 0) {
            float* po = dctx + ((size_t)sl * NCTX + (row0 - NLAT) + wr * 64 + fr) * D + pn * BM + wc * 32 + fq * 8;
#pragma unroll
            for (int ai = 0; ai < 2; ++ai)
#pragma unroll
                for (int m = 0; m < 4; ++m)
#pragma unroll
                    for (int bj = 0; bj < 2; ++bj)
#pragma unroll
                        for (int n = 0; n < 2; ++n) *(f32x4*)(po + (size_t)(ai * HALF + m * 16) * D + bj * HALF + n * 4) = gv[bj][n] * acc[ai][bj][m][n];
            return;
        }
        h16x8 hv[2][4][2];
#pragma unroll
        for (int ai = 0; ai < 2; ++ai)
#pragma unroll
            for (int m = 0; m < 4; ++m)
#pragma unroll
                for (int bj = 0; bj < 2; ++bj) hv[ai][m][bj] = *(const h16x8*)(out + (size_t)(ai * HALF + m * 16) * D + bj * HALF);
#pragma unroll
        for (int ai = 0; ai < 2; ++ai)
#pragma unroll
            for (int m = 0; m < 4; ++m)
#pragma unroll
                for (int bj = 0; bj < 2; ++bj) {
                    const f32x8 hf = __builtin_convertvector(hv[ai][m][bj], f32x8);
                    const f32x4 lo = (f32x4){hf[0], hf[1], hf[2], hf[3]} + gv[bj][0] * acc[ai][bj][m][0], hi = (f32x4){hf[4], hf[5], hf[6], hf[7]} + gv[bj][1] * acc[ai][bj][m][1];
                    const f32x8 v = {lo[0], lo[1], lo[2], lo[3], hi[0], hi[1], hi[2], hi[3]};
                    *(h16x8*)(out + (size_t)(ai * HALF + m * 16) * D + bj * HALF) = __builtin_convertvector(v, h16x8);
                }
    }
};
constexpr float SC_A = 0.125f * 1.4426950408889634f, SC_C = 0.17677669529663687f * 1.4426950408889634f;
constexpr int TS = 260;
struct EpiProj {
    const Params* pp; int l;
    DI void operator()(f32x4 (&acc)[2][2][4][2], int pm, int pn, int sl, char* smem) const {
        const Params& p = *pp;
        LAS float* T = (LAS float*)smem;
        const int tid = TID(), wid = tid >> 6, lane = tid & 63, wr = wid >> 2, wc = wid & 3, fr = lane & 15, fq = lane >> 4;
#pragma unroll
        for (int ai = 0; ai < 2; ++ai) {
            lds_barrier();
#pragma unroll
            for (int bj = 0; bj < 2; ++bj)
#pragma unroll
                for (int m = 0; m < 4; ++m)
#pragma unroll
                    for (int n = 0; n < 2; ++n) *(LAS f32x4*)(T + (wr * 64 + m * 16 + fr) * TS + bj * HALF + wc * 32 + n * 16 + fq * 4) = acc[ai][bj][m][n];
            lds_barrier();
            const int rl = tid & 127, seg = tid >> 7, grow = pm * BM + ai * HALF + rl;
            const bool islat = grow < NLAT;
            const int b = islat ? grow / SEQ : (grow - NLAT) / CTX;
            const int pos = islat ? grow % SEQ : SEQ + (grow - NLAT) % CTX;
            const LAS float* xr = T + rl * TS + seg * 64;
            if (pn >= 7 && seg >= 2) continue;
#define LD8(dstv, off) { const f32x4 _a = *(const LAS f32x4*)(xr + (off)), _b = *(const LAS f32x4*)(xr + (off) + 4); dstv[0] = _a[0]; dstv[1] = _a[1]; dstv[2] = _a[2]; dstv[3] = _a[3]; dstv[4] = _b[0]; dstv[5] = _b[1]; dstv[6] = _b[2]; dstv[7] = _b[3]; }
            if (pn == 0 || (pn == 2 && seg < 2)) {
                const float* g = (pn == 0 ? p.g_q_a : p.g_k_a) + l * 64;
                bf16_t* dst = pn == 0 ? p.QA + ((size_t)(b * 4 + seg) * KEYS + pos) * 64 : p.KA + ((size_t)(b * 2 + seg) * KEYS + pos) * 64;
                float ss = 0.f;
#pragma unroll
                for (int i = 0; i < 16; ++i) { const f32x4 v = *(const LAS f32x4*)(xr + 4 * i); ss += v[0] * v[0] + v[1] * v[1] + v[2] * v[2] + v[3] * v[3]; }
                const float rstd = rsqrtf(ss * (1.f / 64.f) + EPS);
                const float* rp = p.ropeA + (size_t)(islat ? pos : 0) * 64;
#pragma unroll
                for (int i0 = 0; i0 < 32; i0 += 8) {
                    float xa[8], xb[8], o1[8], o2[8];
                    LD8(xa, i0); LD8(xb, i0 + 32);
#pragma unroll
                    for (int i = 0; i < 8; i += 2) {
                        f32x4 cssn = {1.f, 0.f, 1.f, 0.f};
                        if (islat) cssn = *(const f32x4*)(rp + (i0 + i) * 2);
#pragma unroll
                        for (int e = 0; e < 2; ++e) {
                            const float a = xa[i + e] * rstd * g[i0 + i + e], bb = xb[i + e] * rstd * g[i0 + i + e + 32];
                            o1[i + e] = a * cssn[2 * e] - bb * cssn[2 * e + 1]; o2[i + e] = a * cssn[2 * e + 1] + bb * cssn[2 * e];
                        }
                    }
                    const float qs = pn == 0 ? SC_A : 1.f;
                    u32x4 w1, w2;
#pragma unroll
                    for (int i = 0; i < 4; ++i) { w1[i] = pk2(o1[2 * i] * qs, o1[2 * i + 1] * qs); w2[i] = pk2(o2[2 * i] * qs, o2[2 * i + 1] * qs); }
                    *(u32x4*)(dst + i0) = w1; *(u32x4*)(dst + 32 + i0) = w2;
                }
            } else if (pn == 1 || pn == 3) {
                bf16_t* base = (pn == 1 ? p.QC : p.KC);
                const float* rp = p.ropeC + (size_t)(islat ? pos : 0) * 32;
#pragma unroll
                for (int mp = 0; mp < 2; ++mp) {
                    bf16_t* dst = base + ((size_t)(b * 4 + seg) * KEYS + pos) * 64 + mp * 32;
                    float k2 = 0.f;
#pragma unroll
                    for (int i0 = 0; i0 < 16; i0 += 8) {
                        float xa[8], xb[8], o1[8], o2[8];
                        LD8(xa, mp * 32 + i0); LD8(xb, mp * 32 + i0 + 16);
#pragma unroll
                        for (int i = 0; i < 8; ++i) k2 += xa[i] * xa[i] + xb[i] * xb[i];
#pragma unroll
                        for (int i = 0; i < 8; i += 2) {
                            f32x4 cssn = {1.f, 0.f, 1.f, 0.f};
                            if (islat) cssn = *(const f32x4*)(rp + (i0 + i) * 2);
#pragma unroll
                            for (int e = 0; e < 2; ++e) {
                                const float a = xa[i + e], bb = xb[i + e];
                                o1[i + e] = a * cssn[2 * e] - bb * cssn[2 * e + 1]; o2[i + e] = a * cssn[2 * e + 1] + bb * cssn[2 * e];
                            }
                        }
                        const float qs = pn == 1 ? SC_C : 1.f;
                        u32x4 w1, w2;
#pragma unroll
                        for (int i = 0; i < 4; ++i) { w1[i] = pk2(o1[2 * i] * qs, o1[2 * i + 1] * qs); w2[i] = pk2(o2[2 * i] * qs, o2[2 * i + 1] * qs); }
                        *(u32x4*)(dst + i0) = w1; *(u32x4*)(dst + 16 + i0) = w2;
                    }
                    if (pn == 3) {
#pragma unroll
                        for (int o = 32; o >= 1; o >>= 1) k2 = fmaxf(k2, __shfl_xor(k2, o));
                        if (lane == 0) atomicMax(p.kmaxC + (size_t)l * NB * 8 + (b * 4 + seg) * 2 + mp, __float_as_uint(k2));
                    }
                }
            } else if (pn == 2 || pn == 4) {
                bf16_t* dst = pn == 2 ? p.VtA + ((size_t)(b * 2 + (seg - 2)) * 64) * KEYS + pos : p.VtC + ((size_t)(b * 4 + seg) * 64) * KEYS + pos;
#pragma unroll
                for (int d0 = 0; d0 < 64; d0 += 8) {
                    float xa[8]; LD8(xa, d0);
#pragma unroll
                    for (int d = 0; d < 8; ++d) dst[(size_t)(d0 + d) * KEYS] = f2bf(xa[d]);
                }
            } else if (pn == 5) {
                bf16_t* dst = p.U + (size_t)grow * 256 + seg * 64;
#pragma unroll
                for (int i0 = 0; i0 < 64; i0 += 8) {
                    float xa[8]; LD8(xa, i0);
                    u32x4 w;
#pragma unroll
                    for (int i = 0; i < 4; ++i) w[i] = pk2(gelu_f(xa[2 * i]), gelu_f(xa[2 * i + 1]));
                    *(u32x4*)(dst + i0) = w;
                }
            } else if (pn == 6) {
                float ss = 0.f;
#pragma unroll
                for (int i0 = 0; i0 < 64; i0 += 8) {
                    float xa[8]; LD8(xa, i0);
#pragma unroll
                    for (int i = 0; i < 8; ++i) { const float gv = gelu_f(xa[i]); ss += gv * gv; }
                }
                T[rl * TS + 256 + seg] = ss;
                lds_barrier();
                const f32x4 pt = *(const LAS f32x4*)(T + rl * TS + 256);
                const float rstd = rsqrtf(((pt[0] + pt[1]) + (pt[2] + pt[3])) * (1.f / 256.f) + EPS);
                const float* g = p.g_v_b + l * 256 + seg * 64;
                bf16_t* dst = p.VN + (size_t)grow * 256 + seg * 64;
#pragma unroll
                for (int i0 = 0; i0 < 64; i0 += 8) {
                    float xa[8]; LD8(xa, i0);
                    u32x4 w;
#pragma unroll
                    for (int i = 0; i < 4; ++i) w[i] = pk2(gelu_f(xa[2 * i]) * rstd * g[i0 + 2 * i], gelu_f(xa[2 * i + 1]) * rstd * g[i0 + 2 * i + 1]);
                    *(u32x4*)(dst + i0) = w;
                }
            } else {
                bf16_t* dst = p.Y + (size_t)grow * 256 + (pn - 7) * 128 + seg * 64;
#pragma unroll
                for (int i0 = 0; i0 < 64; i0 += 8) {
                    float xa[8], ga[8]; LD8(xa, i0); LD8(ga, 128 + i0);
                    u32x4 w;
#pragma unroll
                    for (int i = 0; i < 4; ++i) w[i] = pk2(xa[2 * i] * sigmoid_f(ga[2 * i]), xa[2 * i + 1] * sigmoid_f(ga[2 * i + 1]));
                    *(u32x4*)(dst + i0) = w;
                }
            }
#undef LD8
        }
        lds_barrier();
    }
};

struct UnitList {
    int nM, nN, nwg, nsp, ntk, split, kvonly;
    DI void init(int M, int N, int K, bool splitctx, bool kvonlyctx) {
        nN = N / BM; ntk = K / BK; split = splitctx; kvonly = kvonlyctx;
        nM = ((splitctx || kvonlyctx) ? NLAT : M) / BM; nwg = nM * nN; nsp = splitctx ? (NCTX / BM) * nN * 4 : (kvonlyctx ? (NCTX / BM) * 3 : 0);
    }
    DI bool get(int L, int& pm, int& pn, int& sl, int& kt0, int& nt) const {
        if (L >= nwg + nsp) return false;
        sl = -1; kt0 = 0; nt = ntk;
        if (L < nwg) tile_order(L, nM, nN, pm, pn);
        else if (kvonly) { const int c = L - nwg; pm = NLAT / BM + c / 3; pn = 2 + c % 3; }
        else {
            const int c = L - nwg, tile = c >> 2; sl = c & 3; pm = NLAT / BM + tile / nN; pn = tile % nN;
            const int q = ntk / 8 * 2, rem2 = (ntk - 4 * q) / 2;
            kt0 = sl * q + 2 * (sl < rem2 ? sl : rem2); nt = q + (sl < rem2 ? 2 : 0);
        }
        return true;
    }
};

template <class Epi>
DI void phase_gemm(const bf16_t* A, const bf16_t* Bt, int M, int N, int K, const Epi& epi, char* smem, bool splitctx = false, bool kvonlyctx = false) {
    UnitList ul; ul.init(M, N, K, splitctx, kvonlyctx);
    for (int L = blockIdx.x;; L += gridDim.x) {
        int pm, pn, sl, kt0, nt;
        if (!ul.get(L, pm, pn, sl, kt0, nt)) break;
        f32x4 acc[2][2][4][2];
        gemm_tile(A, Bt, K, kt0, nt, pm * BM, pn * BM, acc, (LAS unsigned char*)smem);
        epi(acc, pm, pn, sl, smem);
    }
}

template <class Epi>
DI void phase_gemm_stream(const bf16_t* A, const bf16_t* Bt, int M, int N, int K, const Epi& epi, char* smem, bool splitctx = false) {
    UnitList ul; ul.init(M, N, K, splitctx, false);
    LAS unsigned char* lds = (LAS unsigned char*)smem;
    const int tid = TID(), wid = __builtin_amdgcn_readfirstlane(tid >> 6), lane = tid & 63, wr = wid >> 2, wc = wid & 3, fr = lane & 15, fq = lane >> 4;
    unsigned voff[2];
#pragma unroll
    for (int i = 0; i < 2; ++i) { int R, C; stage_rc(tid * 16 + i * 8192, R, C); voff[i] = (unsigned)(R * K + C) * 2u; }
    const size_t kstep = (size_t)(BK * 2), hstep = (size_t)HALF * K * 2, tstep = 2 * hstep;
    const unsigned ldsw = (unsigned)wid * 1024u;
    const int aoff = lds_byte(wr * 64 + fr, fq * 8), boff = lds_byte(wc * 32 + fr, fq * 8);
    int L = blockIdx.x, pm, pn, sl, kt0, nt;
    if (!ul.get(L, pm, pn, sl, kt0, nt)) return;
    f32x4 acc[2][2][4][2];
#pragma unroll
    for (int a = 0; a < 2; ++a)
#pragma unroll
        for (int b = 0; b < 2; ++b)
#pragma unroll
            for (int m = 0; m < 4; ++m)
#pragma unroll
                for (int n = 0; n < 2; ++n) acc[a][b][m][n] = (f32x4){0.f, 0.f, 0.f, 0.f};
    bf16x8 At[4][2], B0[2][2], B1[2][2];
    const char* cA = (const char*)A + (size_t)pm * tstep + (size_t)kt0 * kstep; const char* cB = (const char*)Bt + (size_t)pn * tstep + (size_t)kt0 * kstep;
    STAGE(SB(0, 0), cB); STAGE(SB(0, 1), cB + hstep); STAGE(SA(0, 0), cA); STAGE(SA(0, 1), cA + hstep);
    if (wr == 1) BAR;
    WAIT_V(2); BAR;
    STAGE(SB(1, 0), cB + kstep); STAGE(SA(1, 0), cA + kstep); STAGE(SB(1, 1), cB + hstep + kstep);
    WAIT_V(6); BAR;
    for (;;) {
        int npm, npn, nsl, nkt0, nnt;
        const bool has_next = ul.get(L + gridDim.x, npm, npn, nsl, nkt0, nnt);
        const char* nA = has_next ? (const char*)A + (size_t)npm * tstep + (size_t)nkt0 * kstep : cA; const char* nB = has_next ? (const char*)Bt + (size_t)npn * tstep + (size_t)nkt0 * kstep : cB;
        for (int t = 0; t < nt; t += 2) {
            const bool lastit = (t == nt - 2);
            const char* a1 = cA + (size_t)(t + 1) * kstep;
            const char* a2 = lastit ? nA : cA + (size_t)(t + 2) * kstep; const char* b2 = lastit ? nB : cB + (size_t)(t + 2) * kstep;
            const char* a3 = a2 + kstep; const char* b3 = b2 + kstep;
            LDB(B0, 0, 0); LDB(B1, 0, 1); SCHED; LDA(At, 0, 0); STAGE(SA(1, 1), a1 + hstep);
            WAIT_V(8); WAIT_L(0); BAR; MMA(0, 0, At, B0); MMA(0, 1, At, B1); BAR; SCHED;
            LDA(At, 0, 1); STAGE(SB(0, 0), b2); STAGE(SB(0, 1), b2 + hstep); STAGE(SA(0, 0), a2);
            WAIT_V(8); WAIT_L(0); BAR; MMA(1, 0, At, B0); MMA(1, 1, At, B1); BAR; SCHED;
            LDB(B0, 1, 0); LDB(B1, 1, 1); SCHED; LDA(At, 1, 0); STAGE(SA(0, 1), a2 + hstep);
            WAIT_V(8); WAIT_L(0); BAR; MMA(0, 0, At, B0); MMA(0, 1, At, B1); BAR; SCHED;
            LDA(At, 1, 1); STAGE(SB(1, 0), b3); STAGE(SB(1, 1), b3 + hstep); STAGE(SA(1, 0), a3);
            WAIT_V(8); WAIT_L(0); BAR; MMA(1, 0, At, B0); MMA(1, 1, At, B1); BAR; SCHED;
        }
        if (wr == 0) BAR;
        epi(acc, pm, pn, sl, smem);
        if (!has_next) break;
#pragma unroll
        for (int a = 0; a < 2; ++a)
#pragma unroll
            for (int b = 0; b < 2; ++b)
#pragma unroll
                for (int m = 0; m < 4; ++m)
#pragma unroll
                    for (int n = 0; n < 2; ++n) acc[a][b][m][n] = (f32x4){0.f, 0.f, 0.f, 0.f};
        L += gridDim.x; pm = npm; pn = npn; sl = nsl; kt0 = nkt0; nt = nnt; cA = nA; cB = nB;
        if (wr == 1) BAR;
    }
    WAIT_V(0);
    BAR;
}

constexpr int VROW = 144;
template <bool ISC, bool FIXM>
DI void attn2_core(const bf16_t* Q0, const bf16_t* Q1, const bf16_t* Kg, const bf16_t* Vt, int qpos0, int key_lo, int nkt, float sc, float mfix0, float mfix1, f32x16 (&O)[2][2], char* smem) {
    constexpr int KROW = 144, KBUF = 64 * KROW, VBUF = 64 * VROW, NSLOT = 4, NQ = ISC ? 1 : 2;
    LAS char* lds = (LAS char*)smem;
    const int tid = TID(), lane = tid & 63, wid = tid >> 6, r = lane & 31, h = lane >> 5;
    bf16x8 qf[NQ][4];
#pragma unroll
    for (int c = 0; c < NQ; ++c)
#pragma unroll
        for (int ks = 0; ks < 4; ++ks) qf[c][ks] = *(const bf16x8*)((c == 0 ? Q0 : Q1) + (size_t)(qpos0 + wid * 32 + r) * 64 + ks * 16 + 8 * h);
#pragma unroll
    for (int c = 0; c < 2; ++c)
#pragma unroll
        for (int i = 0; i < 16; ++i) { O[c][0][i] = 0.f; O[c][1][i] = 0.f; }
    float m_run[2] = {FIXM ? mfix0 : -1e30f, FIXM ? mfix1 : -1e30f}, l_run[2] = {0.f, 0.f};
    const int kkey = tid >> 3, kch = tid & 7;
    const int kst = kkey * KROW + kch * 16, vst = NSLOT * KBUF + kkey * VROW + kch * 16;
    const int krd = r * KROW + 16 * h, vrd = NSLOT * KBUF + r * VROW + 8 * h;
    const bf16_t* kg = Kg + (size_t)(key_lo + kkey) * 64 + kch * 8;
    const bf16_t* vg = Vt + (size_t)kkey * KEYS + key_lo + kch * 8;
    u32x4 kreg, vreg;
    bf16x8 kf[4]; u32x2 vf[2][2][2];
    auto gload = [&](int t) { kreg = *(const u32x4*)(kg + (size_t)t * 64 * 64); vreg = *(const u32x4*)(vg + t * 64); };
    auto lstore = [&](int slot) { *(LAS u32x4*)(lds + slot * KBUF + kst) = kreg; *(LAS u32x4*)(lds + slot * VBUF + vst) = vreg; };
    auto ldk = [&](int slot, int kk) {
        const LAS char* kb = lds + slot * KBUF + krd + kk * 32 * KROW;
#pragma unroll
        for (int ks = 0; ks < 4; ++ks) kf[ks] = *(const LAS bf16x8*)(kb + ks * 32);
    };
    auto ldv = [&](int slot, int kk) {
        const LAS char* vb = lds + slot * VBUF + vrd + kk * 64;
#pragma unroll
        for (int st = 0; st < 2; ++st)
#pragma unroll
            for (int dt = 0; dt < 2; ++dt) { const LAS char* vp = vb + dt * 32 * VROW + st * 32; vf[st][dt][0] = *(const LAS u32x2*)vp; vf[st][dt][1] = *(const LAS u32x2*)(vp + 16); }
    };
#define SOFT_PV(c) do { \
        if (!FIXM) { \
        float mx = s##c[0]; \
        _Pragma("unroll") for (int i = 1; i < 16; ++i) mx = __ocml_fmax_f32(mx, s##c[i]); \
        mx = __ocml_fmax_f32(mx, __shfl_xor(mx, 32)); \
        const float m_new = __ocml_fmax_f32(m_run[c], mx); \
        if (__builtin_amdgcn_ballot_w64(m_new > m_run[c]) != 0ull) { \
            const float alpha = __builtin_amdgcn_exp2f(m_run[c] - m_new); \
            m_run[c] = m_new; l_run[c] *= alpha; \
            _Pragma("unroll") for (int i = 0; i < 16; ++i) { O[c][0][i] *= alpha; O[c][1][i] *= alpha; } \
        } } \
        float ps = 0.f; \
        _Pragma("unroll") for (int i = 0; i < 16; ++i) { s##c[i] = __builtin_amdgcn_exp2f(FIXM ? s##c[i] : s##c[i] - m_run[c]); ps += s##c[i]; } \
        l_run[c] += ps; \
        _Pragma("unroll") for (int st = 0; st < 2; ++st) { \
            u32x4 pw; \
            _Pragma("unroll") for (int i = 0; i < 4; ++i) pw[i] = pk2(s##c[8 * st + 2 * i], s##c[8 * st + 2 * i + 1]); \
            const bf16x8 pf = __builtin_bit_cast(bf16x8, pw); \
            _Pragma("unroll") for (int dt = 0; dt < 2; ++dt) { \
                u32x4 vw = {vf[st][dt][0][0], vf[st][dt][0][1], vf[st][dt][1][0], vf[st][dt][1][1]}; \
                O[c][dt] = __builtin_amdgcn_mfma_f32_32x32x16_bf16(__builtin_bit_cast(bf16x8, vw), pf, O[c][dt], 0, 0, 0); \
            } \
        } } while (0)
    lds_barrier();
    gload(0); lstore(0);
    if (nkt > 1) { gload(1); lstore(1); }
    if (nkt > 2) gload(2);
    lds_barrier();
    ldk(0, 0);
    for (int t = 0; t < nkt; ++t) {
        const int cur = t & 3, nxt = (t + 1) & 3;
        if (t + 2 < nkt) lstore((t + 2) & 3);
        if (t + 3 < nkt) gload(t + 3);
#pragma unroll
        for (int kk = 0; kk < 2; ++kk) {
            f32x16 s0, s1;
#pragma unroll
            for (int i = 0; i < 16; ++i) { s0[i] = 0.f; s1[i] = 0.f; }
            if (ISC) {
                s0 = __builtin_amdgcn_mfma_f32_32x32x16_bf16(kf[0], qf[0][0], s0, 0, 0, 0); s1 = __builtin_amdgcn_mfma_f32_32x32x16_bf16(kf[2], qf[0][2], s1, 0, 0, 0);
                s0 = __builtin_amdgcn_mfma_f32_32x32x16_bf16(kf[1], qf[0][1], s0, 0, 0, 0); s1 = __builtin_amdgcn_mfma_f32_32x32x16_bf16(kf[3], qf[0][3], s1, 0, 0, 0);
            } else {
#pragma unroll
                for (int ks = 0; ks < 4; ++ks) s0 = __builtin_amdgcn_mfma_f32_32x32x16_bf16(kf[ks], qf[0][ks], s0, 0, 0, 0);
#pragma unroll
                for (int ks = 0; ks < 4; ++ks) s1 = __builtin_amdgcn_mfma_f32_32x32x16_bf16(kf[ks], qf[NQ - 1][ks], s1, 0, 0, 0);
            }
            __builtin_amdgcn_sched_barrier(0);
            ldv(cur, kk);
            if (kk == 0) ldk(cur, 1); else if (t + 1 < nkt) ldk(nxt, 0);
            SOFT_PV(0);
            SOFT_PV(1);
        }
        lds_barrier();
    }
#undef SOFT_PV
#pragma unroll
    for (int c = 0; c < 2; ++c) {
        const float lt = l_run[c] + __shfl_xor(l_run[c], 32);
        const float inv = 1.f / lt;
#pragma unroll
        for (int i = 0; i < 16; ++i) { O[c][0][i] *= inv; O[c][1][i] *= inv; }
    }
}

DI void store_OT(const f32x16 (&O)[2], bf16_t* dst  , int h) {
#pragma unroll
    for (int dt = 0; dt < 2; ++dt)
#pragma unroll
        for (int gq = 0; gq < 4; ++gq) {
            u32x2 w; w[0] = pk2(O[dt][4 * gq], O[dt][4 * gq + 1]); w[1] = pk2(O[dt][4 * gq + 2], O[dt][4 * gq + 3]);
            *(u32x2*)(dst + dt * 32 + 8 * gq + 4 * h) = w;
        }
}

DI void attn_unit(const Params& p, int l, int idx, int qb, bool isC, char* smem) {
    const int lane = TID() & 63, wid = TID() >> 6, r = lane & 31, h = lane >> 5;
    const int qpos0 = qb < 8 ? qb * 256 : SEQ, key_lo = qb < 8 ? 0 : SEQ, nkt = qb < 8 ? KEYS / 64 : CTX / 64;
    const int qpos = qpos0 + wid * 32 + r;
    f32x16 O[2][2];
    if (!isC) {
        const int b = idx >> 1, kvh = idx & 1;
        const size_t grow = qpos < SEQ ? (size_t)b * SEQ + qpos : (size_t)NLAT + b * CTX + (qpos - SEQ);
        const bf16_t* q0 = p.QA + (size_t)(b * 4 + 2 * kvh) * KEYS * 64;
        const float gq = fabsf(p.g_q_a[l * 64 + lane]), gk = fabsf(p.g_k_a[l * 64 + lane]);
        float mq = gq, mk = gk;
#pragma unroll
        for (int o = 32; o >= 1; o >>= 1) { mq = fmaxf(mq, __shfl_xor(mq, o)); mk = fmaxf(mk, __shfl_xor(mk, o)); }
        const float sc = 1.f, mfix = 64.f * 1.02f * mq * mk * SC_A;
        if (mfix < 60.f)
            attn2_core<false, true>(q0, q0 + (size_t)KEYS * 64, p.KA + (size_t)idx * KEYS * 64, p.VtA + (size_t)idx * 64 * KEYS, qpos0, key_lo, nkt, sc, mfix, mfix, O, smem);
        else
            attn2_core<false, false>(q0, q0 + (size_t)KEYS * 64, p.KA + (size_t)idx * KEYS * 64, p.VtA + (size_t)idx * 64 * KEYS, qpos0, key_lo, nkt, sc, 0.f, 0.f, O, smem);
        store_OT(O[0], p.cat + grow * D + (2 * kvh) * 64, h);
        store_OT(O[1], p.cat + grow * D + (2 * kvh + 1) * 64, h);
    } else {
        const int b = idx >> 2, head = idx & 3;
        const size_t grow = qpos < SEQ ? (size_t)b * SEQ + qpos : (size_t)NLAT + b * CTX + (qpos - SEQ);
        const bf16_t* qc = p.QC + (size_t)idx * KEYS * 64;
        const float scC = 1.f;
        float q2[2] = {0.f, 0.f};
#pragma unroll
        for (int c = 0; c < 2; ++c)
#pragma unroll
            for (int ks = 0; ks < 2; ++ks) {
                const u32x4 qv = *(const u32x4*)(qc + (size_t)qpos * 64 + (2 * c + ks) * 16 + 8 * h);
#pragma unroll
                for (int i = 0; i < 4; ++i) { const float a = bflo(qv[i]), bq = bfhi(qv[i]); q2[c] += a * a + bq * bq; }
            }
        q2[0] += __shfl_xor(q2[0], 32); q2[1] += __shfl_xor(q2[1], 32);
        const unsigned* km = p.kmaxC + (size_t)l * NB * 8 + idx * 2;
        const float mf0 = 1.03f * sqrtf(q2[0] * __uint_as_float(km[0])), mf1 = 1.03f * sqrtf(q2[1] * __uint_as_float(km[1]));
        if (__builtin_amdgcn_ballot_w64(mf0 < 60.f && mf1 < 60.f) == ~0ull)
            attn2_core<true, true>(qc, qc, p.KC + (size_t)idx * KEYS * 64, p.VtC + (size_t)idx * 64 * KEYS, qpos0, key_lo, nkt, scC, mf0, mf1, O, smem);
        else
            attn2_core<true, false>(qc, qc, p.KC + (size_t)idx * KEYS * 64, p.VtC + (size_t)idx * 64 * KEYS, qpos0, key_lo, nkt, scC, 0.f, 0.f, O, smem);
        const float lam_init = 0.8f - 0.6f * __expf(-0.3f * (float)l);
        const float* lp = p.lam_c + l * 128;
        const float d0 = wave_sum(lane < 32 ? lp[lane] * lp[32 + lane] : 0.f), d1 = wave_sum(lane < 32 ? lp[64 + lane] * lp[96 + lane] : 0.f);
        const float lam = __expf(d0) - __expf(d1) + lam_init;
        float ss = 0.f;
#pragma unroll
        for (int dt = 0; dt < 2; ++dt)
#pragma unroll
            for (int i = 0; i < 16; ++i) { const float v = O[0][dt][i] - lam * O[1][dt][i]; O[0][dt][i] = v; ss += v * v; }
        ss += __shfl_xor(ss, 32);
        const float rstd = rsqrtf(ss * (1.f / 64.f) + EPS) * (1.f - lam_init);
        const float* g = p.g_sub_c + l * 64;
#pragma unroll
        for (int dt = 0; dt < 2; ++dt)
#pragma unroll
            for (int i = 0; i < 16; ++i) O[0][dt][i] *= rstd * g[dt * 32 + 8 * (i >> 2) + 4 * h + (i & 3)];
        store_OT(O[0], p.cat + grow * D + 256 + head * 64, h);
    }
}

DI void gmlp_unit(const Params& p, int l, int uidx, char* smem) {
    const int g = uidx & 3, c = uidx >> 2, tid = TID(), lane = tid & 63, wid = tid >> 6, fr = lane & 15, fq = lane >> 4;
    LAS bf16_t* vT = (LAS bf16_t*)smem;
    constexpr int VS = 136;
    const int q = tid >> 2, d0 = (tid & 3) * 16;
    const bf16_t* src = p.VN + (size_t)(c * 128 + q) * 256 + g * 64 + d0;
    const bf16x8 a = *(const bf16x8*)src, bb = *(const bf16x8*)(src + 8);
    const bf16_t* wrow = p.Ws + ((size_t)(l * 4 + g) * 128 + wid * 16 + fr) * 128;
    bf16x8 af[4];
#pragma unroll
    for (int ks = 0; ks < 4; ++ks) af[ks] = *(const bf16x8*)(wrow + ks * 32 + fq * 8);
    const int prow = wid * 16 + fr; const size_t grow = (size_t)c * 128 + prow;
    const float bias = p.b_s_b[(l * 4 + g) * 128 + prow];
    u32x2 uu[4];
#pragma unroll
    for (int n = 0; n < 4; ++n) uu[n] = *(const u32x2*)(p.U + grow * 256 + g * 64 + n * 16 + fq * 4);
    lds_barrier();
#pragma unroll
    for (int j = 0; j < 8; ++j) { vT[(d0 + j) * VS + q] = (bf16_t)a[j]; vT[(d0 + 8 + j) * VS + q] = (bf16_t)bb[j]; }
    lds_barrier();
    f32x4 acc[4];
#pragma unroll
    for (int n = 0; n < 4; ++n) acc[n] = (f32x4){0.f, 0.f, 0.f, 0.f};
#pragma unroll
    for (int ks = 0; ks < 4; ++ks)
#pragma unroll
        for (int n = 0; n < 4; ++n) {
            const bf16x8 bfv = *(const LAS bf16x8*)(vT + (n * 16 + fr) * VS + ks * 32 + fq * 8);
            acc[n] = __builtin_amdgcn_mfma_f32_16x16x32_bf16(bfv, af[ks], acc[n], 0, 0, 0);
        }
#pragma unroll
    for (int n = 0; n < 4; ++n) {
        const int col = g * 64 + n * 16 + fq * 4;
        u32x2 w;
        w[0] = pk2(bflo(uu[n][0]) * (acc[n][0] + bias), bfhi(uu[n][0]) * (acc[n][1] + bias));
        w[1] = pk2(bflo(uu[n][1]) * (acc[n][2] + bias), bfhi(uu[n][1]) * (acc[n][3] + bias));
        *(u32x2*)(p.cat + grow * D + 512 + col) = w;
    }
}

DI void conv_unit(const Params& p, int l, int uidx, char* smem) {
    const int tid = TID(), lane = tid & 63, wid = tid >> 6;
    bf16_t* yin = (bf16_t*)smem;
    float* co = (float*)(smem + 94 * 256 * 2);
    const int row0 = uidx * 64;
    int s0, s1;
    if (row0 < NLAT) { s0 = (row0 / SEQ) * SEQ; s1 = s0 + SEQ; } else { s0 = NLAT + ((row0 - NLAT) / CTX) * CTX; s1 = s0 + CTX; }
    lds_barrier();
    {
        u32x4 v[6];
#pragma unroll
        for (int j = 0; j < 6; ++j) {
            const int i = tid + j * NTHR, rr = i >> 5, ch8 = (i & 31) * 8, gr = row0 - 15 + rr;
            v[j] = (u32x4){0, 0, 0, 0};
            if (i < 94 * 32 && gr >= s0 && gr < s1) v[j] = *(const u32x4*)(p.Y + (size_t)gr * 256 + ch8);
        }
#pragma unroll
        for (int j = 0; j < 6; ++j) {
            const int i = tid + j * NTHR, rr = i >> 5, ch8 = (i & 31) * 8;
            if (i < 94 * 32) *(u32x4*)(yin + rr * 256 + ch8) = v[j];
        }
    }
    lds_barrier();
    {
        const int ch = tid & 255, th = tid >> 8;
        float w[31];
#pragma unroll
        for (int k = 0; k < 31; ++k) w[k] = p.w_dw_d[(size_t)(l * 31 + k) * 256 + ch];
        const float bias = p.b_dw_d[l * 256 + ch];
        for (int i0 = th * 32; i0 < th * 32 + 32; i0 += 8) {
            float xw[38];
#pragma unroll
            for (int j = 0; j < 38; ++j) xw[j] = bf2f(yin[(i0 + j) * 256 + ch]);
#pragma unroll
            for (int o = 0; o < 8; ++o) {
                float a = bias;
#pragma unroll
                for (int k = 0; k < 31; ++k) a += w[k] * xw[o + k];
                co[(i0 + o) * 256 + ch] = a;
            }
        }
    }
    lds_barrier();
#pragma unroll
    for (int j = 0; j < 8; ++j) {
        const int tk = wid * 8 + j;
        const f32x4 v = *(const f32x4*)(co + tk * 256 + lane * 4);
        const float ss = wave_sum(v[0] * v[0] + v[1] * v[1] + v[2] * v[2] + v[3] * v[3]);
        const float rstd = rsqrtf(ss * (1.f / 256.f) + EPS);
        const f32x4 g = *(const f32x4*)(p.g_conv_d + l * 256 + lane * 4);
        u32x2 w; w[0] = pk2(silu_f(v[0] * rstd * g[0]), silu_f(v[1] * rstd * g[1])); w[1] = pk2(silu_f(v[2] * rstd * g[2]), silu_f(v[3] * rstd * g[3]));
        *(u32x2*)(p.cat + (size_t)(row0 + tk) * D + 768 + lane * 4) = w;
    }
}

DI void phase_mixers(const Params& p, int l, bool withctx, char* smem) {
    const int nCL = NB * 4 * 8, nAL = NB * 2 * 8, nCX = withctx ? NB * 4 : 0, nAX = withctx ? NB * 2 : 0;
    const int nG = (withctx ? NTOK : NLAT) / 128 * 4, nV = (withctx ? NTOK : NLAT) / 64;
    const int nAtt = nCL + nAL + nCX + nAX, total = nAtt + nG + nV;
    for (int u = blockIdx.x; u < total; u += gridDim.x) {
        asm volatile("" : "+s"(l));
        int r = u;
        if (r < nAtt) {
            int idx, qb; bool isC;
            if (r < nCL) { isC = true; const int w = r & 255, s = w >> 3; qb = s & 7; idx = (w & 7) + 8 * (s >> 3) + 32 * (r >> 8); }
            else if ((r -= nCL) < nAL) { isC = false; const int w = r & 255, s = w >> 3; qb = s & 7; idx = (w & 7) + 8 * (s >> 3) + 32 * (r >> 8); }
            else if ((r -= nAL) < nCX) { isC = true; idx = r; qb = 8; }
            else { r -= nCX; isC = false; idx = r; qb = 8; }
            if (isC) attn_unit(p, l, idx, qb, true, smem); else attn_unit(p, l, idx, qb, false, smem);
        } else if ((r -= nAtt) < nG) gmlp_unit(p, l, r, smem);
        else conv_unit(p, l, r - nG, smem);
    }
}

#define XB_TMO      128
#define XB_XCNT(j)  (256  + 64 * (j))
#define XB_XSUB(j)  (1280 + 64 * (j))
#define XB_XGEN(j)  (2304 + 64 * (j))
#define XB_TOP      3328
#define XB_TOPGEN   3392
#define XCD_BAR_WORDS 3456
#define XB_SPIN_CAP (1u << 22)
DI unsigned xb_ld(unsigned* p) { return __hip_atomic_load(p, __ATOMIC_RELAXED, __HIP_MEMORY_SCOPE_AGENT); }
DI unsigned xb_add(unsigned* p, unsigned v) { return __hip_atomic_fetch_add(p, v, __ATOMIC_RELAXED, __HIP_MEMORY_SCOPE_AGENT); }
DI unsigned xb_xcc_id() { return (unsigned)__builtin_amdgcn_s_getreg((3 << 11) | 20) & 0xFu; }
#define XB_SPIN(cond, bar) do { unsigned _sp = 0; while (cond) { __builtin_amdgcn_s_sleep(1); \
    if ((++_sp & 255u) == 0u) { if (xb_ld(&(bar)[XB_TMO])) break; if (_sp > XB_SPIN_CAP) { atomicAdd(&(bar)[XB_TMO], 1u); break; } } } } while (0)
DI void xcd_barrier_complete(unsigned* bar, unsigned x, unsigned& nloc, unsigned& nx) {
    const unsigned G = gridDim.x;
    unsigned sum, cnt, mine, sp = 0u;
    for (;;) {
        sum = 0u; cnt = 0u; mine = 0u;
#pragma unroll
        for (unsigned j = 0; j < 16; ++j) { const unsigned c = xb_ld(&bar[XB_XCNT(j)]); sum += c; cnt += (c > 0u) ? 1u : 0u; mine = (j == x) ? c : mine; }
        if (sum == G) break;
        __builtin_amdgcn_s_sleep(1);
        if ((++sp & 255u) == 0u) { if (xb_ld(&bar[XB_TMO])) break; if (sp > XB_SPIN_CAP) { atomicAdd(&bar[XB_TMO], 1u); break; } }
    }
    nloc = mine > 0u ? mine : 1u; nx = cnt > 0u ? cnt : 1u;
}
DI void xcd_barrier(unsigned* bar, volatile LAS unsigned* st) {
    asm volatile("s_waitcnt vmcnt(0)" ::: "memory");
    __syncthreads();
    if (__builtin_amdgcn_workitem_id_x() == 0) {
        __builtin_amdgcn_s_waitcnt(0);
        const unsigned x = xb_xcc_id();
        unsigned nloc = st[0], nx = st[1];
        if (nloc == 0u) { xcd_barrier_complete(bar, x, nloc, nx); st[0] = nloc; st[1] = nx; }
        const unsigned old = xb_add(&bar[XB_XSUB(x)], 1u);
        const unsigned gen = old / nloc;
        if (old + 1u == (gen + 1u) * nloc) {
            __builtin_amdgcn_fence(__ATOMIC_RELEASE, "agent");
            asm volatile("s_waitcnt vmcnt(0)" ::: "memory");
            const unsigned og = xb_add(&bar[XB_TOP], 1u);
            const unsigned tg = og / nx;
            if (og + 1u == (tg + 1u) * nx) xb_add(&bar[XB_TOPGEN], 1u);
            else XB_SPIN(xb_ld(&bar[XB_TOPGEN]) == tg, bar);
            __builtin_amdgcn_fence(__ATOMIC_ACQUIRE, "agent");
            xb_add(&bar[XB_XGEN(x)], 1u);
            asm volatile("s_waitcnt vmcnt(0)" ::: "memory");
        } else {
            XB_SPIN(xb_ld(&bar[XB_XGEN(x)]) == gen, bar);
            __builtin_amdgcn_fence(__ATOMIC_ACQUIRE, "agent");
            asm volatile("s_waitcnt vmcnt(0)" ::: "memory");
        }
    }
    __syncthreads();
}

constexpr int PH_PER_LAYER = 10, N_PHASES = 1 + DEPTH * PH_PER_LAYER + 1;

typedef const __attribute__((address_space(4))) Params* KParamsPtr;
__global__ void __launch_bounds__(NTHR) mega(Params p_unused, int ph_lo, int ph_hi) {
    extern __shared__ __attribute__((aligned(16))) char smem[];
    volatile LAS unsigned* xst = (volatile LAS unsigned*)(smem + LDS_BYTES - 16);
    if (ph_hi - ph_lo > 1) {
        if (__builtin_amdgcn_workitem_id_x() == 0) {
            xst[0] = 0u; xst[1] = 0u;
            KParamsPtr kp0 = (KParamsPtr)__builtin_amdgcn_kernarg_segment_ptr();
            (void)xb_add(&kp0->bar[XB_XCNT(xb_xcc_id())], 1u);
        }
        __syncthreads();
    }
#ifndef PROBE_PH
#define PROBE_PH -1
#endif
#if PROBE_SEL
    unsigned long long pr_t0 = 0, pr_prev = 0, pr_acc = 0; int pr_sel_prev = 0;
#endif
    for (int it = ph_lo; it < ph_hi + (PROBE_PH >= 0 ? 1 : 0); ++it) {
        const int ph = (PROBE_PH >= 0 && it > PROBE_PH) ? it - 1 : it;
        if (it == ph_lo + 1) cg::this_grid().sync();
        else if (it > ph_lo) { KParamsPtr kpb = (KParamsPtr)__builtin_amdgcn_kernarg_segment_ptr(); asm volatile("" : "+s"(kpb)); xcd_barrier(kpb->bar, xst); }
#if PROBE_SEL
        {
            const unsigned long long now = __builtin_amdgcn_s_memrealtime();
            if (it == ph_lo) { pr_t0 = now; } else if (pr_sel_prev) pr_acc += now - pr_prev;
            pr_prev = now;
            const int s_ = ph == 0 ? 10 : (ph == N_PHASES - 1 ? 11 : (ph - 1) % PH_PER_LAYER);
            pr_sel_prev = (PROBE_SEL >> s_) & 1;
            if (ph == N_PHASES - 1 && blockIdx.x == 0 && __builtin_amdgcn_workitem_id_x() == 0) {
                KParamsPtr kpp = (KParamsPtr)__builtin_amdgcn_kernarg_segment_ptr();
                kpp->probe[0] = sqrtf((float)pr_acc / (float)(now - pr_t0) * 2e-5f);
            }
            if (ph == N_PHASES - 1) { __syncthreads(); if (blockIdx.x == 0) { __threadfence(); } cg::this_grid().sync(); }
        }
#endif
        KParamsPtr kp = (KParamsPtr)__builtin_amdgcn_kernarg_segment_ptr();
        asm volatile("" : "+s"(kp));
        const Params& p = *(const Params*)kp;
        if (ph == 0) { phase_prologue(p, smem); continue; }
        if (ph == N_PHASES - 1) { phase_norm<true>(p, false, p.g_final, nullptr, 0, NLAT); continue; }
        const int l = (ph - 1) / PH_PER_LAYER, s = (ph - 1) % PH_PER_LAYER;
        const bool last = l == DEPTH - 1;
        const float* mods_l = p.mods + (size_t)l * 17 * MODW;
        if (s == 0 || s == 3 || s == 7) {
            const int j = s == 0 ? 0 : (s == 3 ? 1 : 2);
            const bool first = (l == 0 && s == 0);
            phase_norm<false>(p, first, p.g_norm + (l * 3 + j) * D, mods_l, 3 * j, (s == 7 && last) ? NLAT : NTOK);
        } else if (s == 1 || s == 8) {
            EpiSwiglu e{p.hid};
            phase_gemm_stream(p.xn, (s == 1 ? p.Wff1in : p.Wff2in) + (size_t)l * D * 2 * DFF, (s == 8 && last) ? NLAT : NTOK, 2 * DFF, D, e, smem);
        } else if (s == 2 || s == 6 || s == 9) {
            const bf16_t* A = s == 6 ? p.cat : p.hid;
            const bf16_t* Bt = s == 2 ? p.Wff1out + (size_t)l * D * DFF : (s == 9 ? p.Wff2out + (size_t)l * D * DFF : p.Wout + (size_t)l * D * D);
            const int K = s == 6 ? D : DFF, gi = s == 2 ? 2 : (s == 6 ? 5 : 8);
            EpiResid e{p.h16, mods_l + gi * D, p.dctx, s == 6 ? 1.0f : 0.5f};
            const bool withctx = !(s != 2 && last);
            phase_gemm_stream(A, Bt, withctx ? NTOK : NLAT, D, K, e, smem, withctx);
        } else if (s == 4) {
            EpiProj e{&p, l}; phase_gemm(p.xn, p.Win + (size_t)l * D * INC, NTOK, INC, D, e, smem, false, last);
        } else {
            phase_mixers(p, l, !last, smem);
        }
    }
}

extern "C" void kernel_launch(void* const* d_in, const int* in_sizes, int n_in, void* d_out, int out_size, void* d_ws, size_t ws_size, hipStream_t stream) {
    static int grid = 0;
    if (grid == 0) {
        int dev = 0, cus = 0, per_cu = 0;
        hipGetDevice(&dev);
        hipDeviceGetAttribute(&cus, hipDeviceAttributeMultiprocessorCount, dev);
        if (hipFuncSetAttribute((const void*)mega, hipFuncAttributeMaxDynamicSharedMemorySize, LDS_BYTES) != hipSuccess) fprintf(stderr, "hipFuncSetAttribute failed\n");
        if (hipOccupancyMaxActiveBlocksPerMultiprocessor(&per_cu, (const void*)mega, NTHR, LDS_BYTES) != hipSuccess || per_cu < 1) { fprintf(stderr, "occupancy query: %d\n", per_cu); per_cu = 1; }
        (void)hipGetLastError();
        grid = cus * per_cu;
        fprintf(stderr, "grid = %d (cus %d per_cu %d) ws_size %zu\n", grid, cus, per_cu, ws_size);
    }
    Params p{};
    const float** pin = (const float**)&p;
    for (int i = 0; i < 24; ++i) pin[i] = (const float*)d_in[i];
    p.out = (float*)d_out;
    char* w = (char*)d_ws; size_t off = 0;
    auto take = [&](size_t bytes) { char* r = w + off; off += (bytes + 255) & ~(size_t)255; return r; };
    p.Wff1in = (bf16_t*)take((size_t)DEPTH * D * 2 * DFF * 2);
    p.Wff1out = (bf16_t*)take((size_t)DEPTH * D * DFF * 2);
    p.Wff2in = (bf16_t*)take((size_t)DEPTH * D * 2 * DFF * 2);
    p.Wff2out = (bf16_t*)take((size_t)DEPTH * D * DFF * 2);
    p.Win = (bf16_t*)take((size_t)DEPTH * D * INC * 2);
    p.Wout = (bf16_t*)take((size_t)DEPTH * D * D * 2);
    p.Ws = (bf16_t*)take((size_t)DEPTH * 4 * 128 * 128 * 2);
    p.mods = (float*)take((size_t)DEPTH * 17 * MODW * 4);
    p.ropeA = (float*)take((size_t)SEQ * 32 * 2 * 4);
    p.ropeC = (float*)take((size_t)SEQ * 16 * 2 * 4);
    p.bar = (unsigned*)take((size_t)XCD_BAR_WORDS * 4);
    p.hc = nullptr;
    p.h16 = (_Float16*)take((size_t)NTOK * D * 2);
    p.probe = (float*)take(256);
    p.kmaxC = (unsigned*)take((size_t)DEPTH * NB * 4 * 2 * 4);
    p.dctx = (float*)take((size_t)4 * NCTX * D * 4);
    p.xn = (bf16_t*)d_out;
    p.cat = p.xn;
    p.hid = (bf16_t*)take((size_t)NTOK * DFF * 2);
    {
        char* q = (char*)p.hid; size_t o2 = 0;
        auto take2 = [&](size_t bytes) { char* r = q + o2; o2 += (bytes + 255) & ~(size_t)255; return r; };
        p.QA = (bf16_t*)take2((size_t)NB * 4 * KEYS * 64 * 2);
        p.KA = (bf16_t*)take2((size_t)NB * 2 * KEYS * 64 * 2);
        p.VtA = (bf16_t*)take2((size_t)NB * 2 * 64 * KEYS * 2);
        p.QC = (bf16_t*)take2((size_t)NB * 4 * 2 * KEYS * 32 * 2);
        p.KC = (bf16_t*)take2((size_t)NB * 4 * 2 * KEYS * 32 * 2);
        p.VtC = (bf16_t*)take2((size_t)NB * 4 * 64 * KEYS * 2);
        p.U = (bf16_t*)take2((size_t)NTOK * 256 * 2);
        p.VN = (bf16_t*)take2((size_t)NTOK * 256 * 2);
        p.Y = (bf16_t*)take2((size_t)NTOK * 256 * 2);
    }
    if (off > ws_size) { fprintf(stderr, "workspace too small: need %zu have %zu\n", off, ws_size); return; }
#if N_LAUNCH_MODE == 1
    if (hipMemsetAsync(p.bar, 0, (size_t)XCD_BAR_WORDS * 4, stream) != hipSuccess) fprintf(stderr, "memset of barrier words failed\n");
    int lo = 0, hi = N_PHASES;
    void* args[] = {&p, &lo, &hi};
    hipError_t e = hipLaunchCooperativeKernel((const void*)mega, dim3(grid), dim3(NTHR), args, LDS_BYTES, stream);
    if (e != hipSuccess) fprintf(stderr, "cooperative launch failed: %s (grid %d)\n", hipGetErrorString(e), grid);
#else
    for (int ph = 0; ph < N_PHASES; ++ph) hipLaunchKernelGGL(mega, dim3(grid), dim3(NTHR), LDS_BYTES, stream, p, ph, ph + 1);
#endif
}
```

```cpp
#include <hip/hip_runtime.h>
#include <hip/hip_cooperative_groups.h>
#include <cstdint>
#include <cstdio>
#include <cmath>
namespace cg = cooperative_groups;

#ifndef PROBE_SEL
#define PROBE_SEL 0
#endif
#ifndef N_LAUNCH_MODE
#define N_LAUNCH_MODE 1
#endif

typedef unsigned short bf16_t;
typedef short bf16x8 __attribute__((ext_vector_type(8)));
typedef short s16x4 __attribute__((ext_vector_type(4)));
typedef float f32x4 __attribute__((ext_vector_type(4)));
typedef float f32x2 __attribute__((ext_vector_type(2)));
typedef float f32x16 __attribute__((ext_vector_type(16)));
typedef unsigned u32x2 __attribute__((ext_vector_type(2)));
typedef unsigned u32x4 __attribute__((ext_vector_type(4)));
typedef __bf16 bf2_t __attribute__((ext_vector_type(2)));
#define DI __device__ __forceinline__

constexpr int D = 1024, NB = 16, SEQ = 2048, CTX = 256, NLAT = NB * SEQ, NCTX = NB * CTX, NTOK = NLAT + NCTX;
constexpr int DFF = 2816, INC = 2304, KEYS = SEQ + CTX, DEPTH = 2, MODW = 9 * D;
constexpr int NTHR = 512;
constexpr int LDS_BYTES = 135168;
constexpr float EPS = 1e-6f;

DI unsigned pk2(float a, float b) { f32x2 v = {a, b}; bf2_t r = __builtin_convertvector(v, bf2_t); return __builtin_bit_cast(unsigned, r); }
DI float bf2f(bf16_t v) { return __uint_as_float(((unsigned)v) << 16); }
DI float bflo(unsigned v) { return __uint_as_float(v << 16); }
DI float bfhi(unsigned v) { return __uint_as_float(v & 0xffff0000u); }
DI bf16_t f2bf(float a) { return (bf16_t)(pk2(a, 0.f) & 0xffffu); }
DI float silu_f(float x) { return x * __builtin_amdgcn_rcpf(1.f + __expf(-x)); }
DI float sigmoid_f(float x) { return __builtin_amdgcn_rcpf(1.f + __expf(-x)); }
DI float gelu_f(float x) { float u = 1.5957691216057308f * (x + 0.044715f * x * x * x); return x * __builtin_amdgcn_rcpf(1.f + __expf(-u)); }
DI int TID() { int t = __builtin_amdgcn_workitem_id_x(); asm volatile("" : "+v"(t)); return t; }
DI void lds_barrier() { asm volatile("s_waitcnt lgkmcnt(0)" ::: "memory"); __builtin_amdgcn_s_barrier(); asm volatile("" ::: "memory"); }
DI float wave_sum(float v) {
#pragma unroll
    for (int o = 32; o >= 1; o >>= 1) v += __shfl_xor(v, o);
    return v;
}

struct Params {
    const float *x, *c, *ctx, *c_ctx, *w_ada, *b_ada, *g_norm, *w_ff1_in, *w_ff1_out, *w_ff2_in, *w_ff2_out, *w_in, *w_out, *g_q_a, *g_k_a, *lam_c,
        *g_sub_c, *g_v_b, *w_s_b, *b_s_b, *w_dw_d, *b_dw_d, *g_conv_d, *g_final;
    float* out;
    bf16_t *Wff1in, *Wff1out, *Wff2in, *Wff2out, *Win, *Wout, *Ws;
    float *mods, *ropeA, *ropeC, *hc;
    bf16_t *xn, *hid, *QA, *KA, *VtA, *QC, *KC, *VtC, *U, *VN, *Y, *cat;
    unsigned* bar;
    float* probe;
    unsigned* kmaxC;
    float* dctx;
    _Float16* h16;
};

DI void sincos_d(double x, double& s, double& c) {
    double k = rint(x * 0.15915494309189535);
    double r = fma(-k, 6.283185307179586, x);
    r = fma(-k, 2.4492935982947064e-16, r);
    double r2 = r * r, as = 1.0, ac = 1.0;
#pragma unroll
    for (int n = 14; n >= 1; --n) {
        as = 1.0 - r2 / (double)((2 * n) * (2 * n + 1)) * as;
        ac = 1.0 - r2 / (double)((2 * n - 1) * (2 * n)) * ac;
    }
    s = r * as; c = ac;
}

constexpr int T_FFIN = (D / 64) * (2 * DFF / 256), T_FFOUT = (DFF / 64) * (D / 256), T_WIN = (D / 64) * (INC / 256), T_WOUT = (D / 64) * (D / 256);
constexpr int T_LAYER = 2 * T_FFIN + 2 * T_FFOUT + T_WIN + T_WOUT;
constexpr int U_TR = DEPTH * T_LAYER, U_WS = 32, U_ADA = 288, U_ROPE = 192;
constexpr int U_P0 = U_TR + U_WS + U_ADA + U_ROPE;

DI void transpose_unit(const float* src, bf16_t* dst, int K, int N, int perm, int ti, float* tile) {
    const int tn = N / 256, kt = ti / tn, nt = ti % tn, k0 = kt * 64;
    const int t = TID();
    const int kk = t >> 4, c4 = (t & 15) * 4;
    f32x4 v[4][2];
#pragma unroll
    for (int sub = 0; sub < 4; ++sub) {
        const int n0 = nt * 256 + sub * 64;
        int sc0 = n0;
        if (perm == 1) { const int q = n0 >> 8, j = n0 & 255; sc0 = j < 128 ? q * 128 + j : DFF + q * 128 + (j - 128); }
        else if (perm == 2 && n0 >= 1792) { const int m = n0 - 1792, q = m >> 8, j = m & 255; sc0 = j < 128 ? 1792 + q * 128 + j : 2048 + q * 128 + (j - 128); }
#pragma unroll
        for (int i = 0; i < 2; ++i) v[sub][i] = *(const f32x4*)(src + (size_t)(k0 + kk + 32 * i) * N + sc0 + c4);
    }
#pragma unroll
    for (int sub = 0; sub < 4; ++sub)
#pragma unroll
        for (int i = 0; i < 2; ++i) {
            float* tp = tile + sub * 64 * 65 + (kk + 32 * i) * 65 + c4;
            tp[0] = v[sub][i][0]; tp[1] = v[sub][i][1]; tp[2] = v[sub][i][2]; tp[3] = v[sub][i][3];
        }
    __syncthreads();
    {
        const int n = t >> 3, k8 = (t & 7) * 8;
#pragma unroll
        for (int sub = 0; sub < 4; ++sub) {
            const float* tp = tile + sub * 64 * 65 + k8 * 65 + n;
            u32x4 o;
            o[0] = pk2(tp[0], tp[65]); o[1] = pk2(tp[2 * 65], tp[3 * 65]); o[2] = pk2(tp[4 * 65], tp[5 * 65]); o[3] = pk2(tp[6 * 65], tp[7 * 65]);
            int drow = nt * 256 + sub * 64 + n;
            if (perm != 2) { const int c = drow & 31; drow = (drow & ~31) + ((c >> 2) & 1) * 16 + (c >> 3) * 4 + (c & 3); }
            *(u32x4*)(dst + (size_t)drow * K + k0 + k8) = o;
        }
    }
    __syncthreads();
}

DI void phase_prologue(const Params& p, char* smem) {
    const int t = TID();
    if ((int)blockIdx.x < U_ADA) {
        float* s = (float*)smem;
        float* red = s + 17 * 1024;
        {
            float cv[34];
#pragma unroll
            for (int j = 0; j < 34; ++j) { const int i = t + j * NTHR, r = i >> 10, k = i & 1023; cv[j] = r < 16 ? p.c[r * D + k] : p.c_ctx[k]; }
#pragma unroll
            for (int j = 0; j < 34; ++j) s[t + j * NTHR] = silu_f(cv[j]);
        }
        __syncthreads();
        const int col = t & 63, ks = t >> 6;
        for (int uu = blockIdx.x; uu < U_ADA; uu += gridDim.x) {
            const int l = uu / 144, col0 = (uu % 144) * 64;
            float acc[17];
#pragma unroll
            for (int r = 0; r < 17; ++r) acc[r] = 0.f;
            const float* w = p.w_ada + (size_t)l * D * MODW + (size_t)(ks * 128) * MODW + col0 + col;
            float wv[16], wn[16];
#pragma unroll
            for (int k = 0; k < 16; ++k) wv[k] = w[(size_t)k * MODW];
            for (int k0 = 0; k0 < 128; k0 += 16) {
                if (k0 + 16 < 128) {
#pragma unroll
                    for (int k = 0; k < 16; ++k) wn[k] = w[(size_t)(k0 + 16 + k) * MODW];
                }
#pragma unroll
                for (int r = 0; r < 17; ++r)
#pragma unroll
                    for (int kq = 0; kq < 4; ++kq) {
                        const f32x4 sv = *(const f32x4*)(s + r * 1024 + ks * 128 + k0 + 4 * kq);
                        acc[r] += (sv[0] * wv[4 * kq] + sv[1] * wv[4 * kq + 1]) + (sv[2] * wv[4 * kq + 2] + sv[3] * wv[4 * kq + 3]);
                    }
#pragma unroll
                for (int k = 0; k < 16; ++k) wv[k] = wn[k];
            }
#pragma unroll
            for (int r = 0; r < 17; ++r) red[(ks * 17 + r) * 64 + col] = acc[r];
            __syncthreads();
            for (int i = t; i < 17 * 64; i += NTHR) {
                const int r = i >> 6, cc = i & 63; float sum = 0.f;
#pragma unroll
                for (int q = 0; q < 8; ++q) sum += red[(q * 17 + r) * 64 + cc];
                p.mods[((size_t)l * 17 + r) * MODW + col0 + cc] = sum + p.b_ada[(size_t)l * MODW + col0 + cc];
            }
            __syncthreads();
        }
    }
    if (blockIdx.x == gridDim.x - 1 && t < DEPTH * NB * 4 * 2) p.kmaxC[t] = 0u;
    for (int v = (int)gridDim.x - 1 - (int)blockIdx.x; v < U_WS + U_ROPE; v += gridDim.x) {
        if (v < U_WS) {
            const int e0 = v * 4096 + t * 8;
            f32x4 a = *(const f32x4*)(p.w_s_b + e0), b = *(const f32x4*)(p.w_s_b + e0 + 4);
            u32x4 o; o[0] = pk2(a[0], a[1]); o[1] = pk2(a[2], a[3]); o[2] = pk2(b[0], b[1]); o[3] = pk2(b[2], b[3]);
            *(u32x4*)(p.Ws + e0) = o;
        } else {
            const int e = (v - U_WS) * 512 + t;
            const int pos = e / 48, j = e % 48, row = pos >> 6, col = pos & 63;
            float ang; float* dst;
            if (j < 32) { const float inv = exp2f(-(float)(j & 15) * (13.287712379549449f / 16.f)); ang = (float)(j < 16 ? row : col) * inv; dst = p.ropeA + ((size_t)pos * 32 + j) * 2; }
            else { const int jj = j - 32; const float inv = exp2f(-(float)(jj & 7) * (13.287712379549449f / 8.f)); ang = (float)(jj < 8 ? row : col) * inv; dst = p.ropeC + ((size_t)pos * 16 + jj) * 2; }
            double sn, cs; sincos_d((double)ang, sn, cs);
            dst[0] = (float)cs; dst[1] = (float)sn;
        }
    }
    for (int u = blockIdx.x; u < U_TR; u += gridDim.x) {
        const int l = u / T_LAYER; int r = u % T_LAYER;
        const float* src; bf16_t* dst; int K, N, perm;
        if (r < T_FFIN) { src = p.w_ff1_in + (size_t)l * D * 2 * DFF; dst = p.Wff1in + (size_t)l * D * 2 * DFF; K = D; N = 2 * DFF; perm = 1; }
        else if ((r -= T_FFIN) < T_FFOUT) { src = p.w_ff1_out + (size_t)l * D * DFF; dst = p.Wff1out + (size_t)l * D * DFF; K = DFF; N = D; perm = 0; }
        else if ((r -= T_FFOUT) < T_FFIN) { src = p.w_ff2_in + (size_t)l * D * 2 * DFF; dst = p.Wff2in + (size_t)l * D * 2 * DFF; K = D; N = 2 * DFF; perm = 1; }
        else if ((r -= T_FFIN) < T_FFOUT) { src = p.w_ff2_out + (size_t)l * D * DFF; dst = p.Wff2out + (size_t)l * D * DFF; K = DFF; N = D; perm = 0; }
        else if ((r -= T_FFOUT) < T_WIN) { src = p.w_in + (size_t)l * D * INC; dst = p.Win + (size_t)l * D * INC; K = D; N = INC; perm = 2; }
        else { r -= T_WIN; src = p.w_out + (size_t)l * D * D; dst = p.Wout + (size_t)l * D * D; K = D; N = D; perm = 0; }
        transpose_unit(src, dst, K, N, perm, r, (float*)smem);
    }
}

typedef _Float16 h16x4 __attribute__((ext_vector_type(4)));
#define NCOL(i) (((i) >> 1) * 512 + lane * 8 + ((i) & 1) * 4)
template <bool FINAL>
DI void phase_norm(const Params& p, bool first, const float* g, const float* mods_l, int mi, int nrows) {
    constexpr int RW = 4;
    const int wid = TID() >> 6, lane = TID() & 63;
    for (int u = blockIdx.x; u < nrows / (8 * RW); u += gridDim.x) {
        const int row0 = (u * 8 + wid) * RW;
        const bool islat = row0 < NLAT;
        const int mb = islat ? row0 / SEQ : 16;
        f32x4 v[RW][4];
        if (first) {
            const float* src = islat ? p.x + (size_t)row0 * D : p.ctx + (size_t)(row0 - NLAT) * D;
#pragma unroll
            for (int q = 0; q < RW; ++q)
#pragma unroll
                for (int i = 0; i < 4; ++i) v[q][i] = *(const f32x4*)(src + (size_t)q * D + NCOL(i));
        } else {
            h16x4 hv[RW][4];
#pragma unroll
            for (int q = 0; q < RW; ++q)
#pragma unroll
                for (int i = 0; i < 4; ++i) hv[q][i] = *(const h16x4*)(p.h16 + (size_t)(row0 + q) * D + NCOL(i));
            if (islat) {
#pragma unroll
                for (int q = 0; q < RW; ++q)
#pragma unroll
                    for (int i = 0; i < 4; ++i) v[q][i] = __builtin_convertvector(hv[q][i], f32x4);
            } else {
#pragma unroll
                for (int q = 0; q < RW; ++q)
#pragma unroll
                    for (int i = 0; i < 4; ++i) {
                        const float* pq = p.dctx + (size_t)(row0 + q - NLAT) * D + NCOL(i);
                        v[q][i] = __builtin_convertvector(hv[q][i], f32x4) + ((*(const f32x4*)pq + *(const f32x4*)(pq + (size_t)NCTX * D)) + (*(const f32x4*)(pq + (size_t)2 * NCTX * D) + *(const f32x4*)(pq + (size_t)3 * NCTX * D)));
                    }
            }
        }
        float rstd[RW];
#pragma unroll
        for (int q = 0; q < RW; ++q) {
            float ss = 0.f;
#pragma unroll
            for (int i = 0; i < 4; ++i) ss += v[q][i][0] * v[q][i][0] + v[q][i][1] * v[q][i][1] + v[q][i][2] * v[q][i][2] + v[q][i][3] * v[q][i][3];
            rstd[q] = rsqrtf(wave_sum(ss) * (1.f / D) + EPS);
        }
        if (FINAL) {
#pragma unroll
            for (int i = 0; i < 4; ++i) { const int col = NCOL(i); const f32x4 gv = *(const f32x4*)(g + col);
#pragma unroll
                for (int q = 0; q < RW; ++q) { f32x4 o = v[q][i] * rstd[q] * gv;
#if PROBE_SEL
                    { const float e = p.probe[0]; o[0] *= 1.f + e; o[1] *= 1.f - e; o[2] *= 1.f + e; o[3] *= 1.f - e; }
#endif
                    *(f32x4*)(p.out + (size_t)(row0 + q) * D + col) = o; } }
        } else {
            if (first || !islat) {
#pragma unroll
                for (int q = 0; q < RW; ++q)
#pragma unroll
                    for (int i = 0; i < 4; ++i) *(h16x4*)(p.h16 + (size_t)(row0 + q) * D + NCOL(i)) = __builtin_convertvector(v[q][i], h16x4);
            }
            const float* sh = mods_l + (size_t)mb * MODW + mi * D; const float* scl = sh + D;
#pragma unroll
            for (int i = 0; i < 4; ++i) {
                const int col = NCOL(i);
                const f32x4 gv = *(const f32x4*)(g + col), sv = *(const f32x4*)(scl + col), bv = *(const f32x4*)(sh + col);
                const f32x4 gs = gv * (1.f + sv);
#pragma unroll
                for (int q = 0; q < RW; ++q) {
                    const f32x4 o = v[q][i] * rstd[q] * gs + bv;
                    u32x2 w; w[0] = pk2(o[0], o[1]); w[1] = pk2(o[2], o[3]);
                    *(u32x2*)(p.xn + (size_t)(row0 + q) * D + col) = w;
                }
            }
        }
    }
}

#undef NCOL
constexpr int BM = 256, BK = 64, HALF = 128, HT = HALF * BK, NXCD = 8, WGM = 8;
DI int lds_byte(int r, int c) { const int st = (r >> 4) * 2 + (c >> 5), rr = r & 15, cc = c & 31, ob = rr * 64 + cc * 2; return st * 1024 + (ob ^ (((ob >> 9) & 1) << 5)); }
DI void stage_rc(int b, int& R, int& C) { const int st = b / 1024, sb = b % 1024, swz = sb ^ (((sb >> 9) & 1) << 5); R = (st >> 1) * 16 + swz / 64; C = (st & 1) * 32 + (swz % 64) / 2; }

#define LAS __attribute__((address_space(3)))
constexpr int HTB = HALF * BK * 2;
DI void gemm_tile(const bf16_t* A, const bf16_t* Bt, int K  , int kt0, int nt  , int brow, int bcol, f32x4 (&acc)[2][2][4][2], LAS unsigned char* lds) {
    const int tid = TID(), wid = __builtin_amdgcn_readfirstlane(tid >> 6), lane = tid & 63, wr = wid >> 2, wc = wid & 3, fr = lane & 15, fq = lane >> 4;
    unsigned voff[2];
#pragma unroll
    for (int i = 0; i < 2; ++i) { int R, C; stage_rc(tid * 16 + i * 8192, R, C); voff[i] = (unsigned)(R * K + C) * 2u; }
    const size_t kstep = (size_t)(BK * 2), hstep = (size_t)HALF * K * 2;
    const unsigned ldsw = (unsigned)wid * 1024u;
    const int aoff = lds_byte(wr * 64 + fr, fq * 8), boff = lds_byte(wc * 32 + fr, fq * 8);
#define SA(b, h) (((b) * 2 + (h)) * HTB)
#define SB(b, h) ((4 + (b) * 2 + (h)) * HTB)
#define STAGE(bufoff, gbase) do { _Pragma("unroll") for (int _i = 0; _i < 2; ++_i) \
        __builtin_amdgcn_global_load_lds((const unsigned*)((const char*)(gbase) + voff[_i]), (LAS unsigned*)(lds + (bufoff) + ldsw + _i * 8192), 16, 0, 0); } while (0)
#define LDA(dst, b, h) do { _Pragma("unroll") for (int m = 0; m < 4; ++m) _Pragma("unroll") for (int k = 0; k < 2; ++k) dst[m][k] = *(const LAS bf16x8*)(lds + SA(b, h) + aoff + m * 2048 + k * 1024); } while (0)
#define LDB(dst, b, h) do { _Pragma("unroll") for (int n = 0; n < 2; ++n) _Pragma("unroll") for (int k = 0; k < 2; ++k) dst[n][k] = *(const LAS bf16x8*)(lds + SB(b, h) + boff + n * 2048 + k * 1024); } while (0)
#define MMA(ai, bj, At_, Bt_) do { __builtin_amdgcn_s_setprio(1); _Pragma("unroll") for (int m = 0; m < 4; ++m) _Pragma("unroll") for (int n = 0; n < 2; ++n) _Pragma("unroll") for (int k = 0; k < 2; ++k) \
        acc[ai][bj][m][n] = __builtin_amdgcn_mfma_f32_16x16x32_bf16(Bt_[n][k], At_[m][k], acc[ai][bj][m][n], 0, 0, 0); __builtin_amdgcn_s_setprio(0); } while (0)
#define WAIT_V(n) asm volatile("s_waitcnt vmcnt(" #n ")" ::: "memory")
#define WAIT_L(n) asm volatile("s_waitcnt lgkmcnt(" #n ")" ::: "memory")
#define BAR __builtin_amdgcn_s_barrier()
#define SCHED __builtin_amdgcn_sched_barrier(0)
#pragma unroll
    for (int a = 0; a < 2; ++a)
#pragma unroll
        for (int b = 0; b < 2; ++b)
#pragma unroll
            for (int m = 0; m < 4; ++m)
#pragma unroll
                for (int n = 0; n < 2; ++n) acc[a][b][m][n] = (f32x4){0.f, 0.f, 0.f, 0.f};
    bf16x8 At[4][2], B0[2][2], B1[2][2];
    const char* cA = (const char*)A + (size_t)brow * K * 2 + (size_t)kt0 * BK * 2; const char* cB = (const char*)Bt + (size_t)bcol * K * 2 + (size_t)kt0 * BK * 2;
    STAGE(SB(0, 0), cB); STAGE(SB(0, 1), cB + hstep); STAGE(SA(0, 0), cA); STAGE(SA(0, 1), cA + hstep);
    if (wr == 1) BAR;
    WAIT_V(2); BAR;
    STAGE(SB(1, 0), cB + kstep); STAGE(SA(1, 0), cA + kstep); STAGE(SB(1, 1), cB + hstep + kstep);
    WAIT_V(6); BAR;
    for (int t = 0; t < nt; t += 2) {
        const bool lastit = (t == nt - 2);
        const char* a1 = cA + (size_t)(t + 1) * kstep;
        const char* a2 = lastit ? cA : cA + (size_t)(t + 2) * kstep; const char* b2 = lastit ? cB : cB + (size_t)(t + 2) * kstep;
        const char* a3 = a2 + kstep; const char* b3 = b2 + kstep;
        LDB(B0, 0, 0); LDB(B1, 0, 1); SCHED; LDA(At, 0, 0); STAGE(SA(1, 1), a1 + hstep);
        WAIT_V(8); WAIT_L(0); BAR; MMA(0, 0, At, B0); MMA(0, 1, At, B1); BAR; SCHED;
        LDA(At, 0, 1); STAGE(SB(0, 0), b2); STAGE(SB(0, 1), b2 + hstep); STAGE(SA(0, 0), a2);
        WAIT_V(8); WAIT_L(0); BAR; MMA(1, 0, At, B0); MMA(1, 1, At, B1); BAR; SCHED;
        LDB(B0, 1, 0); LDB(B1, 1, 1); SCHED; LDA(At, 1, 0); STAGE(SA(0, 1), a2 + hstep);
        WAIT_V(8); WAIT_L(0); BAR; MMA(0, 0, At, B0); MMA(0, 1, At, B1); BAR; SCHED;
        LDA(At, 1, 1); STAGE(SB(1, 0), b3); STAGE(SB(1, 1), b3 + hstep); STAGE(SA(1, 0), a3);
        WAIT_V(8); WAIT_L(0); BAR; MMA(1, 0, At, B0); MMA(1, 1, At, B1); BAR; SCHED;
    }
    WAIT_V(0);
    if (wr == 0) BAR;
    BAR;
}

DI void tile_order(int L, int nM, int nN, int& pm, int& pn) {
    const int nwg = nM * nN; int wgid = L;
    { const int q = nwg / NXCD, r = nwg % NXCD, xcd = wgid % NXCD, off = wgid / NXCD; wgid = (xcd < r ? xcd * (q + 1) : r * (q + 1) + (xcd - r) * q) + off; }
    const int nig = WGM * nN, gid = wgid / nig, fm = gid * WGM, gsz = (nM - fm) < WGM ? (nM - fm) : WGM;
    pm = fm + ((wgid % nig) % gsz); pn = (wgid % nig) / gsz;
}

struct EpiSwiglu {
    bf16_t* hid;
    DI void operator()(f32x4 (&acc)[2][2][4][2], int pm, int pn, int sl, char* smem) const {
        const int wid = TID() >> 6, lane = TID() & 63, wr = wid >> 2, wc = wid & 3, fr = lane & 15, fq = lane >> 4;
#pragma unroll
        for (int ai = 0; ai < 2; ++ai)
#pragma unroll
            for (int m = 0; m < 4; ++m) {
                const int row = pm * BM + ai * HALF + wr * 64 + m * 16 + fr;
                u32x4 w;
#pragma unroll
                for (int n = 0; n < 2; ++n) {
                    const f32x4 a = acc[ai][0][m][n], b = acc[ai][1][m][n];
                    w[2 * n] = pk2(silu_f(a[0]) * b[0], silu_f(a[1]) * b[1]); w[2 * n + 1] = pk2(silu_f(a[2]) * b[2], silu_f(a[3]) * b[3]);
                }
                *(u32x4*)(hid + (size_t)row * DFF + pn * 128 + wc * 32 + fq * 8) = w;
            }
    }
};
struct EpiResid {
    _Float16* h16; const float* gate; float* dctx; float gs;
    DI void operator()(f32x4 (&acc)[2][2][4][2], int pm, int pn, int sl, char* smem) const {
        typedef _Float16 h16x8 __attribute__((ext_vector_type(8)));
        typedef float f32x8 __attribute__((ext_vector_type(8)));
        const int wid = TID() >> 6, lane = TID() & 63, wr = wid >> 2, wc = wid & 3, fr = lane & 15, fq = lane >> 4;
        const int row0 = pm * BM; const bool islat = row0 < NLAT;
        _Float16* out = h16 + (size_t)(row0 + wr * 64 + fr) * D + pn * BM + wc * 32 + fq * 8;
        const float* gt = gate + (size_t)(islat ? row0 / SEQ : 16) * MODW + pn * BM + wc * 32 + fq * 8;
        f32x4 gv[2][2];
#pragma unroll
        for (int bj = 0; bj < 2; ++bj)
#pragma unroll
            for (int n = 0; n < 2; ++n) gv[bj][n] = *(const f32x4*)(gt + bj * HALF + n * 4) * gs;
        if (sl >= 0) {
            float* po = dctx + ((size_t)sl * NCTX + (row0 - NLAT) + wr * 64 + fr) * D + pn * BM + wc * 32 + fq * 8;
#pragma unroll
            for (int ai = 0; ai < 2; ++ai)
#pragma unroll
                for (int m = 0; m < 4; ++m)
#pragma unroll
                    for (int bj = 0; bj < 2; ++bj)
#pragma unroll
                        for (int n = 0; n < 2; ++n) *(f32x4*)(po + (size_t)(ai * HALF + m * 16) * D + bj * HALF + n * 4) = gv[bj][n] * acc[ai][bj][m][n];
            return;
        }
        h16x8 hv[2][4][2];
#pragma unroll
        for (int ai = 0; ai < 2; ++ai)
#pragma unroll
            for (int m = 0; m < 4; ++m)
#pragma unroll
                for (int bj = 0; bj < 2; ++bj) hv[ai][m][bj] = *(const h16x8*)(out + (size_t)(ai * HALF + m * 16) * D + bj * HALF);
#pragma unroll
        for (int ai = 0; ai < 2; ++ai)
#pragma unroll
            for (int m = 0; m < 4; ++m)
#pragma unroll
                for (int bj = 0; bj < 2; ++bj) {
                    const f32x8 hf = __builtin_convertvector(hv[ai][m][bj], f32x8);
                    const f32x4 lo = (f32x4){hf[0], hf[1], hf[2], hf[3]} + gv[bj][0] * acc[ai][bj][m][0], hi = (f32x4){hf[4], hf[5], hf[6], hf[7]} + gv[bj][1] * acc[ai][bj][m][1];
                    const f32x8 v = {lo[0], lo[1], lo[2], lo[3], hi[0], hi[1], hi[2], hi[3]};
                    *(h16x8*)(out + (size_t)(ai * HALF + m * 16) * D + bj * HALF) = __builtin_convertvector(v, h16x8);
                }
    }
};
constexpr float SC_A = 0.125f * 1.4426950408889634f, SC_C = 0.17677669529663687f * 1.4426950408889634f;
constexpr int TS = 260;
struct EpiProj {
    const Params* pp; int l;
    DI void operator()(f32x4 (&acc)[2][2][4][2], int pm, int pn, int sl, char* smem) const {
        const Params& p = *pp;
        LAS float* T = (LAS float*)smem;
        const int tid = TID(), wid = tid >> 6, lane = tid & 63, wr = wid >> 2, wc = wid & 3, fr = lane & 15, fq = lane >> 4;
#pragma unroll
        for (int ai = 0; ai < 2; ++ai) {
            lds_barrier();
#pragma unroll
            for (int bj = 0; bj < 2; ++bj)
#pragma unroll
                for (int m = 0; m < 4; ++m)
#pragma unroll
                    for (int n = 0; n < 2; ++n) *(LAS f32x4*)(T + (wr * 64 + m * 16 + fr) * TS + bj * HALF + wc * 32 + n * 16 + fq * 4) = acc[ai][bj][m][n];
            lds_barrier();
            const int rl = tid & 127, seg = tid >> 7, grow = pm * BM + ai * HALF + rl;
            const bool islat = grow < NLAT;
            const int b = islat ? grow / SEQ : (grow - NLAT) / CTX;
            const int pos = islat ? grow % SEQ : SEQ + (grow - NLAT) % CTX;
            const LAS float* xr = T + rl * TS + seg * 64;
            if (pn >= 7 && seg >= 2) continue;
#define LD8(dstv, off) { const f32x4 _a = *(const LAS f32x4*)(xr + (off)), _b = *(const LAS f32x4*)(xr + (off) + 4); dstv[0] = _a[0]; dstv[1] = _a[1]; dstv[2] = _a[2]; dstv[3] = _a[3]; dstv[4] = _b[0]; dstv[5] = _b[1]; dstv[6] = _b[2]; dstv[7] = _b[3]; }
            if (pn == 0 || (pn == 2 && seg < 2)) {
                const float* g = (pn == 0 ? p.g_q_a : p.g_k_a) + l * 64;
                bf16_t* dst = pn == 0 ? p.QA + ((size_t)(b * 4 + seg) * KEYS + pos) * 64 : p.KA + ((size_t)(b * 2 + seg) * KEYS + pos) * 64;
                float ss = 0.f;
#pragma unroll
                for (int i = 0; i < 16; ++i) { const f32x4 v = *(const LAS f32x4*)(xr + 4 * i); ss += v[0] * v[0] + v[1] * v[1] + v[2] * v[2] + v[3] * v[3]; }
                const float rstd = rsqrtf(ss * (1.f / 64.f) + EPS);
                const float* rp = p.ropeA + (size_t)(islat ? pos : 0) * 64;
#pragma unroll
                for (int i0 = 0; i0 < 32; i0 += 8) {
                    float xa[8], xb[8], o1[8], o2[8];
                    LD8(xa, i0); LD8(xb, i0 + 32);
#pragma unroll
                    for (int i = 0; i < 8; i += 2) {
                        f32x4 cssn = {1.f, 0.f, 1.f, 0.f};
                        if (islat) cssn = *(const f32x4*)(rp + (i0 + i) * 2);
#pragma unroll
                        for (int e = 0; e < 2; ++e) {
                            const float a = xa[i + e] * rstd * g[i0 + i + e], bb = xb[i + e] * rstd * g[i0 + i + e + 32];
                            o1[i + e] = a * cssn[2 * e] - bb * cssn[2 * e + 1]; o2[i + e] = a * cssn[2 * e + 1] + bb * cssn[2 * e];
                        }
                    }
                    const float qs = pn == 0 ? SC_A : 1.f;
                    u32x4 w1, w2;
#pragma unroll
                    for (int i = 0; i < 4; ++i) { w1[i] = pk2(o1[2 * i] * qs, o1[2 * i + 1] * qs); w2[i] = pk2(o2[2 * i] * qs, o2[2 * i + 1] * qs); }
                    *(u32x4*)(dst + i0) = w1; *(u32x4*)(dst + 32 + i0) = w2;
                }
            } else if (pn == 1 || pn == 3) {
                bf16_t* base = (pn == 1 ? p.QC : p.KC);
                const float* rp = p.ropeC + (size_t)(islat ? pos : 0) * 32;
#pragma unroll
                for (int mp = 0; mp < 2; ++mp) {
                    bf16_t* dst = base + ((size_t)(b * 4 + seg) * KEYS + pos) * 64 + mp * 32;
                    float k2 = 0.f;
#pragma unroll
                    for (int i0 = 0; i0 < 16; i0 += 8) {
                        float xa[8], xb[8], o1[8], o2[8];
                        LD8(xa, mp * 32 + i0); LD8(xb, mp * 32 + i0 + 16);
#pragma unroll
                        for (int i = 0; i < 8; ++i) k2 += xa[i] * xa[i] + xb[i] * xb[i];
#pragma unroll
                        for (int i = 0; i < 8; i += 2) {
                            f32x4 cssn = {1.f, 0.f, 1.f, 0.f};
                            if (islat) cssn = *(const f32x4*)(rp + (i0 + i) * 2);
#pragma unroll
                            for (int e = 0; e < 2; ++e) {
                                const float a = xa[i + e], bb = xb[i + e];
                                o1[i + e] = a * cssn[2 * e] - bb * cssn[2 * e + 1]; o2[i + e] = a * cssn[2 * e + 1] + bb * cssn[2 * e];
                            }
                        }
                        const float qs = pn == 1 ? SC_C : 1.f;
                        u32x4 w1, w2;
#pragma unroll
                        for (int i = 0; i < 4; ++i) { w1[i] = pk2(o1[2 * i] * qs, o1[2 * i + 1] * qs); w2[i] = pk2(o2[2 * i] * qs, o2[2 * i + 1] * qs); }
                        *(u32x4*)(dst + i0) = w1; *(u32x4*)(dst + 16 + i0) = w2;
                    }
                    if (pn == 3) {
#pragma unroll
                        for (int o = 32; o >= 1; o >>= 1) k2 = fmaxf(k2, __shfl_xor(k2, o));
                        if (lane == 0) atomicMax(p.kmaxC + (size_t)l * NB * 8 + (b * 4 + seg) * 2 + mp, __float_as_uint(k2));
                    }
                }
            } else if (pn == 2 || pn == 4) {
                bf16_t* dst = pn == 2 ? p.VtA + ((size_t)(b * 2 + (seg - 2)) * 64) * KEYS + pos : p.VtC + ((size_t)(b * 4 + seg) * 64) * KEYS + pos;
#pragma unroll
                for (int d0 = 0; d0 < 64; d0 += 8) {
                    float xa[8]; LD8(xa, d0);
#pragma unroll
                    for (int d = 0; d < 8; ++d) dst[(size_t)(d0 + d) * KEYS] = f2bf(xa[d]);
                }
            } else if (pn == 5) {
                bf16_t* dst = p.U + (size_t)grow * 256 + seg * 64;
#pragma unroll
                for (int i0 = 0; i0 < 64; i0 += 8) {
                    float xa[8]; LD8(xa, i0);
                    u32x4 w;
#pragma unroll
                    for (int i = 0; i < 4; ++i) w[i] = pk2(gelu_f(xa[2 * i]), gelu_f(xa[2 * i + 1]));
                    *(u32x4*)(dst + i0) = w;
                }
            } else if (pn == 6) {
                float ss = 0.f;
#pragma unroll
                for (int i0 = 0; i0 < 64; i0 += 8) {
                    float xa[8]; LD8(xa, i0);
#pragma unroll
                    for (int i = 0; i < 8; ++i) { const float gv = gelu_f(xa[i]); ss += gv * gv; }
                }
                T[rl * TS + 256 + seg] = ss;
                lds_barrier();
                const f32x4 pt = *(const LAS f32x4*)(T + rl * TS + 256);
                const float rstd = rsqrtf(((pt[0] + pt[1]) + (pt[2] + pt[3])) * (1.f / 256.f) + EPS);
                const float* g = p.g_v_b + l * 256 + seg * 64;
                bf16_t* dst = p.VN + (size_t)grow * 256 + seg * 64;
#pragma unroll
                for (int i0 = 0; i0 < 64; i0 += 8) {
                    float xa[8]; LD8(xa, i0);
                    u32x4 w;
#pragma unroll
                    for (int i = 0; i < 4; ++i) w[i] = pk2(gelu_f(xa[2 * i]) * rstd * g[i0 + 2 * i], gelu_f(xa[2 * i + 1]) * rstd * g[i0 + 2 * i + 1]);
                    *(u32x4*)(dst + i0) = w;
                }
            } else {
                bf16_t* dst = p.Y + (size_t)grow * 256 + (pn - 7) * 128 + seg * 64;
#pragma unroll
                for (int i0 = 0; i0 < 64; i0 += 8) {
                    float xa[8], ga[8]; LD8(xa, i0); LD8(ga, 128 + i0);
                    u32x4 w;
#pragma unroll
                    for (int i = 0; i < 4; ++i) w[i] = pk2(xa[2 * i] * sigmoid_f(ga[2 * i]), xa[2 * i + 1] * sigmoid_f(ga[2 * i + 1]));
                    *(u32x4*)(dst + i0) = w;
                }
            }
#undef LD8
        }
        lds_barrier();
    }
};

struct UnitList {
    int nM, nN, nwg, nsp, ntk, split, kvonly;
    DI void init(int M, int N, int K, bool splitctx, bool kvonlyctx) {
        nN = N / BM; ntk = K / BK; split = splitctx; kvonly = kvonlyctx;
        nM = ((splitctx || kvonlyctx) ? NLAT : M) / BM; nwg = nM * nN; nsp = splitctx ? (NCTX / BM) * nN * 4 : (kvonlyctx ? (NCTX / BM) * 3 : 0);
    }
    DI bool get(int L, int& pm, int& pn, int& sl, int& kt0, int& nt) const {
        if (L >= nwg + nsp) return false;
        sl = -1; kt0 = 0; nt = ntk;
        if (L < nwg) tile_order(L, nM, nN, pm, pn);
        else if (kvonly) { const int c = L - nwg; pm = NLAT / BM + c / 3; pn = 2 + c % 3; }
        else {
            const int c = L - nwg, tile = c >> 2; sl = c & 3; pm = NLAT / BM + tile / nN; pn = tile % nN;
            const int q = ntk / 8 * 2, rem2 = (ntk - 4 * q) / 2;
            kt0 = sl * q + 2 * (sl < rem2 ? sl : rem2); nt = q + (sl < rem2 ? 2 : 0);
        }
        return true;
    }
};

template <class Epi>
DI void phase_gemm(const bf16_t* A, const bf16_t* Bt, int M, int N, int K, const Epi& epi, char* smem, bool splitctx = false, bool kvonlyctx = false) {
    UnitList ul; ul.init(M, N, K, splitctx, kvonlyctx);
    for (int L = blockIdx.x;; L += gridDim.x) {
        int pm, pn, sl, kt0, nt;
        if (!ul.get(L, pm, pn, sl, kt0, nt)) break;
        f32x4 acc[2][2][4][2];
        gemm_tile(A, Bt, K, kt0, nt, pm * BM, pn * BM, acc, (LAS unsigned char*)smem);
        epi(acc, pm, pn, sl, smem);
    }
}

template <class Epi>
DI void phase_gemm_stream(const bf16_t* A, const bf16_t* Bt, int M, int N, int K, const Epi& epi, char* smem, bool splitctx = false) {
    UnitList ul; ul.init(M, N, K, splitctx, false);
    LAS unsigned char* lds = (LAS unsigned char*)smem;
    const int tid = TID(), wid = __builtin_amdgcn_readfirstlane(tid >> 6), lane = tid & 63, wr = wid >> 2, wc = wid & 3, fr = lane & 15, fq = lane >> 4;
    unsigned voff[2];
#pragma unroll
    for (int i = 0; i < 2; ++i) { int R, C; stage_rc(tid * 16 + i * 8192, R, C); voff[i] = (unsigned)(R * K + C) * 2u; }
    const size_t kstep = (size_t)(BK * 2), hstep = (size_t)HALF * K * 2, tstep = 2 * hstep;
    const unsigned ldsw = (unsigned)wid * 1024u;
    const int aoff = lds_byte(wr * 64 + fr, fq * 8), boff = lds_byte(wc * 32 + fr, fq * 8);
    int L = blockIdx.x, pm, pn, sl, kt0, nt;
    if (!ul.get(L, pm, pn, sl, kt0, nt)) return;
    f32x4 acc[2][2][4][2];
#pragma unroll
    for (int a = 0; a < 2; ++a)
#pragma unroll
        for (int b = 0; b < 2; ++b)
#pragma unroll
            for (int m = 0; m < 4; ++m)
#pragma unroll
                for (int n = 0; n < 2; ++n) acc[a][b][m][n] = (f32x4){0.f, 0.f, 0.f, 0.f};
    bf16x8 At[4][2], B0[2][2], B1[2][2];
    const char* cA = (const char*)A + (size_t)pm * tstep + (size_t)kt0 * kstep; const char* cB = (const char*)Bt + (size_t)pn * tstep + (size_t)kt0 * kstep;
    STAGE(SB(0, 0), cB); STAGE(SB(0, 1), cB + hstep); STAGE(SA(0, 0), cA); STAGE(SA(0, 1), cA + hstep);
    if (wr == 1) BAR;
    WAIT_V(2); BAR;
    STAGE(SB(1, 0), cB + kstep); STAGE(SA(1, 0), cA + kstep); STAGE(SB(1, 1), cB + hstep + kstep);
    WAIT_V(6); BAR;
    for (;;) {
        int npm, npn, nsl, nkt0, nnt;
        const bool has_next = ul.get(L + gridDim.x, npm, npn, nsl, nkt0, nnt);
        const char* nA = has_next ? (const char*)A + (size_t)npm * tstep + (size_t)nkt0 * kstep : cA; const char* nB = has_next ? (const char*)Bt + (size_t)npn * tstep + (size_t)nkt0 * kstep : cB;
        for (int t = 0; t < nt; t += 2) {
            const bool lastit = (t == nt - 2);
            const char* a1 = cA + (size_t)(t + 1) * kstep;
            const char* a2 = lastit ? nA : cA + (size_t)(t + 2) * kstep; const char* b2 = lastit ? nB : cB + (size_t)(t + 2) * kstep;
            const char* a3 = a2 + kstep; const char* b3 = b2 + kstep;
            LDB(B0, 0, 0); LDB(B1, 0, 1); SCHED; LDA(At, 0, 0); STAGE(SA(1, 1), a1 + hstep);
            WAIT_V(8); WAIT_L(0); BAR; MMA(0, 0, At, B0); MMA(0, 1, At, B1); BAR; SCHED;
            LDA(At, 0, 1); STAGE(SB(0, 0), b2); STAGE(SB(0, 1), b2 + hstep); STAGE(SA(0, 0), a2);
            WAIT_V(8); WAIT_L(0); BAR; MMA(1, 0, At, B0); MMA(1, 1, At, B1); BAR; SCHED;
            LDB(B0, 1, 0); LDB(B1, 1, 1); SCHED; LDA(At, 1, 0); STAGE(SA(0, 1), a2 + hstep);
            WAIT_V(8); WAIT_L(0); BAR; MMA(0, 0, At, B0); MMA(0, 1, At, B1); BAR; SCHED;
            LDA(At, 1, 1); STAGE(SB(1, 0), b3); STAGE(SB(1, 1), b3 + hstep); STAGE(SA(1, 0), a3);
            WAIT_V(8); WAIT_L(0); BAR; MMA(1, 0, At, B0); MMA(1, 1, At, B1); BAR; SCHED;
        }
        if (wr == 0) BAR;
        epi(acc, pm, pn, sl, smem);
        if (!has_next) break;
#pragma unroll
        for (int a = 0; a < 2; ++a)
#pragma unroll
            for (int b = 0; b < 2; ++b)
#pragma unroll
                for (int m = 0; m < 4; ++m)
#pragma unroll
                    for (int n = 0; n < 2; ++n) acc[a][b][m][n] = (f32x4){0.f, 0.f, 0.f, 0.f};
        L += gridDim.x; pm = npm; pn = npn; sl = nsl; kt0 = nkt0; nt = nnt; cA = nA; cB = nB;
        if (wr == 1) BAR;
    }
    WAIT_V(0);
    BAR;
}

constexpr int VROW = 144;
template <bool ISC, bool FIXM>
DI void attn2_core(const bf16_t* Q0, const bf16_t* Q1, const bf16_t* Kg, const bf16_t* Vt, int qpos0, int key_lo, int nkt, float sc, float mfix0, float mfix1, f32x16 (&O)[2][2], char* smem) {
    constexpr int KROW = 144, KBUF = 64 * KROW, VBUF = 64 * VROW, NSLOT = 4, NQ = ISC ? 1 : 2;
    LAS char* lds = (LAS char*)smem;
    const int tid = TID(), lane = tid & 63, wid = tid >> 6, r = lane & 31, h = lane >> 5;
    bf16x8 qf[NQ][4];
#pragma unroll
    for (int c = 0; c < NQ; ++c)
#pragma unroll
        for (int ks = 0; ks < 4; ++ks) qf[c][ks] = *(const bf16x8*)((c == 0 ? Q0 : Q1) + (size_t)(qpos0 + wid * 32 + r) * 64 + ks * 16 + 8 * h);
#pragma unroll
    for (int c = 0; c < 2; ++c)
#pragma unroll
        for (int i = 0; i < 16; ++i) { O[c][0][i] = 0.f; O[c][1][i] = 0.f; }
    float m_run[2] = {FIXM ? mfix0 : -1e30f, FIXM ? mfix1 : -1e30f}, l_run[2] = {0.f, 0.f};
    const int kkey = tid >> 3, kch = tid & 7;
    const int kst = kkey * KROW + kch * 16, vst = NSLOT * KBUF + kkey * VROW + kch * 16;
    const int krd = r * KROW + 16 * h, vrd = NSLOT * KBUF + r * VROW + 8 * h;
    const bf16_t* kg = Kg + (size_t)(key_lo + kkey) * 64 + kch * 8;
    const bf16_t* vg = Vt + (size_t)kkey * KEYS + key_lo + kch * 8;
    u32x4 kreg, vreg;
    bf16x8 kf[4]; u32x2 vf[2][2][2];
    auto gload = [&](int t) { kreg = *(const u32x4*)(kg + (size_t)t * 64 * 64); vreg = *(const u32x4*)(vg + t * 64); };
    auto lstore = [&](int slot) { *(LAS u32x4*)(lds + slot * KBUF + kst) = kreg; *(LAS u32x4*)(lds + slot * VBUF + vst) = vreg; };
    auto ldk = [&](int slot, int kk) {
        const LAS char* kb = lds + slot * KBUF + krd + kk * 32 * KROW;
#pragma unroll
        for (int ks = 0; ks < 4; ++ks) kf[ks] = *(const LAS bf16x8*)(kb + ks * 32);
    };
    auto ldv = [&](int slot, int kk) {
        const LAS char* vb = lds + slot * VBUF + vrd + kk * 64;
#pragma unroll
        for (int st = 0; st < 2; ++st)
#pragma unroll
            for (int dt = 0; dt < 2; ++dt) { const LAS char* vp = vb + dt * 32 * VROW + st * 32; vf[st][dt][0] = *(const LAS u32x2*)vp; vf[st][dt][1] = *(const LAS u32x2*)(vp + 16); }
    };
#define SOFT_PV(c) do { \
        if (!FIXM) { \
        float mx = s##c[0]; \
        _Pragma("unroll") for (int i = 1; i < 16; ++i) mx = __ocml_fmax_f32(mx, s##c[i]); \
        mx = __ocml_fmax_f32(mx, __shfl_xor(mx, 32)); \
        const float m_new = __ocml_fmax_f32(m_run[c], mx); \
        if (__builtin_amdgcn_ballot_w64(m_new > m_run[c]) != 0ull) { \
            const float alpha = __builtin_amdgcn_exp2f(m_run[c] - m_new); \
            m_run[c] = m_new; l_run[c] *= alpha; \
            _Pragma("unroll") for (int i = 0; i < 16; ++i) { O[c][0][i] *= alpha; O[c][1][i] *= alpha; } \
        } } \
        float ps = 0.f; \
        _Pragma("unroll") for (int i = 0; i < 16; ++i) { s##c[i] = __builtin_amdgcn_exp2f(FIXM ? s##c[i] : s##c[i] - m_run[c]); ps += s##c[i]; } \
        l_run[c] += ps; \
        _Pragma("unroll") for (int st = 0; st < 2; ++st) { \
            u32x4 pw; \
            _Pragma("unroll") for (int i = 0; i < 4; ++i) pw[i] = pk2(s##c[8 * st + 2 * i], s##c[8 * st + 2 * i + 1]); \
            const bf16x8 pf = __builtin_bit_cast(bf16x8, pw); \
            _Pragma("unroll") for (int dt = 0; dt < 2; ++dt) { \
                u32x4 vw = {vf[st][dt][0][0], vf[st][dt][0][1], vf[st][dt][1][0], vf[st][dt][1][1]}; \
                O[c][dt] = __builtin_amdgcn_mfma_f32_32x32x16_bf16(__builtin_bit_cast(bf16x8, vw), pf, O[c][dt], 0, 0, 0); \
            } \
        } } while (0)
    lds_barrier();
    gload(0); lstore(0);
    if (nkt > 1) { gload(1); lstore(1); }
    if (nkt > 2) gload(2);
    lds_barrier();
    ldk(0, 0);
    for (int t = 0; t < nkt; ++t) {
        const int cur = t & 3, nxt = (t + 1) & 3;
        if (t + 2 < nkt) lstore((t + 2) & 3);
        if (t + 3 < nkt) gload(t + 3);
#pragma unroll
        for (int kk = 0; kk < 2; ++kk) {
            f32x16 s0, s1;
#pragma unroll
            for (int i = 0; i < 16; ++i) { s0[i] = 0.f; s1[i] = 0.f; }
            if (ISC) {
                s0 = __builtin_amdgcn_mfma_f32_32x32x16_bf16(kf[0], qf[0][0], s0, 0, 0, 0); s1 = __builtin_amdgcn_mfma_f32_32x32x16_bf16(kf[2], qf[0][2], s1, 0, 0, 0);
                s0 = __builtin_amdgcn_mfma_f32_32x32x16_bf16(kf[1], qf[0][1], s0, 0, 0, 0); s1 = __builtin_amdgcn_mfma_f32_32x32x16_bf16(kf[3], qf[0][3], s1, 0, 0, 0);
            } else {
#pragma unroll
                for (int ks = 0; ks < 4; ++ks) s0 = __builtin_amdgcn_mfma_f32_32x32x16_bf16(kf[ks], qf[0][ks], s0, 0, 0, 0);
#pragma unroll
                for (int ks = 0; ks < 4; ++ks) s1 = __builtin_amdgcn_mfma_f32_32x32x16_bf16(kf[ks], qf[NQ - 1][ks], s1, 0, 0, 0);
            }
            __builtin_amdgcn_sched_barrier(0);
            ldv(cur, kk);
            if (kk == 0) ldk(cur, 1); else if (t + 1 < nkt) ldk(nxt, 0);
            SOFT_PV(0);
            SOFT_PV(1);
        }
        lds_barrier();
    }
#undef SOFT_PV
#pragma unroll
    for (int c = 0; c < 2; ++c) {
        const float lt = l_run[c] + __shfl_xor(l_run[c], 32);
        const float inv = 1.f / lt;
#pragma unroll
        for (int i = 0; i < 16; ++i) { O[c][0][i] *= inv; O[c][1][i] *= inv; }
    }
}

DI void store_OT(const f32x16 (&O)[2], bf16_t* dst  , int h) {
#pragma unroll
    for (int dt = 0; dt < 2; ++dt)
#pragma unroll
        for (int gq = 0; gq < 4; ++gq) {
            u32x2 w; w[0] = pk2(O[dt][4 * gq], O[dt][4 * gq + 1]); w[1] = pk2(O[dt][4 * gq + 2], O[dt][4 * gq + 3]);
            *(u32x2*)(dst + dt * 32 + 8 * gq + 4 * h) = w;
        }
}

DI void attn_unit(const Params& p, int l, int idx, int qb, bool isC, char* smem) {
    const int lane = TID() & 63, wid = TID() >> 6, r = lane & 31, h = lane >> 5;
    const int qpos0 = qb < 8 ? qb * 256 : SEQ, key_lo = qb < 8 ? 0 : SEQ, nkt = qb < 8 ? KEYS / 64 : CTX / 64;
    const int qpos = qpos0 + wid * 32 + r;
    f32x16 O[2][2];
    if (!isC) {
        const int b = idx >> 1, kvh = idx & 1;
        const size_t grow = qpos < SEQ ? (size_t)b * SEQ + qpos : (size_t)NLAT + b * CTX + (qpos - SEQ);
        const bf16_t* q0 = p.QA + (size_t)(b * 4 + 2 * kvh) * KEYS * 64;
        const float gq = fabsf(p.g_q_a[l * 64 + lane]), gk = fabsf(p.g_k_a[l * 64 + lane]);
        float mq = gq, mk = gk;
#pragma unroll
        for (int o = 32; o >= 1; o >>= 1) { mq = fmaxf(mq, __shfl_xor(mq, o)); mk = fmaxf(mk, __shfl_xor(mk, o)); }
        const float sc = 1.f, mfix = 64.f * 1.02f * mq * mk * SC_A;
        if (mfix < 60.f)
            attn2_core<false, true>(q0, q0 + (size_t)KEYS * 64, p.KA + (size_t)idx * KEYS * 64, p.VtA + (size_t)idx * 64 * KEYS, qpos0, key_lo, nkt, sc, mfix, mfix, O, smem);
        else
            attn2_core<false, false>(q0, q0 + (size_t)KEYS * 64, p.KA + (size_t)idx * KEYS * 64, p.VtA + (size_t)idx * 64 * KEYS, qpos0, key_lo, nkt, sc, 0.f, 0.f, O, smem);
        store_OT(O[0], p.cat + grow * D + (2 * kvh) * 64, h);
        store_OT(O[1], p.cat + grow * D + (2 * kvh + 1) * 64, h);
    } else {
        const int b = idx >> 2, head = idx & 3;
        const size_t grow = qpos < SEQ ? (size_t)b * SEQ + qpos : (size_t)NLAT + b * CTX + (qpos - SEQ);
        const bf16_t* qc = p.QC + (size_t)idx * KEYS * 64;
        const float scC = 1.f;
        float q2[2] = {0.f, 0.f};
#pragma unroll
        for (int c = 0; c < 2; ++c)
#pragma unroll
            for (int ks = 0; ks < 2; ++ks) {
                const u32x4 qv = *(const u32x4*)(qc + (size_t)qpos * 64 + (2 * c + ks) * 16 + 8 * h);
#pragma unroll
                for (int i = 0; i < 4; ++i) { const float a = bflo(qv[i]), bq = bfhi(qv[i]); q2[c] += a * a + bq * bq; }
            }
        q2[0] += __shfl_xor(q2[0], 32); q2[1] += __shfl_xor(q2[1], 32);
        const unsigned* km = p.kmaxC + (size_t)l * NB * 8 + idx * 2;
        const float mf0 = 1.03f * sqrtf(q2[0] * __uint_as_float(km[0])), mf1 = 1.03f * sqrtf(q2[1] * __uint_as_float(km[1]));
        if (__builtin_amdgcn_ballot_w64(mf0 < 60.f && mf1 < 60.f) == ~0ull)
            attn2_core<true, true>(qc, qc, p.KC + (size_t)idx * KEYS * 64, p.VtC + (size_t)idx * 64 * KEYS, qpos0, key_lo, nkt, scC, mf0, mf1, O, smem);
        else
            attn2_core<true, false>(qc, qc, p.KC + (size_t)idx * KEYS * 64, p.VtC + (size_t)idx * 64 * KEYS, qpos0, key_lo, nkt, scC, 0.f, 0.f, O, smem);
        const float lam_init = 0.8f - 0.6f * __expf(-0.3f * (float)l);
        const float* lp = p.lam_c + l * 128;
        const float d0 = wave_sum(lane < 32 ? lp[lane] * lp[32 + lane] : 0.f), d1 = wave_sum(lane < 32 ? lp[64 + lane] * lp[96 + lane] : 0.f);
        const float lam = __expf(d0) - __expf(d1) + lam_init;
        float ss = 0.f;
#pragma unroll
        for (int dt = 0; dt < 2; ++dt)
#pragma unroll
            for (int i = 0; i < 16; ++i) { const float v = O[0][dt][i] - lam * O[1][dt][i]; O[0][dt][i] = v; ss += v * v; }
        ss += __shfl_xor(ss, 32);
        const float rstd = rsqrtf(ss * (1.f / 64.f) + EPS) * (1.f - lam_init);
        const float* g = p.g_sub_c + l * 64;
#pragma unroll
        for (int dt = 0; dt < 2; ++dt)
#pragma unroll
            for (int i = 0; i < 16; ++i) O[0][dt][i] *= rstd * g[dt * 32 + 8 * (i >> 2) + 4 * h + (i & 3)];
        store_OT(O[0], p.cat + grow * D + 256 + head * 64, h);
    }
}

DI void gmlp_unit(const Params& p, int l, int uidx, char* smem) {
    const int g = uidx & 3, c = uidx >> 2, tid = TID(), lane = tid & 63, wid = tid >> 6, fr = lane & 15, fq = lane >> 4;
    LAS bf16_t* vT = (LAS bf16_t*)smem;
    constexpr int VS = 136;
    const int q = tid >> 2, d0 = (tid & 3) * 16;
    const bf16_t* src = p.VN + (size_t)(c * 128 + q) * 256 + g * 64 + d0;
    const bf16x8 a = *(const bf16x8*)src, bb = *(const bf16x8*)(src + 8);
    const bf16_t* wrow = p.Ws + ((size_t)(l * 4 + g) * 128 + wid * 16 + fr) * 128;
    bf16x8 af[4];
#pragma unroll
    for (int ks = 0; ks < 4; ++ks) af[ks] = *(const bf16x8*)(wrow + ks * 32 + fq * 8);
    const int prow = wid * 16 + fr; const size_t grow = (size_t)c * 128 + prow;
    const float bias = p.b_s_b[(l * 4 + g) * 128 + prow];
    u32x2 uu[4];
#pragma unroll
    for (int n = 0; n < 4; ++n) uu[n] = *(const u32x2*)(p.U + grow * 256 + g * 64 + n * 16 + fq * 4);
    lds_barrier();
#pragma unroll
    for (int j = 0; j < 8; ++j) { vT[(d0 + j) * VS + q] = (bf16_t)a[j]; vT[(d0 + 8 + j) * VS + q] = (bf16_t)bb[j]; }
    lds_barrier();
    f32x4 acc[4];
#pragma unroll
    for (int n = 0; n < 4; ++n) acc[n] = (f32x4){0.f, 0.f, 0.f, 0.f};
#pragma unroll
    for (int ks = 0; ks < 4; ++ks)
#pragma unroll
        for (int n = 0; n < 4; ++n) {
            const bf16x8 bfv = *(const LAS bf16x8*)(vT + (n * 16 + fr) * VS + ks * 32 + fq * 8);
            acc[n] = __builtin_amdgcn_mfma_f32_16x16x32_bf16(bfv, af[ks], acc[n], 0, 0, 0);
        }
#pragma unroll
    for (int n = 0; n < 4; ++n) {
        const int col = g * 64 + n * 16 + fq * 4;
        u32x2 w;
        w[0] = pk2(bflo(uu[n][0]) * (acc[n][0] + bias), bfhi(uu[n][0]) * (acc[n][1] + bias));
        w[1] = pk2(bflo(uu[n][1]) * (acc[n][2] + bias), bfhi(uu[n][1]) * (acc[n][3] + bias));
        *(u32x2*)(p.cat + grow * D + 512 + col) = w;
    }
}

DI void conv_unit(const Params& p, int l, int uidx, char* smem) {
    const int tid = TID(), lane = tid & 63, wid = tid >> 6;
    bf16_t* yin = (bf16_t*)smem;
    float* co = (float*)(smem + 94 * 256 * 2);
    const int row0 = uidx * 64;
    int s0, s1;
    if (row0 < NLAT) { s0 = (row0 / SEQ) * SEQ; s1 = s0 + SEQ; } else { s0 = NLAT + ((row0 - NLAT) / CTX) * CTX; s1 = s0 + CTX; }
    lds_barrier();
    {
        u32x4 v[6];
#pragma unroll
        for (int j = 0; j < 6; ++j) {
            const int i = tid + j * NTHR, rr = i >> 5, ch8 = (i & 31) * 8, gr = row0 - 15 + rr;
            v[j] = (u32x4){0, 0, 0, 0};
            if (i < 94 * 32 && gr >= s0 && gr < s1) v[j] = *(const u32x4*)(p.Y + (size_t)gr * 256 + ch8);
        }
#pragma unroll
        for (int j = 0; j < 6; ++j) {
            const int i = tid + j * NTHR, rr = i >> 5, ch8 = (i & 31) * 8;
            if (i < 94 * 32) *(u32x4*)(yin + rr * 256 + ch8) = v[j];
        }
    }
    lds_barrier();
    {
        const int ch = tid & 255, th = tid >> 8;
        float w[31];
#pragma unroll
        for (int k = 0; k < 31; ++k) w[k] = p.w_dw_d[(size_t)(l * 31 + k) * 256 + ch];
        const float bias = p.b_dw_d[l * 256 + ch];
        for (int i0 = th * 32; i0 < th * 32 + 32; i0 += 8) {
            float xw[38];
#pragma unroll
            for (int j = 0; j < 38; ++j) xw[j] = bf2f(yin[(i0 + j) * 256 + ch]);
#pragma unroll
            for (int o = 0; o < 8; ++o) {
                float a = bias;
#pragma unroll
                for (int k = 0; k < 31; ++k) a += w[k] * xw[o + k];
                co[(i0 + o) * 256 + ch] = a;
            }
        }
    }
    lds_barrier();
#pragma unroll
    for (int j = 0; j < 8; ++j) {
        const int tk = wid * 8 + j;
        const f32x4 v = *(const f32x4*)(co + tk * 256 + lane * 4);
        const float ss = wave_sum(v[0] * v[0] + v[1] * v[1] + v[2] * v[2] + v[3] * v[3]);
        const float rstd = rsqrtf(ss * (1.f / 256.f) + EPS);
        const f32x4 g = *(const f32x4*)(p.g_conv_d + l * 256 + lane * 4);
        u32x2 w; w[0] = pk2(silu_f(v[0] * rstd * g[0]), silu_f(v[1] * rstd * g[1])); w[1] = pk2(silu_f(v[2] * rstd * g[2]), silu_f(v[3] * rstd * g[3]));
        *(u32x2*)(p.cat + (size_t)(row0 + tk) * D + 768 + lane * 4) = w;
    }
}

DI void phase_mixers(const Params& p, int l, bool withctx, char* smem) {
    const int nCL = NB * 4 * 8, nAL = NB * 2 * 8, nCX = withctx ? NB * 4 : 0, nAX = withctx ? NB * 2 : 0;
    const int nG = (withctx ? NTOK : NLAT) / 128 * 4, nV = (withctx ? NTOK : NLAT) / 64;
    const int nAtt = nCL + nAL + nCX + nAX, total = nAtt + nG + nV;
    for (int u = blockIdx.x; u < total; u += gridDim.x) {
        asm volatile("" : "+s"(l));
        int r = u;
        if (r < nAtt) {
            int idx, qb; bool isC;
            if (r < nCL) { isC = true; const int w = r & 255, s = w >> 3; qb = s & 7; idx = (w & 7) + 8 * (s >> 3) + 32 * (r >> 8); }
            else if ((r -= nCL) < nAL) { isC = false; const int w = r & 255, s = w >> 3; qb = s & 7; idx = (w & 7) + 8 * (s >> 3) + 32 * (r >> 8); }
            else if ((r -= nAL) < nCX) { isC = true; idx = r; qb = 8; }
            else { r -= nCX; isC = false; idx = r; qb = 8; }
            if (isC) attn_unit(p, l, idx, qb, true, smem); else attn_unit(p, l, idx, qb, false, smem);
        } else if ((r -= nAtt) < nG) gmlp_unit(p, l, r, smem);
        else conv_unit(p, l, r - nG, smem);
    }
}

#define XB_TMO      128
#define XB_XCNT(j)  (256  + 64 * (j))
#define XB_XSUB(j)  (1280 + 64 * (j))
#define XB_XGEN(j)  (2304 + 64 * (j))
#define XB_TOP      3328
#define XB_TOPGEN   3392
#define XCD_BAR_WORDS 3456
#define XB_SPIN_CAP (1u << 22)
DI unsigned xb_ld(unsigned* p) { return __hip_atomic_load(p, __ATOMIC_RELAXED, __HIP_MEMORY_SCOPE_AGENT); }
DI unsigned xb_add(unsigned* p, unsigned v) { return __hip_atomic_fetch_add(p, v, __ATOMIC_RELAXED, __HIP_MEMORY_SCOPE_AGENT); }
DI unsigned xb_xcc_id() { return (unsigned)__builtin_amdgcn_s_getreg((3 << 11) | 20) & 0xFu; }
#define XB_SPIN(cond, bar) do { unsigned _sp = 0; while (cond) { __builtin_amdgcn_s_sleep(1); \
    if ((++_sp & 255u) == 0u) { if (xb_ld(&(bar)[XB_TMO])) break; if (_sp > XB_SPIN_CAP) { atomicAdd(&(bar)[XB_TMO], 1u); break; } } } } while (0)
DI void xcd_barrier_complete(unsigned* bar, unsigned x, unsigned& nloc, unsigned& nx) {
    const unsigned G = gridDim.x;
    unsigned sum, cnt, mine, sp = 0u;
    for (;;) {
        sum = 0u; cnt = 0u; mine = 0u;
#pragma unroll
        for (unsigned j = 0; j < 16; ++j) { const unsigned c = xb_ld(&bar[XB_XCNT(j)]); sum += c; cnt += (c > 0u) ? 1u : 0u; mine = (j == x) ? c : mine; }
        if (sum == G) break;
        __builtin_amdgcn_s_sleep(1);
        if ((++sp & 255u) == 0u) { if (xb_ld(&bar[XB_TMO])) break; if (sp > XB_SPIN_CAP) { atomicAdd(&bar[XB_TMO], 1u); break; } }
    }
    nloc = mine > 0u ? mine : 1u; nx = cnt > 0u ? cnt : 1u;
}
DI void xcd_barrier(unsigned* bar, volatile LAS unsigned* st) {
    asm volatile("s_waitcnt vmcnt(0)" ::: "memory");
    __syncthreads();
    if (__builtin_amdgcn_workitem_id_x() == 0) {
        __builtin_amdgcn_s_waitcnt(0);
        const unsigned x = xb_xcc_id();
        unsigned nloc = st[0], nx = st[1];
        if (nloc == 0u) { xcd_barrier_complete(bar, x, nloc, nx); st[0] = nloc; st[1] = nx; }
        const unsigned old = xb_add(&bar[XB_XSUB(x)], 1u);
        const unsigned gen = old / nloc;
        if (old + 1u == (gen + 1u) * nloc) {
            __builtin_amdgcn_fence(__ATOMIC_RELEASE, "agent");
            asm volatile("s_waitcnt vmcnt(0)" ::: "memory");
            const unsigned og = xb_add(&bar[XB_TOP], 1u);
            const unsigned tg = og / nx;
            if (og + 1u == (tg + 1u) * nx) xb_add(&bar[XB_TOPGEN], 1u);
            else XB_SPIN(xb_ld(&bar[XB_TOPGEN]) == tg, bar);
            __builtin_amdgcn_fence(__ATOMIC_ACQUIRE, "agent");
            xb_add(&bar[XB_XGEN(x)], 1u);
            asm volatile("s_waitcnt vmcnt(0)" ::: "memory");
        } else {
            XB_SPIN(xb_ld(&bar[XB_XGEN(x)]) == gen, bar);
            __builtin_amdgcn_fence(__ATOMIC_ACQUIRE, "agent");
            asm volatile("s_waitcnt vmcnt(0)" ::: "memory");
        }
    }
    __syncthreads();
}

constexpr int PH_PER_LAYER = 10, N_PHASES = 1 + DEPTH * PH_PER_LAYER + 1;

typedef const __attribute__((address_space(4))) Params* KParamsPtr;
__global__ void __launch_bounds__(NTHR) mega(Params p_unused, int ph_lo, int ph_hi) {
    extern __shared__ __attribute__((aligned(16))) char smem[];
    volatile LAS unsigned* xst = (volatile LAS unsigned*)(smem + LDS_BYTES - 16);
    if (ph_hi - ph_lo > 1) {
        if (__builtin_amdgcn_workitem_id_x() == 0) {
            xst[0] = 0u; xst[1] = 0u;
            KParamsPtr kp0 = (KParamsPtr)__builtin_amdgcn_kernarg_segment_ptr();
            (void)xb_add(&kp0->bar[XB_XCNT(xb_xcc_id())], 1u);
        }
        __syncthreads();
    }
#ifndef PROBE_PH
#define PROBE_PH -1
#endif
#if PROBE_SEL
    unsigned long long pr_t0 = 0, pr_prev = 0, pr_acc = 0; int pr_sel_prev = 0;
#endif
    for (int it = ph_lo; it < ph_hi + (PROBE_PH >= 0 ? 1 : 0); ++it) {
        const int ph = (PROBE_PH >= 0 && it > PROBE_PH) ? it - 1 : it;
        if (it == ph_lo + 1) cg::this_grid().sync();
        else if (it > ph_lo) { KParamsPtr kpb = (KParamsPtr)__builtin_amdgcn_kernarg_segment_ptr(); asm volatile("" : "+s"(kpb)); xcd_barrier(kpb->bar, xst); }
#if PROBE_SEL
        {
            const unsigned long long now = __builtin_amdgcn_s_memrealtime();
            if (it == ph_lo) { pr_t0 = now; } else if (pr_sel_prev) pr_acc += now - pr_prev;
            pr_prev = now;
            const int s_ = ph == 0 ? 10 : (ph == N_PHASES - 1 ? 11 : (ph - 1) % PH_PER_LAYER);
            pr_sel_prev = (PROBE_SEL >> s_) & 1;
            if (ph == N_PHASES - 1 && blockIdx.x == 0 && __builtin_amdgcn_workitem_id_x() == 0) {
                KParamsPtr kpp = (KParamsPtr)__builtin_amdgcn_kernarg_segment_ptr();
                kpp->probe[0] = sqrtf((float)pr_acc / (float)(now - pr_t0) * 2e-5f);
            }
            if (ph == N_PHASES - 1) { __syncthreads(); if (blockIdx.x == 0) { __threadfence(); } cg::this_grid().sync(); }
        }
#endif
        KParamsPtr kp = (KParamsPtr)__builtin_amdgcn_kernarg_segment_ptr();
        asm volatile("" : "+s"(kp));
        const Params& p = *(const Params*)kp;
        if (ph == 0) { phase_prologue(p, smem); continue; }
        if (ph == N_PHASES - 1) { phase_norm<true>(p, false, p.g_final, nullptr, 0, NLAT); continue; }
        const int l = (ph - 1) / PH_PER_LAYER, s = (ph - 1) % PH_PER_LAYER;
        const bool last = l == DEPTH - 1;
        const float* mods_l = p.mods + (size_t)l * 17 * MODW;
        if (s == 0 || s == 3 || s == 7) {
            const int j = s == 0 ? 0 : (s == 3 ? 1 : 2);
            const bool first = (l == 0 && s == 0);
            phase_norm<false>(p, first, p.g_norm + (l * 3 + j) * D, mods_l, 3 * j, (s == 7 && last) ? NLAT : NTOK);
        } else if (s == 1 || s == 8) {
            EpiSwiglu e{p.hid};
            phase_gemm_stream(p.xn, (s == 1 ? p.Wff1in : p.Wff2in) + (size_t)l * D * 2 * DFF, (s == 8 && last) ? NLAT : NTOK, 2 * DFF, D, e, smem);
        } else if (s == 2 || s == 6 || s == 9) {
            const bf16_t* A = s == 6 ? p.cat : p.hid;
            const bf16_t* Bt = s == 2 ? p.Wff1out + (size_t)l * D * DFF : (s == 9 ? p.Wff2out + (size_t)l * D * DFF : p.Wout + (size_t)l * D * D);
            const int K = s == 6 ? D : DFF, gi = s == 2 ? 2 : (s == 6 ? 5 : 8);
            EpiResid e{p.h16, mods_l + gi * D, p.dctx, s == 6 ? 1.0f : 0.5f};
            const bool withctx = !(s != 2 && last);
            phase_gemm_stream(A, Bt, withctx ? NTOK : NLAT, D, K, e, smem, withctx);
        } else if (s == 4) {
            EpiProj e{&p, l}; phase_gemm(p.xn, p.Win + (size_t)l * D * INC, NTOK, INC, D, e, smem, false, last);
        } else {
            phase_mixers(p, l, !last, smem);
        }
    }
}

extern "C" void kernel_launch(void* const* d_in, const int* in_sizes, int n_in, void* d_out, int out_size, void* d_ws, size_t ws_size, hipStream_t stream) {
    static int grid = 0;
    if (grid == 0) {
        int dev = 0, cus = 0, per_cu = 0;
        hipGetDevice(&dev);
        hipDeviceGetAttribute(&cus, hipDeviceAttributeMultiprocessorCount, dev);
        if (hipFuncSetAttribute((const void*)mega, hipFuncAttributeMaxDynamicSharedMemorySize, LDS_BYTES) != hipSuccess) fprintf(stderr, "hipFuncSetAttribute failed\n");
        if (hipOccupancyMaxActiveBlocksPerMultiprocessor(&per_cu, (const void*)mega, NTHR, LDS_BYTES) != hipSuccess || per_cu < 1) { fprintf(stderr, "occupancy query: %d\n", per_cu); per_cu = 1; }
        (void)hipGetLastError();
        grid = cus * per_cu;
        fprintf(stderr, "grid = %d (cus %d per_cu %d) ws_size %zu\n", grid, cus, per_cu, ws_size);
    }
    Params p{};
    const float** pin = (const float**)&p;
    for (int i = 0; i < 24; ++i) pin[i] = (const float*)d_in[i];
    p.out = (float*)d_out;
    char* w = (char*)d_ws; size_t off = 0;
    auto take = [&](size_t bytes) { char* r = w + off; off += (bytes + 255) & ~(size_t)255; return r; };
    p.Wff1in = (bf16_t*)take((size_t)DEPTH * D * 2 * DFF * 2);
    p.Wff1out = (bf16_t*)take((size_t)DEPTH * D * DFF * 2);
    p.Wff2in = (bf16_t*)take((size_t)DEPTH * D * 2 * DFF * 2);
    p.Wff2out = (bf16_t*)take((size_t)DEPTH * D * DFF * 2);
    p.Win = (bf16_t*)take((size_t)DEPTH * D * INC * 2);
    p.Wout = (bf16_t*)take((size_t)DEPTH * D * D * 2);
    p.Ws = (bf16_t*)take((size_t)DEPTH * 4 * 128 * 128 * 2);
    p.mods = (float*)take((size_t)DEPTH * 17 * MODW * 4);
    p.ropeA = (float*)take((size_t)SEQ * 32 * 2 * 4);
    p.ropeC = (float*)take((size_t)SEQ * 16 * 2 * 4);
    p.bar = (unsigned*)take((size_t)XCD_BAR_WORDS * 4);
    p.hc = nullptr;
    p.h16 = (_Float16*)take((size_t)NTOK * D * 2);
    p.probe = (float*)take(256);
    p.kmaxC = (unsigned*)take((size_t)DEPTH * NB * 4 * 2 * 4);
    p.dctx = (float*)take((size_t)4 * NCTX * D * 4);
    p.xn = (bf16_t*)d_out;
    p.cat = p.xn;
    p.hid = (bf16_t*)take((size_t)NTOK * DFF * 2);
    {
        char* q = (char*)p.hid; size_t o2 = 0;
        auto take2 = [&](size_t bytes) { char* r = q + o2; o2 += (bytes + 255) & ~(size_t)255; return r; };
        p.QA = (bf16_t*)take2((size_t)NB * 4 * KEYS * 64 * 2);
        p.KA = (bf16_t*)take2((size_t)NB * 2 * KEYS * 64 * 2);
        p.VtA = (bf16_t*)take2((size_t)NB * 2 * 64 * KEYS * 2);
        p.QC = (bf16_t*)take2((size_t)NB * 4 * 2 * KEYS * 32 * 2);
        p.KC = (bf16_t*)take2((size_t)NB * 4 * 2 * KEYS * 32 * 2);
        p.VtC = (bf16_t*)take2((size_t)NB * 4 * 64 * KEYS * 2);
        p.U = (bf16_t*)take2((size_t)NTOK * 256 * 2);
        p.VN = (bf16_t*)take2((size_t)NTOK * 256 * 2);
        p.Y = (bf16_t*)take2((size_t)NTOK * 256 * 2);
    }
    if (off > ws_size) { fprintf(stderr, "workspace too small: need %zu have %zu\n", off, ws_size); return; }
#if N_LAUNCH_MODE == 1
    if (hipMemsetAsync(p.bar, 0, (size_t)XCD_BAR_WORDS * 4, stream) != hipSuccess) fprintf(stderr, "memset of barrier words failed\n");
    int lo = 0, hi = N_PHASES;
    void* args[] = {&p, &lo, &hi};
    hipError_t e = hipLaunchCooperativeKernel((const void*)mega, dim3(grid), dim3(NTHR), args, LDS_BYTES, stream);
    if (e != hipSuccess) fprintf(stderr, "cooperative launch failed: %s (grid %d)\n", hipGetErrorString(e), grid);
#else
    for (int ph = 0; ph < N_PHASES; ++ph) hipLaunchKernelGGL(mega, dim3(grid), dim3(NTHR), LDS_BYTES, stream, p, ph, ph + 1);
#endif
}
```
